# Optimizing an MI355X kernel written in HIP

```python
import math
import jax
import jax.numpy as jnp
from jax import lax
import numpy as np

D_MODEL = 1024
BATCH = 1
SEQ = 16384
DEPTH = 1

CTX_LEN = 256
GRID_W = 64
HEAD_DIM = 64
ATTN_HEADS = 8
ATTN_KV_HEADS = 2
GQA_GROUP = ATTN_HEADS // ATTN_KV_HEADS
RET_HEADS = 4
RET_QK_DIM = 64
RET_V_DIM = 128
ATTN_WIDTH = ATTN_HEADS * HEAD_DIM
RET_WIDTH = RET_HEADS * RET_V_DIM
MIX_WIDTH = ATTN_WIDTH + RET_WIDTH
PROJ_SIZES = (ATTN_WIDTH, ATTN_KV_HEADS * HEAD_DIM, ATTN_KV_HEADS * HEAD_DIM,
              RET_HEADS * RET_QK_DIM, RET_HEADS * RET_QK_DIM, RET_WIDTH, RET_WIDTH)
PROJ_DIM = sum(PROJ_SIZES)
PROJ_SPLITS = tuple(int(v) for v in np.cumsum(PROJ_SIZES)[:-1])
Q_BLOCK = 128
RET_CHUNK = 128
ROPE_THETA = 10000.0
ROPE_AXIS_DIM = HEAD_DIM // 2
N_GROUPS = 4
EXPERTS_PER_GROUP = 8
N_EXPERTS = N_GROUPS * EXPERTS_PER_GROUP
TOP_K_IN_GROUP = 2
D_EXPERT = 512
MOE_BLOCK = 128
EPS = 1e-6

kernel_name = "hybrid_attn_retention_hmoe_dit"


def _rmsnorm(x, g):
    xf = x.astype(jnp.float32)
    xf = xf * lax.rsqrt(jnp.mean(xf * xf, axis=-1, keepdims=True) + EPS)
    return xf.astype(x.dtype) * g


def _modulate(xn, shift, scale):
    return xn * (1.0 + scale) + shift


def _axial_rope_tables(rows):
    row = jnp.repeat(jnp.arange(rows), GRID_W).astype(jnp.float32)
    col = jnp.tile(jnp.arange(GRID_W), rows).astype(jnp.float32)
    freqs = ROPE_THETA ** (-jnp.arange(0, ROPE_AXIS_DIM, 2, dtype=jnp.float32) / ROPE_AXIS_DIM)
    ang = jnp.concatenate([row[:, None] * freqs, col[:, None] * freqs], axis=-1)
    return jnp.cos(ang), jnp.sin(ang)


def _rope(x, cos, sin):
    B, L, H, d = x.shape
    xp = x.astype(jnp.float32).reshape(B, L, H, d // 2, 2)
    x0, x1 = xp[..., 0], xp[..., 1]
    c = cos[None, :, None, :]
    s = sin[None, :, None, :]
    out = jnp.stack([x0 * c - x1 * s, x0 * s + x1 * c], axis=-1).reshape(B, L, H, d)
    return out.astype(x.dtype)


def _attend(q, k, v):
    B, L, _, _ = q.shape
    nb = L // Q_BLOCK
    qb = jnp.moveaxis(q.reshape(B, nb, Q_BLOCK, ATTN_KV_HEADS, GQA_GROUP, HEAD_DIM), 1, 0)
    scale = HEAD_DIM ** -0.5

    def one_block(q_blk):
        s = jnp.einsum('bqhgd,bkhd->bhgqk', q_blk, k).astype(jnp.float32) * scale
        p = jax.nn.softmax(s, axis=-1)
        return jnp.einsum('bhgqk,bkhd->bqhgd', p.astype(v.dtype), v)

    o = lax.map(one_block, qb)
    return jnp.moveaxis(o, 0, 1).reshape(B, L, ATTN_WIDTH)


def _head_rms(x, g):
    xf = x.astype(jnp.float32)
    xf = xf * lax.rsqrt(jnp.mean(xf * xf, axis=-1, keepdims=True) + EPS)
    return xf.astype(x.dtype) * g


def _ret_heads(q, k, v, cos, sin):
    B, L, _ = q.shape
    q = q.reshape(B, L, RET_HEADS, RET_QK_DIM)
    k = k.reshape(B, L, RET_HEADS, RET_QK_DIM)
    if cos is not None:
        q = _rope(q, cos, sin)
        k = _rope(k, cos, sin)
    q = jnp.transpose(q, (0, 2, 1, 3)).astype(jnp.float32)
    k = jnp.transpose(k, (0, 2, 1, 3)).astype(jnp.float32) * (RET_QK_DIM ** -0.5)
    v = jnp.transpose(v.reshape(B, L, RET_HEADS, RET_V_DIM), (0, 2, 1, 3)).astype(jnp.float32)
    return q, k, v


def _retention_state(k, v, log_g, reverse):
    Lc = k.shape[2]
    m = jnp.arange(Lc, dtype=jnp.float32)
    dist = m if reverse else (Lc - 1 - m)
    w = jnp.exp(log_g[:, None] * dist[None, :])
    return jnp.einsum('bhmk,bhmv,hm->bhkv', k, v, w)


def _retention_chunked(q, k, v, log_g, s0, include_diag):
    B, H, L, dk = q.shape
    dv = v.shape[-1]
    C = RET_CHUNK
    n = L // C
    qc = q.reshape(B, H, n, C, dk)
    kc = k.reshape(B, H, n, C, dk)
    vc = v.reshape(B, H, n, C, dv)
    pos = jnp.arange(C, dtype=jnp.float32)
    diff = pos[:, None] - pos[None, :]
    mask = (diff >= 0) if include_diag else (diff > 0)
    dmat = jnp.where(mask, jnp.exp(log_g[:, None, None] * jnp.where(mask, diff, 0.0)[None]), 0.0)
    scores = jnp.einsum('bhnik,bhnjk->bhnij', qc, kc) * dmat[None, :, None]
    intra = jnp.einsum('bhnij,bhnjv->bhniv', scores, vc)
    zeta = jnp.exp(log_g[:, None] * (C - 1 - pos)[None, :])
    u = jnp.einsum('bhnjk,bhnjv,hj->bhnkv', kc, vc, zeta)
    g_chunk = jnp.exp(log_g * C)[None, :, None, None]

    def step(s, u_n):
        return g_chunk * s + u_n, s

    s_final, s_prev = lax.scan(step, s0, jnp.moveaxis(u, 2, 0))
    xi = jnp.exp(log_g[:, None] * (pos + 1.0)[None, :])
    cross = jnp.einsum('bhnik,nbhkv,hi->bhniv', qc, s_prev, xi)
    return (intra + cross).reshape(B, H, L, dv), s_final


def _retention_latent(q, k, v, k_c, v_c, log_gf, log_gb):
    s_f = _retention_state(k_c, v_c, log_gf, reverse=False)
    s_b = _retention_state(k_c, v_c, log_gb, reverse=True)
    o_f, _ = _retention_chunked(q, k, v, log_gf, s_f, True)
    o_b, _ = _retention_chunked(jnp.flip(q, 2), jnp.flip(k, 2), jnp.flip(v, 2), log_gb, s_b, False)
    return o_f + jnp.flip(o_b, 2)


def _retention_context(q, k, v, log_gf, log_gb):
    B, H, _, dk = q.shape
    s0 = jnp.zeros((B, H, dk, v.shape[-1]), jnp.float32)
    o_f, _ = _retention_chunked(q, k, v, log_gf, s0, True)
    o_b, _ = _retention_chunked(jnp.flip(q, 2), jnp.flip(k, 2), jnp.flip(v, 2), log_gb, s0, False)
    return o_f + jnp.flip(o_b, 2)


def _ret_output(o, gn_g, gn_b, gate, dtype):
    B, H, L, dv = o.shape
    mu = jnp.mean(o, axis=-1, keepdims=True)
    var = jnp.mean(jnp.square(o - mu), axis=-1, keepdims=True)
    on = (o - mu) * lax.rsqrt(var + EPS)
    on = jnp.transpose(on, (0, 2, 1, 3)).reshape(B, L, H * dv).astype(dtype)
    return (on * gn_g + gn_b) * jax.nn.silu(gate)


def _hier_moe(h, w_grp, b_grp, w_exp, b_exp, w_gate, w_up, w_down):
    T, D = h.shape
    grp_p = jax.nn.softmax((h @ w_grp).astype(jnp.float32) + b_grp, axis=-1)
    p_g, g_idx = lax.top_k(grp_p, 1)
    exp_logits = ((h @ w_exp).astype(jnp.float32) + b_exp).reshape(T, N_GROUPS, EXPERTS_PER_GROUP)
    sel = jnp.take_along_axis(exp_logits, jnp.broadcast_to(g_idx[:, :, None], (T, 1, EXPERTS_PER_GROUP)), axis=1)[:, 0]
    p_e, j_idx = lax.top_k(jax.nn.softmax(sel, axis=-1), TOP_K_IN_GROUP)
    weights = p_g * (p_e / jnp.sum(p_e, axis=-1, keepdims=True))
    eid = (g_idx * EXPERTS_PER_GROUP + j_idx).astype(jnp.int32)

    A = T * TOP_K_IN_GROUP
    eid_f = eid.reshape(A)
    tok_f = jnp.repeat(jnp.arange(T, dtype=jnp.int32), TOP_K_IN_GROUP)
    w_f = weights.reshape(A)
    order = jnp.argsort(eid_f)
    e_s, tok_s, w_s = eid_f[order], tok_f[order], w_f[order]
    counts = jnp.zeros((N_EXPERTS,), jnp.int32).at[eid_f].add(1)
    starts = jnp.cumsum(counts) - counts
    pcounts = (counts + MOE_BLOCK - 1) // MOE_BLOCK * MOE_BLOCK
    pends = jnp.cumsum(pcounts)
    pstarts = pends - pcounts
    dest = pstarts[e_s] + (jnp.arange(A, dtype=jnp.int32) - starts[e_s])
    P = A + N_EXPERTS * MOE_BLOCK
    nblk = P // MOE_BLOCK
    buf_tok = jnp.full((P,), T, jnp.int32).at[dest].set(tok_s)
    buf_w = jnp.zeros((P,), jnp.float32).at[dest].set(w_s).astype(h.dtype)
    blk_start = jnp.arange(nblk, dtype=jnp.int32) * MOE_BLOCK
    blk_e = jnp.minimum(jnp.sum(blk_start[:, None] >= pends[None, :], axis=1), N_EXPERTS - 1)
    h_pad = jnp.concatenate([h, jnp.zeros((1, D), h.dtype)], axis=0)
    xb = h_pad[buf_tok].reshape(nblk, MOE_BLOCK, D)

    def expert_block(args):
        x_blk, e = args
        return (jax.nn.silu(x_blk @ w_gate[e]) * (x_blk @ w_up[e])) @ w_down[e]

    yb = lax.map(expert_block, (xb, blk_e)).reshape(P, D)
    out = jnp.zeros((T + 1, D), h.dtype).at[buf_tok].add(yb * buf_w[:, None])
    return out[:T]


def setup_inputs(seed: int = 0) -> dict:
    key = jax.random.key(seed)
    ks = jax.random.split(key, 32)
    f32 = jnp.float32

    def nrm(k, shape, scale):
        return jax.random.normal(k, shape, f32) * scale

    base_logit = jnp.asarray(np.log(2.0 ** (5 + np.arange(RET_HEADS)) - 1.0).astype(np.float32))
    return {
        "x": nrm(ks[0], (BATCH, SEQ, D_MODEL), 1.0),
        "c": nrm(ks[1], (BATCH, D_MODEL), 1.0),
        "ctx": nrm(ks[2], (BATCH, CTX_LEN, D_MODEL), 1.0),
        "c_ctx": nrm(ks[3], (D_MODEL,), 1.0),
        "w_ada": nrm(ks[4], (DEPTH, D_MODEL, 6 * D_MODEL), 0.5 * D_MODEL ** -0.5),
        "b_ada": nrm(ks[5], (DEPTH, 6 * D_MODEL), 0.01),
        "norm1_g": 1.0 + nrm(ks[6], (DEPTH, D_MODEL), 0.05),
        "w_in": nrm(ks[7], (DEPTH, D_MODEL, PROJ_DIM), D_MODEL ** -0.5),
        "attn_q_norm": 1.0 + nrm(ks[8], (DEPTH, HEAD_DIM), 0.05),
        "attn_k_norm": 1.0 + nrm(ks[9], (DEPTH, HEAD_DIM), 0.05),
        "ret_decay_fwd": base_logit + nrm(ks[10], (DEPTH, RET_HEADS), 0.1),
        "ret_decay_bwd": base_logit + nrm(ks[11], (DEPTH, RET_HEADS), 0.1),
        "ret_gn_g": 1.0 + nrm(ks[12], (DEPTH, RET_WIDTH), 0.05),
        "ret_gn_b": nrm(ks[13], (DEPTH, RET_WIDTH), 0.01),
        "w_out": nrm(ks[14], (DEPTH, MIX_WIDTH, D_MODEL), MIX_WIDTH ** -0.5),
        "norm2_g": 1.0 + nrm(ks[15], (DEPTH, D_MODEL), 0.05),
        "moe_w_grp": nrm(ks[16], (DEPTH, D_MODEL, N_GROUPS), D_MODEL ** -0.5),
        "moe_b_grp": nrm(ks[17], (DEPTH, N_GROUPS), 0.01),
        "moe_w_exp": nrm(ks[18], (DEPTH, D_MODEL, N_EXPERTS), D_MODEL ** -0.5),
        "moe_b_exp": nrm(ks[19], (DEPTH, N_EXPERTS), 0.01),
        "moe_w_gate": nrm(ks[20], (DEPTH, N_EXPERTS, D_MODEL, D_EXPERT), D_MODEL ** -0.5),
        "moe_w_up": nrm(ks[21], (DEPTH, N_EXPERTS, D_MODEL, D_EXPERT), D_MODEL ** -0.5),
        "moe_w_down": nrm(ks[22], (DEPTH, N_EXPERTS, D_EXPERT, D_MODEL), D_EXPERT ** -0.5),
        "final_norm_g": 1.0 + nrm(ks[23], (D_MODEL,), 0.05),
    }


def reference(x, c, ctx, c_ctx, w_ada, b_ada, norm1_g, w_in, attn_q_norm, attn_k_norm,
              ret_decay_fwd, ret_decay_bwd, ret_gn_g, ret_gn_b, w_out, norm2_g,
              moe_w_grp, moe_b_grp, moe_w_exp, moe_b_exp, moe_w_gate, moe_w_up, moe_w_down,
              final_norm_g):
    B, L, D = x.shape
    CL = ctx.shape[1]
    ROWS = L // GRID_W
    cos, sin = _axial_rope_tables(ROWS)

    for l in range(DEPTH):
        mod_x = (jax.nn.silu(c) @ w_ada[l] + b_ada[l])[:, None, :]
        mod_c = (jax.nn.silu(c_ctx) @ w_ada[l] + b_ada[l])[None, None, :]
        sh1, sc1, gt1, sh2, sc2, gt2 = jnp.split(mod_x, 6, axis=-1)
        csh1, csc1, cgt1, csh2, csc2, cgt2 = jnp.split(mod_c, 6, axis=-1)
        log_gf = jax.nn.log_sigmoid(ret_decay_fwd[l].astype(jnp.float32))
        log_gb = jax.nn.log_sigmoid(ret_decay_bwd[l].astype(jnp.float32))

        hx = _modulate(_rmsnorm(x, norm1_g[l]), sh1, sc1)
        hc = _modulate(_rmsnorm(ctx, norm1_g[l]), csh1, csc1)
        qa, ka, va, qr, kr, vr, gr = jnp.split(hx @ w_in[l], PROJ_SPLITS, axis=-1)
        qa_c, ka_c, va_c, qr_c, kr_c, vr_c, gr_c = jnp.split(hc @ w_in[l], PROJ_SPLITS, axis=-1)

        qa = _rope(_head_rms(qa.reshape(B, L, ATTN_HEADS, HEAD_DIM), attn_q_norm[l]), cos, sin)
        ka = _rope(_head_rms(ka.reshape(B, L, ATTN_KV_HEADS, HEAD_DIM), attn_k_norm[l]), cos, sin)
        va = va.reshape(B, L, ATTN_KV_HEADS, HEAD_DIM)
        ka_c = _head_rms(ka_c.reshape(B, CL, ATTN_KV_HEADS, HEAD_DIM), attn_k_norm[l])
        va_c = va_c.reshape(B, CL, ATTN_KV_HEADS, HEAD_DIM)
        attn_x = _attend(qa, jnp.concatenate([ka_c, ka], axis=1), jnp.concatenate([va_c, va], axis=1))

        q_r, k_r, v_r = _ret_heads(qr, kr, vr, cos, sin)
        q_rc, k_rc, v_rc = _ret_heads(qr_c, kr_c, vr_c, None, None)
        ret_o = _retention_latent(q_r, k_r, v_r, k_rc, v_rc, log_gf, log_gb)
        ret_x = _ret_output(ret_o, ret_gn_g[l], ret_gn_b[l], gr, x.dtype)

        x_new = x + gt1 * (jnp.concatenate([attn_x, ret_x], axis=-1) @ w_out[l])

        h2 = _modulate(_rmsnorm(x_new, norm2_g[l]), sh2, sc2)
        y = _hier_moe(h2.reshape(B * L, D), moe_w_grp[l], moe_b_grp[l], moe_w_exp[l], moe_b_exp[l],
                      moe_w_gate[l], moe_w_up[l], moe_w_down[l]).reshape(B, L, D)
        x_new = x_new + gt2 * y

        if l + 1 < DEPTH:
            qa_c = _head_rms(qa_c.reshape(B, CL, ATTN_HEADS, HEAD_DIM), attn_q_norm[l])
            attn_c = _attend(qa_c, ka_c, va_c)
            ret_c = _ret_output(_retention_context(q_rc, k_rc, v_rc, log_gf, log_gb),
                                ret_gn_g[l], ret_gn_b[l], gr_c, ctx.dtype)
            ctx_new = ctx + cgt1 * (jnp.concatenate([attn_c, ret_c], axis=-1) @ w_out[l])
            h2c = _modulate(_rmsnorm(ctx_new, norm2_g[l]), csh2, csc2)
            yc = _hier_moe(h2c.reshape(B * CL, D), moe_w_grp[l], moe_b_grp[l], moe_w_exp[l], moe_b_exp[l],
                           moe_w_gate[l], moe_w_up[l], moe_w_down[l]).reshape(B, CL, D)
            ctx = ctx_new + cgt2 * yc
        x = x_new

    return _rmsnorm(x, final_norm_g)
```

```cpp
#include <hip/hip_runtime.h>
#include <cstdio>
#include <cstdint>
#include <cmath>

constexpr int DM = 1024, SEQ = 16384, CL = 256, NKV = SEQ + CL  , GRIDW = 64, NPROJ = 2304;
constexpr int NEXP = 32, DEXP = 512;
constexpr float EPS = 1e-6f;
constexpr float QSCALE = 0.125f * 1.4426950408889634f;
typedef unsigned short bf16;
typedef float f32x4 __attribute__((ext_vector_type(4)));
typedef unsigned u32x4 __attribute__((ext_vector_type(4)));
typedef unsigned u32x2 __attribute__((ext_vector_type(2)));

__host__ __device__ __forceinline__ float bf2f(bf16 v) { union { unsigned u; float f; } c; c.u = ((unsigned)v) << 16; return c.f; }
__host__ __device__ __forceinline__ bf16 f2bf(float f) { union { unsigned u; float f; } c; c.f = f; return (bf16)((c.u + 0x7fffu + ((c.u >> 16) & 1u)) >> 16); }
__device__ __forceinline__ unsigned pk2(float lo, float hi) { return (unsigned)f2bf(lo) | ((unsigned)f2bf(hi) << 16); }
__device__ __forceinline__ float wave_sum(float v) {
#pragma unroll
    for (int o = 1; o < 64; o <<= 1) v += __shfl_xor(v, o);
    return v;
}

constexpr size_t MiB = 1u << 20;
constexpr size_t WS_CTL = 0, CTL_ZERO_BYTES = 1 * MiB;
constexpr size_t WS_MOD = 1 * MiB;
constexpr size_t WS_ROPE = 1 * MiB + 64 * 1024;
constexpr size_t WS_EID = 2 * MiB;
constexpr size_t WS_RW = 2 * MiB + 256 * 1024;
constexpr size_t WS_LIST = 3 * MiB;
constexpr size_t WS_WI = 6 * MiB;
constexpr size_t WS_WO = 11 * MiB;
constexpr size_t WS_WGU = 13 * MiB;
constexpr size_t WS_WD = 77 * MiB;
constexpr size_t WS_HX = 109 * MiB;
constexpr size_t WS_MIX = WS_HX, WS_H2 = WS_HX;
constexpr size_t WS_Q = 142 * MiB;
constexpr size_t WS_K = 158 * MiB;
constexpr size_t WS_V = WS_K + 4352 * 1024;
constexpr size_t WS_QR = WS_V + 4352 * 1024;
constexpr size_t WS_KR = WS_QR + 8 * MiB;
constexpr size_t WS_VR = WS_KR + 8448 * 1024;
constexpr size_t WS_GR = WS_VR + 16896 * 1024;
constexpr size_t WS_U = WS_GR + 16 * MiB;
constexpr size_t WS_SP = WS_U + 33280 * 1024;
constexpr size_t WS_C_END = WS_SP + 16 * MiB;
constexpr size_t WS_ACT = 142 * MiB;
constexpr size_t WS_Y = 182 * MiB;
constexpr size_t WS_END = (WS_C_END > WS_Y + 64 * MiB ? WS_C_END : WS_Y + 64 * MiB);
constexpr int CW_TMO = 0, CW_CODE = 1, CW_CNT = 1024  , CW_BAR = 4096;

__device__ __forceinline__ void route_row(int t, int lane, const float* XN, const float* g2, const float* MOD, const float* wgrp, const float* bgrp,
                                          const float* wexp, const float* bexp, bf16* H2, int* EID, float* RW, int* CNT, int* LIST) {
    const f32x4* xr = (const f32x4*)(XN + (size_t)t * DM) + lane;
    f32x4 v[4]; float ss = 0.f;
#pragma unroll
    for (int j = 0; j < 4; ++j) { v[j] = xr[64 * j]; ss += (v[j].x * v[j].x + v[j].y * v[j].y) + (v[j].z * v[j].z + v[j].w * v[j].w); }
    const float rstd = rsqrtf(wave_sum(ss) * (1.f / DM) + EPS);
    float gl[4] = {0.f, 0.f, 0.f, 0.f};
    float h[16];
#pragma unroll
    for (int j = 0; j < 4; ++j) {
        const int n = 4 * lane + 256 * j;
        const f32x4 g = *(const f32x4*)(g2 + n), sh = *(const f32x4*)(MOD + 3072 + n), sc = *(const f32x4*)(MOD + 4096 + n);
#pragma unroll
        for (int i = 0; i < 4; ++i) { const float hv = (v[j][i] * rstd) * g[i] * (1.f + sc[i]) + sh[i]; h[4 * j + i] = hv;
            const f32x4 w = *(const f32x4*)(wgrp + (size_t)(n + i) * 4); gl[0] += hv * w.x; gl[1] += hv * w.y; gl[2] += hv * w.z; gl[3] += hv * w.w; }
        u32x2 o; o.x = pk2(h[4 * j], h[4 * j + 1]); o.y = pk2(h[4 * j + 2], h[4 * j + 3]);
        *(u32x2*)(H2 + (size_t)t * DM + n) = o;
    }
#pragma unroll
    for (int c = 0; c < 4; ++c) gl[c] = wave_sum(gl[c]) + bgrp[c];
    int g = 0; float gm = gl[0];
#pragma unroll
    for (int c = 1; c < 4; ++c) if (gl[c] > gm) { gm = gl[c]; g = c; }
    float gs = 0.f;
#pragma unroll
    for (int c = 0; c < 4; ++c) gs += expf(gl[c] - gm);
    const float pg = 1.f / gs;
    float el[8] = {0.f, 0.f, 0.f, 0.f, 0.f, 0.f, 0.f, 0.f};
#pragma unroll
    for (int j = 0; j < 4; ++j)
#pragma unroll
        for (int i = 0; i < 4; ++i) { const int n = 4 * lane + 256 * j + i; const f32x4 w0 = *(const f32x4*)(wexp + (size_t)n * 32 + g * 8), w1 = *(const f32x4*)(wexp + (size_t)n * 32 + g * 8 + 4);
            const float hv = h[4 * j + i]; el[0] += hv * w0.x; el[1] += hv * w0.y; el[2] += hv * w0.z; el[3] += hv * w0.w; el[4] += hv * w1.x; el[5] += hv * w1.y; el[6] += hv * w1.z; el[7] += hv * w1.w; }
#pragma unroll
    for (int c = 0; c < 8; ++c) el[c] = wave_sum(el[c]) + bexp[g * 8 + c];
    int j1 = 0; float m1 = el[0];
#pragma unroll
    for (int c = 1; c < 8; ++c) if (el[c] > m1) { m1 = el[c]; j1 = c; }
    int j2 = -1; float m2 = -INFINITY;
#pragma unroll
    for (int c = 0; c < 8; ++c) if (c != j1 && el[c] > m2) { m2 = el[c]; j2 = c; }
    const float e2 = expf(m2 - m1), w1 = pg / (1.f + e2), w2 = pg * e2 / (1.f + e2);
    if (lane == 0) {
        const int ea = g * 8 + j1, eb = g * 8 + j2;
        EID[2 * t] = ea; EID[2 * t + 1] = eb; RW[2 * t] = w1; RW[2 * t + 1] = w2;
        const int sa = atomicAdd(CNT + ea, 1); LIST[ea * SEQ + sa] = 2 * t;
        const int sb = atomicAdd(CNT + eb, 1); LIST[eb * SEQ + sb] = 2 * t + 1;
    }
}
__device__ __forceinline__ void final_row(int t, int lane, const float* XN, const bf16* Y, const float* RW, const float* MOD, const float* gfin, float* out) {
    const float w0 = RW[2 * t], w1 = RW[2 * t + 1];
    f32x4 v[4]; float ss = 0.f;
#pragma unroll
    for (int j = 0; j < 4; ++j) {
        const int n = 4 * lane + 256 * j;
        const f32x4 xv = *(const f32x4*)(XN + (size_t)t * DM + n), gt = *(const f32x4*)(MOD + 5120 + n);
        const u32x2 a = *(const u32x2*)(Y + (size_t)t * DM + n), b = *(const u32x2*)(Y + ((size_t)SEQ + t) * DM + n);
        float ya[4] = {__uint_as_float(a.x << 16), __uint_as_float(a.x & 0xffff0000u), __uint_as_float(a.y << 16), __uint_as_float(a.y & 0xffff0000u)};
        float yb[4] = {__uint_as_float(b.x << 16), __uint_as_float(b.x & 0xffff0000u), __uint_as_float(b.y << 16), __uint_as_float(b.y & 0xffff0000u)};
#pragma unroll
        for (int i = 0; i < 4; ++i) { v[j][i] = xv[i] + gt[i] * (ya[i] * w0 + yb[i] * w1); ss += v[j][i] * v[j][i]; }
    }
    const float rstd = rsqrtf(wave_sum(ss) * (1.f / DM) + EPS);
#pragma unroll
    for (int j = 0; j < 4; ++j) { const int n = 4 * lane + 256 * j; const f32x4 g = *(const f32x4*)(gfin + n);
        f32x4 o; o.x = v[j].x * rstd * g.x; o.y = v[j].y * rstd * g.y; o.z = v[j].z * rstd * g.z; o.w = v[j].w * rstd * g.w;
        *(f32x4*)(out + (size_t)t * DM + n) = o; }
}
__global__ void k_route(const float* XN, const float* g2, const float* MOD, const float* wgrp, const float* bgrp, const float* wexp, const float* bexp,
                        bf16* H2, int* EID, float* RW, int* CNT, int* LIST) {
    const int t = blockIdx.x * 4 + (threadIdx.x >> 6);
    route_row(t, threadIdx.x & 63, XN, g2, MOD, wgrp, bgrp, wexp, bexp, H2, EID, RW, CNT, LIST);
}
__global__ void k_final(const float* XN, const bf16* Y, const float* RW, const float* MOD, const float* gfin, float* out) {
    const int t = blockIdx.x * 4 + (threadIdx.x >> 6);
    final_row(t, threadIdx.x & 63, XN, Y, RW, MOD, gfin, out);
}
namespace nv {
__device__ __forceinline__ float silu(float v) { return v / (1.f + expf(-v)); }

__global__ void k_mod(const float* c, const float* cctx, const float* w, const float* b, float* MOD) {
    const int j = blockIdx.x * 256 + threadIdx.x, s = blockIdx.y; const float* src = s ? cctx : c;
    float acc = 0.f;
    for (int k = 0; k < DM; ++k) acc += silu(src[k]) * w[(size_t)k * 6144 + j];
    MOD[s * 6144 + j] = acc + b[j];
}
__global__ void k_rope(float* ROPE) {
    const int i = blockIdx.x * 256 + threadIdx.x; if (i >= 256 * 16) return;
    const int pos = i >> 4, f = i & 15;
    const float freq = powf(10000.f, -(float)(2 * f) / 32.f); const float ang = (float)pos * freq;
    ROPE[2 * i] = cosf(ang); ROPE[2 * i + 1] = sinf(ang);
}
__global__ void k_norm1(const float* x, const float* ctx, const float* g1, const float* MOD, bf16* HX) {
    const int r = blockIdx.x, tid = threadIdx.x; const float* src = r < CL ? ctx + (size_t)r * DM : x + (size_t)(r - CL) * DM;
    const float* mod = MOD + (r < CL ? 6144 : 0);
    __shared__ float red[256];
    float v[4]; float ss = 0.f;
    for (int i = 0; i < 4; ++i) { v[i] = src[tid + 256 * i]; ss += v[i] * v[i]; }
    red[tid] = ss; __syncthreads();
    for (int o = 128; o > 0; o >>= 1) { if (tid < o) red[tid] += red[tid + o]; __syncthreads(); }
    const float rstd = rsqrtf(red[0] / DM + EPS);
    for (int i = 0; i < 4; ++i) { const int n = tid + 256 * i; const float xn = (v[i] * rstd) * g1[n]; HX[(size_t)r * DM + n] = f2bf(xn * (1.f + mod[1024 + n]) + mod[n]); }
}
__global__ void k_inproj(const bf16* HX, const float* w_in, const float* gq, const float* gk, const float* ROPE,
                         bf16* Q, bf16* K, bf16* V, bf16* QR, bf16* KR, bf16* VR, bf16* GR) {
    __shared__ float As[16][65]; __shared__ float Bs[16][65]; __shared__ float C[64][65];
    const int ct = blockIdx.x, rt = blockIdx.y, tid = threadIdx.x, ty = tid >> 4, tx = tid & 15;
    const int r0 = rt * 64, n0 = ct * 64;
    float acc[4][4] = {};
    for (int k0 = 0; k0 < DM; k0 += 16) {
        for (int i = tid; i < 64 * 16; i += 256) { const int rr = i >> 4, kk = i & 15; As[kk][rr] = bf2f(HX[(size_t)(r0 + rr) * DM + k0 + kk]); }
        for (int i = tid; i < 16 * 64; i += 256) { const int kk = i >> 6, nn = i & 63; Bs[kk][nn] = w_in[(size_t)(k0 + kk) * NPROJ + n0 + nn]; }
        __syncthreads();
        for (int kk = 0; kk < 16; ++kk) { float a[4], b[4];
            for (int i = 0; i < 4; ++i) { a[i] = As[kk][ty * 4 + i]; b[i] = Bs[kk][tx * 4 + i]; }
            for (int i = 0; i < 4; ++i) for (int j = 0; j < 4; ++j) acc[i][j] += a[i] * b[j]; }
        __syncthreads();
    }
    for (int i = 0; i < 4; ++i) for (int j = 0; j < 4; ++j) C[ty * 4 + i][tx * 4 + j] = acc[i][j];
    __syncthreads();
    const int row = tid >> 2, p0 = (tid & 3) * 8, r = r0 + row; const bool isctx = r < CL; const int t = r - CL;
    int kind, h;
    if (ct < 8) { kind = 0; h = ct; } else if (ct < 10) { kind = 1; h = ct - 8; } else if (ct < 12) { kind = 2; h = ct - 10; }
    else if (ct < 16) { kind = 3; h = ct - 12; } else if (ct < 20) { kind = 4; h = ct - 16; } else if (ct < 28) { kind = 5; h = ct - 20; } else { kind = 6; h = ct - 28; }
    if (isctx && (kind == 0 || kind == 3 || kind == 6)) return;
    float rn = 1.f;
    if (kind == 0 || kind == 1) { float ss = 0.f; for (int d = 0; d < 64; ++d) ss += C[row][d] * C[row][d]; rn = rsqrtf(ss / 64.f + EPS); }
    for (int pi = 0; pi < 8; ++pi) {
        const int p = p0 + pi, d0 = 2 * p; float x0 = C[row][d0], x1 = C[row][d0 + 1];
        if (kind == 0) { x0 = x0 * rn * gq[d0]; x1 = x1 * rn * gq[d0 + 1]; }
        if (kind == 1) { x0 = x0 * rn * gk[d0]; x1 = x1 * rn * gk[d0 + 1]; }
        if (!isctx && (kind == 0 || kind == 1 || kind == 3 || kind == 4)) {
            const int pos = p < 16 ? (t / GRIDW) : (t % GRIDW), f = p & 15; const float cs = ROPE[(pos * 16 + f) * 2], sn = ROPE[(pos * 16 + f) * 2 + 1];
            const float y0 = x0 * cs - x1 * sn, y1 = x0 * sn + x1 * cs; x0 = y0; x1 = y1; }
        switch (kind) {
            case 0: Q[(size_t)t * 512 + h * 64 + d0] = f2bf(x0 * QSCALE); Q[(size_t)t * 512 + h * 64 + d0 + 1] = f2bf(x1 * QSCALE); break;
            case 1: K[((size_t)h * NKV + r) * 64 + d0] = f2bf(x0); K[((size_t)h * NKV + r) * 64 + d0 + 1] = f2bf(x1); break;
            case 2: V[((size_t)h * NKV + r) * 64 + d0] = f2bf(x0); V[((size_t)h * NKV + r) * 64 + d0 + 1] = f2bf(x1); break;
            case 3: QR[((size_t)h * SEQ + t) * 64 + d0] = f2bf(x0); QR[((size_t)h * SEQ + t) * 64 + d0 + 1] = f2bf(x1); break;
            case 4: KR[((size_t)h * NKV + r) * 64 + d0] = f2bf(x0 * 0.125f); KR[((size_t)h * NKV + r) * 64 + d0 + 1] = f2bf(x1 * 0.125f); break;
            case 5: { const int hh = h >> 1, half = h & 1; VR[((size_t)hh * NKV + r) * 128 + half * 64 + d0] = f2bf(x0); VR[((size_t)hh * NKV + r) * 128 + half * 64 + d0 + 1] = f2bf(x1); } break;
            default: GR[(size_t)t * 512 + h * 64 + d0] = f2bf(x0); GR[(size_t)t * 512 + h * 64 + d0 + 1] = f2bf(x1); break;
        }
    }
}
__global__ void __launch_bounds__(256) k_attn(const bf16* Q, const bf16* K, const bf16* V, bf16* MIX) {
    __shared__ float Ks[32][64]; __shared__ float Vs[32][64];
    const int h = blockIdx.y, t = blockIdx.x * 256 + threadIdx.x, hk = h >> 2;
    float q[64], o[64]; float m = -1e30f, l = 0.f;
    for (int d = 0; d < 64; ++d) { q[d] = bf2f(Q[(size_t)t * 512 + h * 64 + d]); o[d] = 0.f; }
    for (int j0 = 0; j0 < NKV; j0 += 32) {
        __syncthreads();
        for (int i = threadIdx.x; i < 32 * 64; i += 256) { Ks[i >> 6][i & 63] = bf2f(K[((size_t)hk * NKV + j0) * 64 + i]); Vs[i >> 6][i & 63] = bf2f(V[((size_t)hk * NKV + j0) * 64 + i]); }
        __syncthreads();
        float s[32]; float tm = -1e30f;
        for (int j = 0; j < 32; ++j) { float a = 0.f; for (int d = 0; d < 64; ++d) a += q[d] * Ks[j][d]; s[j] = a; tm = fmaxf(tm, a); }
        const float mn = fmaxf(m, tm), sc = exp2f(m - mn); m = mn; l *= sc;
        for (int d = 0; d < 64; ++d) o[d] *= sc;
        for (int j = 0; j < 32; ++j) { const float p = exp2f(s[j] - mn); l += p; for (int d = 0; d < 64; ++d) o[d] += p * Vs[j][d]; }
    }
    const float il = 1.f / l;
    for (int d = 0; d < 64; ++d) MIX[(size_t)t * 1024 + h * 64 + d] = f2bf(o[d] * il);
}
__global__ void __launch_bounds__(256) k_ret(const bf16* QR, const bf16* KR, const bf16* VR, const bf16* GR, const float* dec_f, const float* dec_b,
                                             const float* gn_g, const float* gn_b, bf16* MIX) {
    __shared__ float Ks[16][64]; __shared__ float Vs[16][128]; __shared__ float red[2][128];
    const int h = blockIdx.y, tl = threadIdx.x & 127, half = threadIdx.x >> 7, t = blockIdx.x * 128 + tl;
    const float lgf = -log1pf(expf(-dec_f[h])), lgb = -log1pf(expf(-dec_b[h]));
    float q[64], acc[64];
    for (int d = 0; d < 64; ++d) { q[d] = bf2f(QR[((size_t)h * SEQ + t) * 64 + d]); acc[d] = 0.f; }
    for (int m0 = 0; m0 < NKV; m0 += 16) {
        __syncthreads();
        for (int i = threadIdx.x; i < 16 * 64; i += 256) Ks[i >> 6][i & 63] = bf2f(KR[((size_t)h * NKV + m0) * 64 + i]);
        for (int i = threadIdx.x; i < 16 * 128; i += 256) Vs[i >> 7][i & 127] = bf2f(VR[((size_t)h * NKV + m0) * 128 + i]);
        __syncthreads();
        for (int j = 0; j < 16; ++j) {
            const int mc = m0 + j;
            float w;
            if (mc < CL) w = expf(lgf * (float)(t + CL - mc)) + expf(lgb * (float)(SEQ - t + mc));
            else { const int ml = mc - CL; w = ml <= t ? expf(lgf * (float)(t - ml)) : expf(lgb * (float)(ml - t)); }
            float a = 0.f; for (int d = 0; d < 64; ++d) a += q[d] * Ks[j][d];
            a *= w;
            for (int d = 0; d < 64; ++d) acc[d] += a * Vs[j][half * 64 + d];
        }
    }
    float s = 0.f; for (int d = 0; d < 64; ++d) s += acc[d];
    red[half][tl] = s; __syncthreads();
    const float mu = (red[0][tl] + red[1][tl]) * (1.f / 128.f); __syncthreads();
    float var = 0.f; for (int d = 0; d < 64; ++d) { const float e = acc[d] - mu; var += e * e; }
    red[half][tl] = var; __syncthreads();
    const float rs = rsqrtf((red[0][tl] + red[1][tl]) * (1.f / 128.f) + EPS);
    for (int d = 0; d < 64; ++d) { const int c = h * 128 + half * 64 + d; const float on = (acc[d] - mu) * rs; const float g = bf2f(GR[(size_t)t * 512 + c]);
        MIX[(size_t)t * 1024 + 512 + c] = f2bf((on * gn_g[c] + gn_b[c]) * silu(g)); }
}
__global__ void k_outproj(const bf16* MIX, const float* w_out, const float* x, const float* MOD, float* XN) {
    __shared__ float As[16][65]; __shared__ float Bs[16][65];
    const int ct = blockIdx.x, rt = blockIdx.y, tid = threadIdx.x, ty = tid >> 4, tx = tid & 15; const int r0 = rt * 64, n0 = ct * 64;
    float acc[4][4] = {};
    for (int k0 = 0; k0 < 1024; k0 += 16) {
        for (int i = tid; i < 64 * 16; i += 256) { const int rr = i >> 4, kk = i & 15; As[kk][rr] = bf2f(MIX[(size_t)(r0 + rr) * 1024 + k0 + kk]); }
        for (int i = tid; i < 16 * 64; i += 256) { const int kk = i >> 6, nn = i & 63; Bs[kk][nn] = w_out[(size_t)(k0 + kk) * DM + n0 + nn]; }
        __syncthreads();
        for (int kk = 0; kk < 16; ++kk) { float a[4], b[4];
            for (int i = 0; i < 4; ++i) { a[i] = As[kk][ty * 4 + i]; b[i] = Bs[kk][tx * 4 + i]; }
            for (int i = 0; i < 4; ++i) for (int j = 0; j < 4; ++j) acc[i][j] += a[i] * b[j]; }
        __syncthreads();
    }
    for (int i = 0; i < 4; ++i) for (int j = 0; j < 4; ++j) { const int r = r0 + ty * 4 + i, n = n0 + tx * 4 + j; XN[(size_t)r * DM + n] = x[(size_t)r * DM + n] + MOD[2048 + n] * acc[i][j]; }
}
__global__ void __launch_bounds__(256) k_moe(const bf16* H2, const int* CNT, const int* LIST, const float* wg, const float* wu, const float* wd, bf16* Y) {
    __shared__ float hs[8][1024]; __shared__ float act[8][512]; __shared__ int as_[8];
    const int e = blockIdx.y, s0 = blockIdx.x * 8, cnt = CNT[e], tid = threadIdx.x;
    if (s0 >= cnt) return;
    const int nv_ = min(8, cnt - s0);
    if (tid < 8) as_[tid] = tid < nv_ ? LIST[e * SEQ + s0 + tid] : -1;
    __syncthreads();
    for (int i = 0; i < 8; ++i) { const int a = as_[i]; for (int kk = tid; kk < 1024; kk += 256) hs[i][kk] = a >= 0 ? bf2f(H2[(size_t)(a >> 1) * DM + kk]) : 0.f; }
    __syncthreads();
    for (int j = tid; j < 512; j += 256) { float g[8] = {}, u[8] = {}; const float* pg = wg + (size_t)e * 1024 * 512 + j; const float* pu = wu + (size_t)e * 1024 * 512 + j;
        for (int kk = 0; kk < 1024; ++kk) { const float a = pg[(size_t)kk * 512], b = pu[(size_t)kk * 512];
            for (int i = 0; i < 8; ++i) { g[i] += hs[i][kk] * a; u[i] += hs[i][kk] * b; } }
        for (int i = 0; i < 8; ++i) act[i][j] = bf2f(f2bf(silu(g[i]) * u[i])); }
    __syncthreads();
    for (int n = tid; n < 1024; n += 256) { float y[8] = {}; const float* pd = wd + (size_t)e * 512 * 1024 + n;
        for (int j = 0; j < 512; ++j) { const float w = pd[(size_t)j * 1024]; for (int i = 0; i < 8; ++i) y[i] += act[i][j] * w; }
        for (int i = 0; i < 8; ++i) { const int a = as_[i]; if (a >= 0) Y[((size_t)(a & 1) * SEQ + (a >> 1)) * DM + n] = f2bf(y[i]); } }
}
}
extern "C" void kernel_launch(void* const* d_in, const int* in_sizes, int n_in, void* d_out, int out_size, void* d_ws, size_t ws_size, hipStream_t stream) {
    if (n_in != 24 || out_size != SEQ * DM || ws_size < WS_END) { fprintf(stderr, "kernel_launch: unexpected shapes / workspace (%d inputs, out %d, ws %zu < %zu)\n", n_in, out_size, ws_size, (size_t)WS_END); return; }
    const float* const* in = (const float* const*)d_in;
    unsigned char* ws = (unsigned char*)d_ws; float* out = (float*)d_out;
    float* MOD = (float*)(ws + WS_MOD); float* ROPE = (float*)(ws + WS_ROPE);
    int* EID = (int*)(ws + WS_EID); float* RW = (float*)(ws + WS_RW); int* LIST = (int*)(ws + WS_LIST); int* CNT = (int*)(ws + WS_CTL) + CW_CNT;
    bf16 *HX = (bf16*)(ws + WS_HX), *MIX = (bf16*)(ws + WS_MIX), *H2 = (bf16*)(ws + WS_H2), *Q = (bf16*)(ws + WS_Q), *K = (bf16*)(ws + WS_K), *V = (bf16*)(ws + WS_V);
    bf16 *QR = (bf16*)(ws + WS_QR), *KR = (bf16*)(ws + WS_KR), *VR = (bf16*)(ws + WS_VR), *GR = (bf16*)(ws + WS_GR), *Y = (bf16*)(ws + WS_Y);
    (void)hipMemsetAsync(ws + WS_CTL, 0, CTL_ZERO_BYTES, stream);
    nv::k_mod<<<dim3(24, 2), 256, 0, stream>>>(in[1], in[3], in[4], in[5], MOD);
    nv::k_rope<<<16, 256, 0, stream>>>(ROPE);
    nv::k_norm1<<<NKV, 256, 0, stream>>>(in[0], in[2], in[6], MOD, HX);
    nv::k_inproj<<<dim3(36, NKV / 64), 256, 0, stream>>>(HX, in[7], in[8], in[9], ROPE, Q, K, V, QR, KR, VR, GR);
    nv::k_attn<<<dim3(SEQ / 256, 8), 256, 0, stream>>>(Q, K, V, MIX);
    nv::k_ret<<<dim3(SEQ / 128, 4), 256, 0, stream>>>(QR, KR, VR, GR, in[10], in[11], in[12], in[13], MIX);
    nv::k_outproj<<<dim3(16, SEQ / 64), 256, 0, stream>>>(MIX, in[14], in[0], MOD, out);
    k_route<<<SEQ / 4, 256, 0, stream>>>(out, in[15], MOD, in[16], in[17], in[18], in[19], H2, EID, RW, CNT, LIST);
    nv::k_moe<<<dim3(SEQ / 8, NEXP), 256, 0, stream>>>(H2, CNT, LIST, in[20], in[21], in[22], Y);
    k_final<<<SEQ / 4, 256, 0, stream>>>(out, Y, RW, MOD, in[23], out);
}
```

```cpp
#define ONE_LAUNCH 1
#define FILL_ITEMS 16384
#define NT_POLICY 1
#define FUSE67_WT true
#define RET_WT 1
#define WT_MASK 3
#define MOE_NOACQ 1
#include <hip/hip_runtime.h>
#include <cstdio>
#include <cstdint>
#include <cmath>

constexpr int DM = 1024, SEQ = 16384, CL = 256, NKV = SEQ + CL  , GRIDW = 64, NPROJ = 2304;
constexpr int NEXP = 32, DEXP = 512;
constexpr float EPS = 1e-6f;
constexpr float QSCALE = 0.125f * 1.4426950408889634f;
typedef unsigned short bf16;
typedef float f32x4 __attribute__((ext_vector_type(4)));
typedef unsigned u32x4 __attribute__((ext_vector_type(4)));
typedef unsigned u32x2 __attribute__((ext_vector_type(2)));

__host__ __device__ __forceinline__ float bf2f(bf16 v) { union { unsigned u; float f; } c; c.u = ((unsigned)v) << 16; return c.f; }
__host__ __device__ __forceinline__ bf16 f2bf(float f) { union { unsigned u; float f; } c; c.f = f; return (bf16)((c.u + 0x7fffu + ((c.u >> 16) & 1u)) >> 16); }
__device__ __forceinline__ unsigned pk2(float lo, float hi) { unsigned r; asm("v_cvt_pk_bf16_f32 %0, %1, %2" : "=v"(r) : "v"(lo), "v"(hi)); return r; }
#ifndef WSUM_DPP
#define WSUM_DPP 0
#endif
__device__ __forceinline__ float dpp_add_(float v, const int ctrl_sel) {
    int r; const int iv = __float_as_int(v);
    switch (ctrl_sel) { case 0: r = __builtin_amdgcn_update_dpp(iv, iv, 0xB1, 0xF, 0xF, false); break;
                        case 1: r = __builtin_amdgcn_update_dpp(iv, iv, 0x4E, 0xF, 0xF, false); break;
                        case 2: r = __builtin_amdgcn_update_dpp(iv, iv, 0x141, 0xF, 0xF, false); break;
                        default: r = __builtin_amdgcn_update_dpp(iv, iv, 0x140, 0xF, 0xF, false); break; }
    return v + __int_as_float(r);
}
__device__ __forceinline__ float wave_sum(float v) {
#if WSUM_DPP
    v = dpp_add_(v, 0); v = dpp_add_(v, 1); v = dpp_add_(v, 2); v = dpp_add_(v, 3);
    { auto rr = __builtin_amdgcn_permlane16_swap(__float_as_uint(v), __float_as_uint(v), false, false); v = __uint_as_float(rr[0]) + __uint_as_float(rr[1]); }
    { auto rr = __builtin_amdgcn_permlane32_swap(__float_as_uint(v), __float_as_uint(v), false, false); v = __uint_as_float(rr[0]) + __uint_as_float(rr[1]); }
    return v;
#else
#pragma unroll
    for (int o = 1; o < 64; o <<= 1) v += __shfl_xor(v, o);
    return v;
#endif
}

#ifdef NT_POLICY
#define NT_LD(p) __builtin_nontemporal_load(p)
#define NT_ST(v, p) __builtin_nontemporal_store(v, p)
#else
#define NT_LD(p) (*(p))
#define NT_ST(v, p) (*(p) = (v))
#endif
#ifndef WT_MASK
#define WT_MASK 0
#endif
__device__ __forceinline__ void st16_sel(void* p, u32x4 v, bool wt) { if (wt) asm volatile("global_store_dwordx4 %0, %1, off sc1\n\ts_nop 1" :: "v"(p), "v"(v) : "memory"); else *(u32x4*)p = v; }
#define ATTN_STORE16(p, v) st16_sel((p), (v), (WT_MASK & 4) != 0)
__device__ __forceinline__ void st8_sel(void* p, u32x2 v, bool wt) { if (wt) asm volatile("global_store_dwordx2 %0, %1, off sc1\n\ts_nop 1" :: "v"(p), "v"(v) : "memory"); else *(u32x2*)p = v; }

__device__ __forceinline__ int fresh_lane() { int l; asm volatile("v_mbcnt_lo_u32_b32 %0, -1, 0\n\tv_mbcnt_hi_u32_b32 %0, -1, %0" : "=v"(l)); return l; }

constexpr size_t MiB = 1u << 20;
constexpr size_t WS_CTL = 0, CTL_ZERO_BYTES = 128 * 1024;
constexpr size_t WS_MOD = 1 * MiB;
constexpr size_t WS_ROPE = 1 * MiB + 64 * 1024;
constexpr size_t WS_RTW = 1 * MiB + 128 * 1024;
constexpr size_t WS_EID = 2 * MiB;
constexpr size_t WS_RW = 2 * MiB + 256 * 1024;
constexpr size_t WS_LIST = 3 * MiB;
constexpr size_t WS_WI = 6 * MiB;
constexpr size_t WS_WO = 11 * MiB;
constexpr size_t WS_WGU = 13 * MiB;
constexpr size_t WS_WD = 77 * MiB;
constexpr size_t WS_HX = 109 * MiB;
constexpr size_t WS_MIX = WS_HX, WS_H2 = WS_HX;
constexpr size_t WS_Q = 142 * MiB;
constexpr size_t WS_K = 158 * MiB;
constexpr size_t WS_V = WS_K + 4352 * 1024;
constexpr size_t WS_QR = WS_V + 4352 * 1024;
constexpr size_t WS_KR = WS_QR + 8 * MiB;
constexpr size_t WS_VR = WS_KR + 8448 * 1024;
constexpr size_t WS_GR = WS_VR + 16896 * 1024;
constexpr size_t WS_U = WS_GR + 16 * MiB;
constexpr size_t WS_SP = WS_U + 33280 * 1024;
constexpr size_t WS_C_END = WS_SP + 16 * MiB;
constexpr size_t WS_ACT = 142 * MiB;
constexpr size_t WS_Y = 182 * MiB;
constexpr size_t WS_XNB = 246 * MiB;
constexpr size_t WS_END = WS_XNB + 32 * MiB;
constexpr int CW_TMO = 0, CW_CODE = 1, CW_CNT = 1024  , CW_MODCNT = 2048, CW_R1CNT = 2112, CW_SCANCNT = 2176, CW_BAR = 4096, CW_PANEL = 8192  , CW_TILE = 16384  ;

__device__ __forceinline__ void route_row(int t, int lane, const float* XN, const float* g2, const float* MOD, const float* wgrp, const float* bgrp,
                                          const float* wexp, const float* bexp, bf16* H2, int* EID, float* RW, int* CNT, int* LIST) {
    const f32x4* xr = (const f32x4*)(XN + (size_t)t * DM) + lane;
    f32x4 v[4]; float ss = 0.f;
#pragma unroll
    for (int j = 0; j < 4; ++j) { v[j] = xr[64 * j]; ss += (v[j].x * v[j].x + v[j].y * v[j].y) + (v[j].z * v[j].z + v[j].w * v[j].w); }
    const float rstd = rsqrtf(wave_sum(ss) * (1.f / DM) + EPS);
    float gl[4] = {0.f, 0.f, 0.f, 0.f};
    float h[16];
#pragma unroll
    for (int j = 0; j < 4; ++j) {
        const int n = 4 * lane + 256 * j;
        const f32x4 g = *(const f32x4*)(g2 + n), sh = *(const f32x4*)(MOD + 3072 + n), sc = *(const f32x4*)(MOD + 4096 + n);
#pragma unroll
        for (int i = 0; i < 4; ++i) { const float hv = (v[j][i] * rstd) * g[i] * (1.f + sc[i]) + sh[i]; h[4 * j + i] = hv;
            const f32x4 w = *(const f32x4*)(wgrp + (size_t)(n + i) * 4); gl[0] += hv * w.x; gl[1] += hv * w.y; gl[2] += hv * w.z; gl[3] += hv * w.w; }
        u32x2 o; o.x = pk2(h[4 * j], h[4 * j + 1]); o.y = pk2(h[4 * j + 2], h[4 * j + 3]);
        *(u32x2*)(H2 + (size_t)t * DM + n) = o;
    }
#pragma unroll
    for (int c = 0; c < 4; ++c) gl[c] = wave_sum(gl[c]) + bgrp[c];
    int g = 0; float gm = gl[0];
#pragma unroll
    for (int c = 1; c < 4; ++c) if (gl[c] > gm) { gm = gl[c]; g = c; }
    float gs = 0.f;
#pragma unroll
    for (int c = 0; c < 4; ++c) gs += expf(gl[c] - gm);
    const float pg = 1.f / gs;
    float el[8] = {0.f, 0.f, 0.f, 0.f, 0.f, 0.f, 0.f, 0.f};
#pragma unroll
    for (int j = 0; j < 4; ++j)
#pragma unroll
        for (int i = 0; i < 4; ++i) { const int n = 4 * lane + 256 * j + i; const f32x4 w0 = *(const f32x4*)(wexp + (size_t)n * 32 + g * 8), w1 = *(const f32x4*)(wexp + (size_t)n * 32 + g * 8 + 4);
            const float hv = h[4 * j + i]; el[0] += hv * w0.x; el[1] += hv * w0.y; el[2] += hv * w0.z; el[3] += hv * w0.w; el[4] += hv * w1.x; el[5] += hv * w1.y; el[6] += hv * w1.z; el[7] += hv * w1.w; }
#pragma unroll
    for (int c = 0; c < 8; ++c) el[c] = wave_sum(el[c]) + bexp[g * 8 + c];
    int j1 = 0; float m1 = el[0];
#pragma unroll
    for (int c = 1; c < 8; ++c) if (el[c] > m1) { m1 = el[c]; j1 = c; }
    int j2 = -1; float m2 = -INFINITY;
#pragma unroll
    for (int c = 0; c < 8; ++c) if (c != j1 && el[c] > m2) { m2 = el[c]; j2 = c; }
    const float e2 = expf(m2 - m1), w1 = pg / (1.f + e2), w2 = pg * e2 / (1.f + e2);
    if (lane == 0) {
        const int ea = g * 8 + j1, eb = g * 8 + j2;
        EID[2 * t] = ea; EID[2 * t + 1] = eb; RW[2 * t] = w1; RW[2 * t + 1] = w2;
        const int sa = atomicAdd(CNT + ea, 1); LIST[ea * SEQ + sa] = 2 * t;
        const int sb = atomicAdd(CNT + eb, 1); LIST[eb * SEQ + sb] = 2 * t + 1;
    }
}
template <int NB> __device__ __forceinline__ void final_rows(const int (&rows)[NB], int lane, const bf16* XN, const bf16* Y, const float* RW, const float* MOD, const float* gfin, float* out) {
    f32x4 xv[NB][4]; u32x2 ya[NB][4], yb[NB][4]; float w0[NB], w1[NB];
#pragma unroll
    for (int b = 0; b < NB; ++b) { const int t = rows[b]; w0[b] = RW[2 * t]; w1[b] = RW[2 * t + 1];
#pragma unroll
        for (int j = 0; j < 4; ++j) { const int n = 4 * lane + 256 * j; { const u32x2 xw = NT_LD((const u32x2*)(XN + (size_t)t * DM + n)); xv[b][j] = (f32x4){__uint_as_float(xw.x << 16), __uint_as_float(xw.x & 0xffff0000u), __uint_as_float(xw.y << 16), __uint_as_float(xw.y & 0xffff0000u)}; }
            ya[b][j] = NT_LD((const u32x2*)(Y + (size_t)t * DM + n)); yb[b][j] = NT_LD((const u32x2*)(Y + ((size_t)SEQ + t) * DM + n)); } }
#pragma unroll
    for (int b = 0; b < NB; ++b) { const int t = rows[b]; f32x4 v[4]; float ss = 0.f;
#pragma unroll
        for (int j = 0; j < 4; ++j) { const int n = 4 * lane + 256 * j; const f32x4 gt = *(const f32x4*)(MOD + 5120 + n); const u32x2 a = ya[b][j], c = yb[b][j];
            const float fa[4] = {__uint_as_float(a.x << 16), __uint_as_float(a.x & 0xffff0000u), __uint_as_float(a.y << 16), __uint_as_float(a.y & 0xffff0000u)};
            const float fb[4] = {__uint_as_float(c.x << 16), __uint_as_float(c.x & 0xffff0000u), __uint_as_float(c.y << 16), __uint_as_float(c.y & 0xffff0000u)};
#pragma unroll
            for (int i = 0; i < 4; ++i) { v[j][i] = xv[b][j][i] + gt[i] * (fa[i] * w0[b] + fb[i] * w1[b]); ss += v[j][i] * v[j][i]; } }
        const float rstd = rsqrtf(wave_sum(ss) * (1.f / DM) + EPS);
#pragma unroll
        for (int j = 0; j < 4; ++j) { const int n = 4 * lane + 256 * j; const f32x4 g = *(const f32x4*)(gfin + n);
            f32x4 o; o.x = v[j].x * rstd * g.x; o.y = v[j].y * rstd * g.y; o.z = v[j].z * rstd * g.z; o.w = v[j].w * rstd * g.w;
            NT_ST(o, (f32x4*)(out + (size_t)t * DM + n)); } }
}
__device__ __forceinline__ void final_row(int t, int lane, const bf16* XN, const bf16* Y, const float* RW, const float* MOD, const float* gfin, float* out) {
    const int rows[1] = {t}; final_rows<1>(rows, lane, XN, Y, RW, MOD, gfin, out);
}
#ifdef WITH_NAIVE
__global__ void k_route(const float* XN, const float* g2, const float* MOD, const float* wgrp, const float* bgrp, const float* wexp, const float* bexp,
                        bf16* H2, int* EID, float* RW, int* CNT, int* LIST) {
    const int t = blockIdx.x * 4 + (threadIdx.x >> 6);
    route_row(t, threadIdx.x & 63, XN, g2, MOD, wgrp, bgrp, wexp, bexp, H2, EID, RW, CNT, LIST);
}
__global__ void k_final(const float* XN, const bf16* Y, const float* RW, const float* MOD, const float* gfin, float* out) {
    const int t = blockIdx.x * 4 + (threadIdx.x >> 6);
    final_row(t, threadIdx.x & 63, XN, Y, RW, MOD, gfin, out);
}

#endif
#define GAS __attribute__((address_space(1)))
#define LAS __attribute__((address_space(3)))
typedef unsigned v4u __attribute__((ext_vector_type(4)));
typedef short bf16x8 __attribute__((ext_vector_type(8)));
typedef GAS unsigned gu32;
typedef GAS unsigned long long gu64;
#define RLX_AGENT __ATOMIC_RELAXED, __HIP_MEMORY_SCOPE_AGENT
#define LDS_WAIT() asm volatile("s_waitcnt lgkmcnt(0)" ::: "memory")
#define VM_WAIT() asm volatile("s_waitcnt vmcnt(0)" ::: "memory")
__device__ __forceinline__ unsigned long long rt() { return __builtin_amdgcn_s_memrealtime(); }

#define XB_TMO      128
#define XB_XCNT(j)  (256  + 64 * (j))
#define XB_XSUB(j)  (1280 + 64 * (j))
#define XB_XGEN(j)  (2304 + 64 * (j))
#define XB_TOP      3328
#define XB_TOPGEN   3392
#define XCD_BAR_WORDS 3456
#define XB_SPIN_CAP (1u << 18)

__device__ __forceinline__ unsigned xb_ld(unsigned* p)              { return __hip_atomic_load(p, __ATOMIC_RELAXED, __HIP_MEMORY_SCOPE_AGENT); }
__device__ __forceinline__ unsigned xb_add(unsigned* p, unsigned v) { return __hip_atomic_fetch_add(p, v, __ATOMIC_RELAXED, __HIP_MEMORY_SCOPE_AGENT); }
__device__ __forceinline__ unsigned xb_xcc_id() { return (unsigned)__builtin_amdgcn_s_getreg((3 << 11) | 20) & 0xFu; }
#define XB_SPIN(cond, bar) do { unsigned _sp = 0; while (cond) { __builtin_amdgcn_s_sleep(1); \
    if ((++_sp & 255u) == 0u) { if (xb_ld(&(bar)[XB_TMO])) break; if (_sp > XB_SPIN_CAP) { atomicAdd(&(bar)[XB_TMO], 1u); break; } } } } while (0)

struct XcdBarrier {
    unsigned* bar; unsigned x;
    volatile LAS unsigned* st;
};

__device__ __forceinline__ XcdBarrier xcd_barrier_post(unsigned* bar, volatile LAS unsigned* st) {
    XcdBarrier b; b.bar = bar; b.x = xb_xcc_id(); b.st = st;
    if (threadIdx.x == 0) (void)xb_add(&bar[XB_XCNT(b.x)], 1u);
    return b;
}
__device__ __forceinline__ void xcd_barrier_complete(unsigned* bar, unsigned x, unsigned& nloc, unsigned& nx) {
    const unsigned G = gridDim.x * gridDim.y * gridDim.z;
    unsigned sum, cnt, mine, sp = 0u;
    for (;;) {
        sum = 0u; cnt = 0u; mine = 0u;
#pragma unroll
        for (unsigned j = 0; j < 16; ++j) { const unsigned c = xb_ld(&bar[XB_XCNT(j)]); sum += c; cnt += (c > 0u) ? 1u : 0u; mine = (j == x) ? c : mine; }
        if (sum == G) break;
        __builtin_amdgcn_s_sleep(1);
        if ((++sp & 255u) == 0u) { if (xb_ld(&bar[XB_TMO])) break; if (sp > XB_SPIN_CAP) { atomicAdd(&bar[XB_TMO], 1u); break; } }
    }
    nloc = mine > 0u ? mine : 1u; nx = cnt > 0u ? cnt : 1u;
}

__device__ __forceinline__ void xcd_barrier(const XcdBarrier& b, const bool leader_thread) {
    asm volatile("s_waitcnt vmcnt(0)" ::: "memory");
    __syncthreads();
    if (leader_thread) {
        unsigned* bar = b.bar;
        __builtin_amdgcn_s_waitcnt(0);
        unsigned nloc = b.st[0], nx = b.st[1];
        if (nloc == 0u) { xcd_barrier_complete(bar, b.x, nloc, nx); b.st[0] = nloc; b.st[1] = nx; }
        const unsigned old = xb_add(&bar[XB_XSUB(b.x)], 1u);
        const unsigned gen = old / nloc;
        if (old + 1u == (gen + 1u) * nloc) {
            __builtin_amdgcn_fence(__ATOMIC_RELEASE, "agent");
            asm volatile("s_waitcnt vmcnt(0)" ::: "memory");
            const unsigned og = xb_add(&bar[XB_TOP], 1u);
            const unsigned tg = og / nx;
            if (og + 1u == (tg + 1u) * nx) xb_add(&bar[XB_TOPGEN], 1u);
            else XB_SPIN(xb_ld(&bar[XB_TOPGEN]) == tg, bar);
            __builtin_amdgcn_fence(__ATOMIC_ACQUIRE, "agent");
            xb_add(&bar[XB_XGEN(b.x)], 1u);
            asm volatile("s_waitcnt vmcnt(0)" ::: "memory");
        } else {
            XB_SPIN(xb_ld(&bar[XB_XGEN(b.x)]) == gen, bar);
            __builtin_amdgcn_fence(__ATOMIC_ACQUIRE, "agent");
            asm volatile("s_waitcnt vmcnt(0)" ::: "memory");
        }
    }
    __syncthreads();
}
namespace pg8 {
#define PG8_LAS __attribute__((address_space(3)))
typedef unsigned short bf16_t;
typedef short bf16x8 __attribute__((ext_vector_type(8)));
typedef float f32x4 __attribute__((ext_vector_type(4)));
typedef unsigned u32x4 __attribute__((ext_vector_type(4)));
constexpr int BM = 256, BK = 64, HALF = 128, HTB = HALF * BK * 2  , STAGE_BYTES = 8 * HTB, NXCD = 8, WGM = 8;

__host__ __device__ __forceinline__ int lds_byte(int r, int c) { const int st = (r >> 4) * 2 + (c >> 5), rr = r & 15, cc = c & 31, ob = rr * 64 + cc * 2; return st * 1024 + (ob ^ (((ob >> 9) & 1) << 5)); }
__host__ __device__ __forceinline__ void stage_rc(int b, int& R, int& C) { const int st = b / 1024, sb = b % 1024, swz = sb ^ (((sb >> 9) & 1) << 5); R = (st >> 1) * 16 + swz / 64; C = (st & 1) * 32 + (swz % 64) / 2; }
__host__ __device__ __forceinline__ int perm32(int rho) { const int n = rho >> 4, i = rho & 15; return 8 * (i >> 2) + 4 * n + (i & 3); }

struct Unit { int pm, pn; };
struct Gemm { const bf16_t* A; const bf16_t* Bt; int M, N, K; };

struct StaticOrder {
    int nM, nN, nwg, G, c;
    __host__ __device__ void init(int M, int N, int G_, int c_) { nM = M / BM; nN = N / BM; nwg = nM * nN; G = G_; c = c_; }
    __host__ __device__ bool next(int i, Unit& u) const {
        const long L = (long)i * G + c; if (L >= nwg) return false;
        int wgid = (int)L; { const int q = nwg / NXCD, r = nwg % NXCD, xcd = wgid % NXCD, off = wgid / NXCD; wgid = (xcd < r ? xcd * (q + 1) : r * (q + 1) + (xcd - r) * q) + off; }
        const int nig = WGM * nN, gid = wgid / nig, fm = gid * WGM, gsz = (nM - fm) < WGM ? (nM - fm) : WGM;
        u.pm = fm + ((wgid % nig) % gsz); u.pn = (wgid % nig) / gsz; return true;
    }
    __device__ __forceinline__ void a_ready(const Unit&) const {}
    __device__ __forceinline__ void done(const Unit&) const {}
};

__device__ __forceinline__ unsigned cvt_pk_bf16(float lo, float hi) { unsigned r; asm volatile("v_cvt_pk_bf16_f32 %0, %1, %2" : "=v"(r) : "v"(lo), "v"(hi)); return r; }
typedef float f32x2 __attribute__((ext_vector_type(2)));
template <class Epi, class Sched, class AMap, bool ALIGN_EPI = false, bool SP2 = false>
__device__ __forceinline__ void gemm_phase(PG8_LAS unsigned char* lds, const Gemm g, const Sched& S, const Epi& E, const AMap& AM, const int tid) {
    const int wid = __builtin_amdgcn_readfirstlane(tid >> 6), lane = tid & 63, wr = wid >> 2, wc = wid & 3, fr = lane & 15, fq = lane >> 4;
    const int K = g.K, nt = K / BK;
    unsigned voffB[2]; int stR[2], stC[2];
#pragma unroll
    for (int i = 0; i < 2; ++i) { int R, C; stage_rc(tid * 16 + i * 8192, R, C); const int Rb = Epi::PERM ? ((R & ~31) + perm32(R & 31)) : R;
        stR[i] = R; stC[i] = C; voffB[i] = (unsigned)(Rb * K + C) * 2u; }
    unsigned vAc[2][2], vAn[2][2]; int rN[2][2], rNN[2][2];
#define PG8_AOFF(dst, un) do { _Pragma("unroll") for (int _h = 0; _h < 2; ++_h) _Pragma("unroll") for (int _i = 0; _i < 2; ++_i) \
        dst[_h][_i] = (unsigned)AM.row(un, _h * HALF + stR[_i]) * (unsigned)(K * 2) + (unsigned)(stC[_i] * 2); } while (0)
#define PG8_AROW(dst, un) do { _Pragma("unroll") for (int _h = 0; _h < 2; ++_h) _Pragma("unroll") for (int _i = 0; _i < 2; ++_i) dst[_h][_i] = AM.raw(un, _h * HALF + stR[_i]); } while (0)
#define PG8_AOFFR(dst, raw) do { _Pragma("unroll") for (int _h = 0; _h < 2; ++_h) _Pragma("unroll") for (int _i = 0; _i < 2; ++_i) \
        dst[_h][_i] = (unsigned)AM.fix(raw[_h][_i]) * (unsigned)(K * 2) + (unsigned)(stC[_i] * 2); } while (0)
    const size_t kstep = (size_t)(BK * 2);
    const size_t hstep = (size_t)HALF * K * 2;
    const size_t tstep = 2 * hstep;
    const unsigned ldsw = (unsigned)wid * 1024u;
    const int aoff = lds_byte(wr * 64 + fr, fq * 8), boff = lds_byte(wc * 32 + fr, fq * 8);
#define PG8_SA(b, h) (((b) * 2 + (h)) * HTB)
#define PG8_SB(b, h) ((4 + (b) * 2 + (h)) * HTB)
#define PG8_STAGE(bufoff, gbase, voff) do { _Pragma("unroll") for (int _i = 0; _i < 2; ++_i) \
        __builtin_amdgcn_global_load_lds((const unsigned*)((const char*)(gbase) + (voff)[_i]), (PG8_LAS unsigned*)(lds + (bufoff) + ldsw + _i * 8192), 16, 0, 0); } while (0)
#define PG8_STAGEA(bufoff, koff, vo) do { _Pragma("unroll") for (int _i = 0; _i < 2; ++_i) \
        __builtin_amdgcn_global_load_lds((const unsigned*)((const char*)g.A + (koff) + (vo)[_i]), (PG8_LAS unsigned*)(lds + (bufoff) + ldsw + _i * 8192), 16, 0, 0); } while (0)
#define PG8_LDA(dst, b, h) do { _Pragma("unroll") for (int m = 0; m < 4; ++m) _Pragma("unroll") for (int k = 0; k < 2; ++k) dst[m][k] = *(const PG8_LAS bf16x8*)(lds + PG8_SA(b, h) + aoff + m * 2048 + k * 1024); } while (0)
#define PG8_LDB(dst, b, h) do { _Pragma("unroll") for (int n = 0; n < 2; ++n) _Pragma("unroll") for (int k = 0; k < 2; ++k) dst[n][k] = *(const PG8_LAS bf16x8*)(lds + PG8_SB(b, h) + boff + n * 2048 + k * 1024); } while (0)
#define PG8_MMA(ai, bj, At, Bt) do { __builtin_amdgcn_s_setprio(1); _Pragma("unroll") for (int m = 0; m < 4; ++m) _Pragma("unroll") for (int n = 0; n < 2; ++n) _Pragma("unroll") for (int k = 0; k < 2; ++k) \
        acc[ai][bj][m][n] = __builtin_amdgcn_mfma_f32_16x16x32_bf16(Bt[n][k], At[m][k], acc[ai][bj][m][n], 0, 0, 0); __builtin_amdgcn_s_setprio(0); } while (0)
#define PG8_WAIT_V(n) asm volatile("s_waitcnt vmcnt(" #n ")" ::: "memory")
#define PG8_WAIT_L(n) asm volatile("s_waitcnt lgkmcnt(" #n ")" ::: "memory")
#define PG8_BAR __builtin_amdgcn_s_barrier()
#define PG8_SCHED __builtin_amdgcn_sched_barrier(0)
    Unit cur, nxt, nn; int ui = 0;
    if (!S.next(0, cur)) return;
    f32x4 acc[2][2][4][2];
#pragma unroll
    for (int a = 0; a < 2; ++a)
#pragma unroll
        for (int b = 0; b < 2; ++b)
#pragma unroll
            for (int m = 0; m < 4; ++m)
#pragma unroll
                for (int n = 0; n < 2; ++n) acc[a][b][m][n] = (f32x4){0.f, 0.f, 0.f, 0.f};
    bf16x8 At[4][2], B0[2][2], B1[2][2];
    const char* cB = (const char*)g.Bt + (size_t)cur.pn * tstep;
    S.a_ready(cur);
    PG8_AOFF(vAc, cur);
    bool has_next = S.next(1, nxt);
    if (has_next) PG8_AROW(rN, nxt);
    if constexpr (SP2) {
        PG8_STAGE(PG8_SB(0, 0), cB, voffB); PG8_STAGE(PG8_SB(0, 1), cB + hstep, voffB); PG8_STAGEA(PG8_SA(0, 0), 0, vAc[0]); PG8_STAGEA(PG8_SA(0, 1), 0, vAc[1]);
        if (wr == 1) PG8_BAR;
        PG8_WAIT_V(2); PG8_BAR;
        PG8_STAGE(PG8_SB(1, 0), cB + kstep, voffB); PG8_STAGEA(PG8_SA(1, 0), kstep, vAc[0]); PG8_STAGE(PG8_SB(1, 1), cB + hstep + kstep, voffB);
        PG8_WAIT_V(6); PG8_BAR;
    } else {
        PG8_STAGE(PG8_SB(0, 0), cB, voffB); PG8_STAGEA(PG8_SA(0, 0), 0, vAc[0]); PG8_STAGE(PG8_SB(0, 1), cB + hstep, voffB); PG8_STAGEA(PG8_SA(0, 1), 0, vAc[1]);
        if (wr == 1) PG8_BAR;
        PG8_WAIT_V(4); PG8_BAR;
        PG8_STAGE(PG8_SB(1, 0), cB + kstep, voffB); PG8_STAGEA(PG8_SA(1, 0), kstep, vAc[0]); PG8_STAGE(PG8_SB(1, 1), cB + hstep + kstep, voffB);
        PG8_WAIT_V(6); PG8_BAR;
    }
    for (;;) {
        const bool has_nn = has_next && S.next(ui + 2, nn);
        if (has_nn) PG8_AROW(rNN, nn);
        const char* nB = has_next ? (const char*)g.Bt + (size_t)nxt.pn * tstep : cB;
        if (has_next) { PG8_AOFFR(vAn, rN); } else { _Pragma("unroll") for (int _h = 0; _h < 2; ++_h) _Pragma("unroll") for (int _i = 0; _i < 2; ++_i) vAn[_h][_i] = vAc[_h][_i]; }
        for (int t = 0; t < nt; t += 2) {
            const bool last = (t == nt - 2);
            const size_t a1 = (size_t)(t + 1) * kstep;
            const size_t a2 = last ? (size_t)0 : (size_t)(t + 2) * kstep; const char* b2 = last ? nB : cB + (size_t)(t + 2) * kstep;
            const size_t a3 = a2 + kstep; const char* b3 = b2 + kstep;
#define PG8_SWAPA() do { if (last) { _Pragma("unroll") for (int _h = 0; _h < 2; ++_h) _Pragma("unroll") for (int _i = 0; _i < 2; ++_i) vAc[_h][_i] = vAn[_h][_i]; } } while (0)
            if (last && has_next) S.a_ready(nxt);
            if constexpr (SP2) {
            PG8_LDB(B0, 0, 0); PG8_LDB(B1, 0, 1); PG8_SCHED; PG8_LDA(At, 0, 0); PG8_STAGEA(PG8_SA(1, 1), a1, vAc[1]); PG8_SWAPA();
            PG8_WAIT_V(8); PG8_WAIT_L(0); PG8_BAR; PG8_MMA(0, 0, At, B0); PG8_MMA(0, 1, At, B1); PG8_BAR; PG8_SCHED;
            PG8_LDA(At, 0, 1); PG8_STAGE(PG8_SB(0, 0), b2, voffB); PG8_STAGE(PG8_SB(0, 1), b2 + hstep, voffB); PG8_STAGEA(PG8_SA(0, 0), a2, vAc[0]);
            PG8_WAIT_V(8); PG8_WAIT_L(0); PG8_BAR; PG8_MMA(1, 0, At, B0); PG8_MMA(1, 1, At, B1); PG8_BAR; PG8_SCHED;
            PG8_LDB(B0, 1, 0); PG8_LDB(B1, 1, 1); PG8_SCHED; PG8_LDA(At, 1, 0); PG8_STAGEA(PG8_SA(0, 1), a2, vAc[1]);
            PG8_WAIT_V(8); PG8_WAIT_L(0); PG8_BAR; PG8_MMA(0, 0, At, B0); PG8_MMA(0, 1, At, B1); PG8_BAR; PG8_SCHED;
            PG8_LDA(At, 1, 1); PG8_STAGE(PG8_SB(1, 0), b3, voffB); PG8_STAGE(PG8_SB(1, 1), b3 + hstep, voffB); PG8_STAGEA(PG8_SA(1, 0), a3, vAc[0]);
            PG8_WAIT_V(8); PG8_WAIT_L(0); PG8_BAR; PG8_MMA(1, 0, At, B0); PG8_MMA(1, 1, At, B1); PG8_BAR; PG8_SCHED;
            } else {
            PG8_LDB(B0, 0, 0); PG8_SCHED; PG8_LDA(At, 0, 0); PG8_STAGEA(PG8_SA(1, 1), a1, vAc[1]); PG8_SWAPA();
            PG8_WAIT_L(8); PG8_BAR; PG8_WAIT_L(0); PG8_MMA(0, 0, At, B0); PG8_BAR; PG8_SCHED;
            PG8_LDB(B1, 0, 1); PG8_STAGE(PG8_SB(0, 0), b2, voffB);
            PG8_BAR; PG8_WAIT_L(0); PG8_MMA(0, 1, At, B1); PG8_BAR;
            PG8_LDA(At, 0, 1); PG8_STAGEA(PG8_SA(0, 0), a2, vAc[0]);
            PG8_BAR; PG8_WAIT_L(0); PG8_MMA(1, 0, At, B0); PG8_BAR; PG8_SCHED;
            PG8_STAGE(PG8_SB(0, 1), b2 + hstep, voffB);
            PG8_WAIT_V(6); PG8_BAR; PG8_MMA(1, 1, At, B1); PG8_BAR;
            PG8_LDB(B0, 1, 0); PG8_SCHED; PG8_LDA(At, 1, 0); PG8_STAGEA(PG8_SA(0, 1), a2, vAc[1]);
            PG8_WAIT_L(8); PG8_BAR; PG8_WAIT_L(0); PG8_MMA(0, 0, At, B0); PG8_BAR; PG8_SCHED;
            PG8_LDB(B1, 1, 1); PG8_STAGE(PG8_SB(1, 0), b3, voffB);
            PG8_BAR; PG8_WAIT_L(0); PG8_MMA(0, 1, At, B1); PG8_BAR;
            PG8_LDA(At, 1, 1); PG8_STAGEA(PG8_SA(1, 0), a3, vAc[0]);
            PG8_BAR; PG8_WAIT_L(0); PG8_MMA(1, 0, At, B0); PG8_BAR; PG8_SCHED;
            PG8_STAGE(PG8_SB(1, 1), b3 + hstep, voffB);
            PG8_WAIT_V(6); PG8_BAR; PG8_MMA(1, 1, At, B1); PG8_BAR;
            }
        }
        if constexpr (ALIGN_EPI) { if (wr == 0) PG8_BAR; }
        if constexpr (!Epi::AFTER_DRAIN) { E(acc, cur, wr, wc, fr, fq); S.done(cur); }
        if (!has_next) break;
#pragma unroll
        for (int a = 0; a < 2; ++a)
#pragma unroll
            for (int b = 0; b < 2; ++b)
#pragma unroll
                for (int m = 0; m < 4; ++m)
#pragma unroll
                    for (int n = 0; n < 2; ++n) acc[a][b][m][n] = (f32x4){0.f, 0.f, 0.f, 0.f};
        cur = nxt; nxt = nn; has_next = has_nn; cB = nB; ++ui;
        _Pragma("unroll") for (int _h = 0; _h < 2; ++_h) _Pragma("unroll") for (int _i = 0; _i < 2; ++_i) rN[_h][_i] = rNN[_h][_i];
        if constexpr (ALIGN_EPI) { if (wr == 1) PG8_BAR; }
    }
    PG8_WAIT_V(0);
    if constexpr (!ALIGN_EPI) { if (wr == 0) PG8_BAR; }
    PG8_BAR;
    if constexpr (Epi::AFTER_DRAIN) { E.fused(acc, cur, wr, wc, fr, fq, lds, wid, lane); S.done(cur); }
#undef PG8_SA
#undef PG8_SB
#undef PG8_STAGE
#undef PG8_STAGEA
#undef PG8_AOFF
#undef PG8_AROW
#undef PG8_AOFFR
#undef PG8_SWAPA
#undef PG8_LDA
#undef PG8_LDB
#undef PG8_MMA
#undef PG8_WAIT_V
#undef PG8_WAIT_L
#undef PG8_BAR
#undef PG8_SCHED
}
}
namespace attn_body {
using bf16=unsigned short;
using bf16x8=__attribute__((ext_vector_type(8)))short;
using s16x4=__attribute__((ext_vector_type(4)))short;
using f32x16=__attribute__((ext_vector_type(16)))float;
using u32x4=__attribute__((ext_vector_type(4)))unsigned;
constexpr int D=64,QP=512,KVP=64,OP=1024,NKEYS=16640;
constexpr int NW=8,QBLK=32,QB=QBLK*NW,KVBLK=64;
constexpr int ATTN_UNIT_ROWS=QB;
__device__ __forceinline__ int crow(int r,int hi){return (r&3)+8*(r>>2)+4*hi;}
#define SBAR() __builtin_amdgcn_sched_barrier(0)
constexpr int NSLOT=3, SLOTB=8192;
constexpr int LDS_K=0, LDS_V=NSLOT*SLOTB, LDS_WS=2*NSLOT*SLOTB, LDS_OST=LDS_WS+NW*64*4, LDS_BYTES=LDS_OST+NW*4096;
constexpr float C2=0.125f*1.4426950408889634f;
__device__ __forceinline__ void glds16(const void*gsrc,unsigned lds_dst){unsigned keep;
  asm volatile("s_mov_b32 %0, m0\n\ts_mov_b32 m0, %2\n\ts_nop 0\n\tglobal_load_lds_dwordx4 %1, off\n\ts_mov_b32 m0, %0":"=&s"(keep):"v"(gsrc),"s"(lds_dst):"memory");}
__device__ __forceinline__ float max3f(float a,float b,float c){float r;asm("v_max3_f32 %0, %1, %2, %3":"=v"(r):"v"(a),"v"(b),"v"(c));return r;}
__device__ __forceinline__ float max2f(float a,float b){float r;asm("v_max_f32_e32 %0, %1, %2":"=v"(r):"v"(a),"v"(b));return r;}
__device__ __forceinline__ float fadd_s(float a,float b){float r;asm("v_add_f32_e32 %0, %1, %2":"=v"(r):"v"(a),"v"(b));return r;}
__device__ __forceinline__ float fsub_s(float a,float b){float r;asm("v_sub_f32_e32 %0, %1, %2":"=v"(r):"v"(a),"v"(b));return r;}
typedef float f32x2_t __attribute__((ext_vector_type(2))); typedef __bf16 bf16x2_t __attribute__((ext_vector_type(2)));
__device__ __forceinline__ unsigned cvtpk_s(float lo,float hi){f32x2_t v={lo,hi};bf16x2_t b=__builtin_convertvector(v,bf16x2_t);return __builtin_bit_cast(unsigned,b);}
#define WAIT_BAR(N) asm volatile("s_waitcnt vmcnt(" #N ") lgkmcnt(0)\n\ts_barrier":::"memory")

__device__ __forceinline__ void qkt(f32x16&p0,f32x16&p1,const char*Kslot,const bf16x8*qr,const f32x16&negm,int r32,int hi){
  const char*kb=Kslot+hi*1024+r32*16;
  #pragma unroll
  for(int d0=0;d0<4;++d0){
    const bf16x8 b0=*reinterpret_cast<const bf16x8*>(kb+d0*2048);
    const bf16x8 b1=*reinterpret_cast<const bf16x8*>(kb+d0*2048+512);
    if(d0==0){p0=__builtin_amdgcn_mfma_f32_32x32x16_bf16(b0,qr[0],negm,0,0,0);p1=__builtin_amdgcn_mfma_f32_32x32x16_bf16(b1,qr[0],negm,0,0,0);}
    else{p0=__builtin_amdgcn_mfma_f32_32x32x16_bf16(b0,qr[d0],p0,0,0,0);p1=__builtin_amdgcn_mfma_f32_32x32x16_bf16(b1,qr[d0],p1,0,0,0);}}
}
typedef __attribute__((address_space(3))) const char* lds_cptr;
typedef short v4i16_t __attribute__((ext_vector_type(4)));
__device__ __forceinline__ void kload8(bf16x8*kf,lds_cptr kp){
  kf[0]=*(const __attribute__((address_space(3))) bf16x8*)(kp);      kf[1]=*(const __attribute__((address_space(3))) bf16x8*)(kp+512);
  kf[2]=*(const __attribute__((address_space(3))) bf16x8*)(kp+2048); kf[3]=*(const __attribute__((address_space(3))) bf16x8*)(kp+2560);
  kf[4]=*(const __attribute__((address_space(3))) bf16x8*)(kp+4096); kf[5]=*(const __attribute__((address_space(3))) bf16x8*)(kp+4608);
  kf[6]=*(const __attribute__((address_space(3))) bf16x8*)(kp+6144); kf[7]=*(const __attribute__((address_space(3))) bf16x8*)(kp+6656);
}
__device__ __forceinline__ void kload2(bf16x8*kf,lds_cptr kp,int j){ kf[2*j]=*(const __attribute__((address_space(3))) bf16x8*)(kp+j*2048); kf[2*j+1]=*(const __attribute__((address_space(3))) bf16x8*)(kp+j*2048+512); }
__device__ __forceinline__ s16x4 vtr(lds_cptr p){ return __builtin_bit_cast(s16x4,__builtin_amdgcn_ds_read_tr16_b64_v4i16((__attribute__((address_space(3))) v4i16_t*)p)); }
__device__ __forceinline__ float rowmax(const f32x16&p0,const f32x16&p1){
  float a=max3f(p0[0],p0[1],p1[0]),b=max3f(p0[2],p0[3],p1[1]);a=max3f(a,p1[2],p1[3]);
  #pragma unroll
  for(int r=4;r<16;r+=4){a=max3f(a,p0[r],p0[r+1]);b=max3f(b,p0[r+2],p0[r+3]);a=max3f(a,p1[r],p1[r+1]);b=max3f(b,p1[r+2],p1[r+3]);}
  const float m=max2f(a,b);
  auto rr=__builtin_amdgcn_permlane32_swap(__float_as_uint(m),__float_as_uint(m),false,false);
  return max2f(__uint_as_float(rr[0]),__uint_as_float(rr[1]));
}
__device__ __forceinline__ void pv(f32x16*o,int vb,bf16x8 pa0,bf16x8 pa1,bf16x8 pa2,bf16x8 pa3){
  #pragma unroll
  for(int d0=0;d0<2;++d0){s16x4 lo[4],hi[4];
    #pragma unroll
    for(int ks=0;ks<4;++ks){
      asm volatile("ds_read_b64_tr_b16 %0,%1 offset:%c2":"=&v"(lo[ks]):"v"(vb),"i"(d0*4096+ks*1024):"memory");
      asm volatile("ds_read_b64_tr_b16 %0,%1 offset:%c2":"=&v"(hi[ks]):"v"(vb),"i"(d0*4096+ks*1024+512):"memory");}
    asm volatile("s_waitcnt lgkmcnt(0)":::"memory");SBAR();
    #define PK(k) (bf16x8){lo[k][0],lo[k][1],lo[k][2],lo[k][3],hi[k][0],hi[k][1],hi[k][2],hi[k][3]}
    o[d0]=__builtin_amdgcn_mfma_f32_32x32x16_bf16(pa0,PK(0),o[d0],0,0,0);
    o[d0]=__builtin_amdgcn_mfma_f32_32x32x16_bf16(pa1,PK(1),o[d0],0,0,0);
    o[d0]=__builtin_amdgcn_mfma_f32_32x32x16_bf16(pa2,PK(2),o[d0],0,0,0);
    o[d0]=__builtin_amdgcn_mfma_f32_32x32x16_bf16(pa3,PK(3),o[d0],0,0,0);
    #undef PK
  }
}

#ifndef ATTN_STORE16
#define ATTN_STORE16(p,v) (*(u32x4*)(p)=(v))
#endif
template<int THRL> __device__ __forceinline__ void attn_unit(int h,int qb,const bf16*Q,const bf16*__restrict__ K,const bf16*__restrict__ V,bf16*O,char*shm,const int tid){
  const int lane=tid&63,r32=lane&31,hi=lane>>5; const int wid=__builtin_amdgcn_readfirstlane(tid>>6);
  const int q0=qb*QB;
  const bf16*Qw=Q+(long)(q0+wid*QBLK)*QP+h*D;
  const bf16*Kh=K+(long)(h>>2)*NKEYS*KVP,*Vh=V+(long)(h>>2)*NKEYS*KVP;
  const unsigned lds0=(unsigned)(uintptr_t)shm;
  float*wsf=(float*)(shm+LDS_WS)+wid*64;
  const bf16*ksrc=Kh+(long)lane*KVP+wid*8;
  const bf16*vsrc=Vh+(long)(16*(wid&3)+(lane>>2))*KVP+(wid>>2)*32+(lane&3)*8;
  const unsigned kdst=lds0+LDS_K+wid*1024, vdst=lds0+LDS_V+wid*1024;
  #define DMA_K(t,slot) glds16(ksrc+(long)(t)*KVBLK*KVP,(unsigned)__builtin_amdgcn_readfirstlane(kdst+(slot)))
  #define DMA_V(t,slot) glds16(vsrc+(long)(t)*KVBLK*KVP,(unsigned)__builtin_amdgcn_readfirstlane(vdst+(slot)))
  const int vb0=(int)(lds0+LDS_V)+((lane>>4)&1)*32+(lane&3)*8+(4*hi+((lane&15)>>2))*64;
  const char*Kbase=shm+LDS_K; bf16x8 kf[8];
  const lds_cptr shm3=(lds_cptr)shm; const lds_cptr kp0=shm3+LDS_K+hi*1024+r32*16; const lds_cptr vp0=shm3+LDS_V+((lane>>4)&1)*32+(lane&3)*8+(4*hi+((lane&15)>>2))*64;
  constexpr int NT=NKEYS/KVBLK;
  DMA_K(0,0);DMA_V(0,0);DMA_K(1,SLOTB);
  bf16x8 qr[4];
  #pragma unroll
  for(int d0=0;d0<4;++d0)qr[d0]=*reinterpret_cast<const bf16x8*>(&Qw[(long)r32*QP+d0*16+hi*8]);
  float l_reg=0.f;f32x16 o[2];o[0]=f32x16{};o[1]=f32x16{};const f32x16 negm=f32x16{};
  #define CMASK(P0,P1,t) do{}while(0)
  #define START(P0,P1) do{ _Pragma("unroll") for(int r=0;r<16;++r)P0[r]=__builtin_amdgcn_exp2f(P0[r]); }while(0)
  #define RESC() do{}while(0)
  f32x16 pA0,pA1,pB0,pB1;
  int sl_prev=0,sl_cur=0,sl_next=SLOTB;
  #define ROT() do{sl_prev=sl_cur;sl_cur=sl_next;sl_next=(sl_next==(NSLOT-1)*SLOTB)?0:sl_next+SLOTB;}while(0)
  DMA_K(2,2*SLOTB);
  WAIT_BAR(3);
  qkt(pA0,pA1,Kbase,qr,negm,r32,hi);asm volatile("s_nop 15\n\ts_nop 7":"+v"(pA0),"+v"(pA1));CMASK(pA0,pA1,0);
  START(pA0,pA1);
  _Pragma("unroll") for(int r=0;r<16;++r)pA1[r]=__builtin_amdgcn_exp2f(pA1[r]);
  WAIT_BAR(0);
  DMA_K(3,0);DMA_V(1,SLOTB);
  ROT();
  kload8(kf,kp0+sl_cur);
  WAIT_BAR(2);
  s16x4 vlo[8],vhi[8]; u32x4 pw0,pw1,pw2,pw3;
  #define PKW(P,B) cvtpk_s(P[B],P[B+1])
  #define PAF(k) __builtin_bit_cast(bf16x8,pw##k)
  #define VFR(i) (bf16x8){vlo[i][0],vlo[i][1],vlo[i][2],vlo[i][3],vhi[i][0],vhi[i][1],vhi[i][2],vhi[i][3]}
  #define PIN(x) asm volatile("":"+v"(x))
  #define MX3(a,b,c) __builtin_fmaxf(__builtin_fmaxf((a),(b)),(c))
  #define GAPA(MF,A0,A1,A2,A3,W0,W1,PW) do{ MF; sacc+=A0; sacc+=A1; sacc+=A2; sacc+=A3; PIN(sacc); W0; W1; PIN(PW); SBAR(); }while(0)
  #define EX(v) __builtin_amdgcn_exp2f(v)
  #define GAPB(MF,X,B) do{ MF; X[B]=EX(X[B]); X[B+1]=EX(X[B+1]); X[B+2]=EX(X[B+2]); X[B+3]=EX(X[B+3]); PIN(X); SBAR(); }while(0)
  #define VRD(i) do{ vlo[i]=vtr(vp_+(((i)>>2)*4096+((i)&3)*1024)); vhi[i]=vtr(vp_+(((i)>>2)*4096+((i)&3)*1024+512)); }while(0)
  #define KRD(G,j) do{ if(G){ kload2(kf,kp0+sl_next,j); SBAR(); } }while(0)
  #define STEP(C0,C1,P0,P1,t,GK,GV,GL) do{ SBAR(); \
    const lds_cptr vp_=vp0+sl_prev; \
    VRD(0); SBAR(); float sacc=(P0[0]+P0[1]); \
    GAPA(C0=__builtin_amdgcn_mfma_f32_32x32x16_bf16(kf[0],qr[0],negm,0,0,0), P0[2],P0[3],P0[4],P0[5],     pw0[0]=PKW(P0,0), pw0[1]=PKW(P0,2), pw0); \
    VRD(4); SBAR(); GAPA(C1=__builtin_amdgcn_mfma_f32_32x32x16_bf16(kf[1],qr[0],negm,0,0,0), P0[6],P0[7],P0[8],P0[9],     pw0[2]=PKW(P0,4), pw0[3]=PKW(P0,6), pw0); \
    VRD(1); SBAR(); GAPA(C0=__builtin_amdgcn_mfma_f32_32x32x16_bf16(kf[2],qr[1],C0,0,0,0),   P0[10],P0[11],P0[12],P0[13], pw1[0]=PKW(P0,8), pw1[1]=PKW(P0,10), pw1); \
    VRD(5); SBAR(); GAPA(C1=__builtin_amdgcn_mfma_f32_32x32x16_bf16(kf[3],qr[1],C1,0,0,0),   P0[14],P0[15],P1[0],P1[1],   pw1[2]=PKW(P0,12),pw1[3]=PKW(P0,14), pw1); \
    VRD(2); SBAR(); GAPA(C0=__builtin_amdgcn_mfma_f32_32x32x16_bf16(kf[4],qr[2],C0,0,0,0),   P1[2],P1[3],P1[4],P1[5],     pw2[0]=PKW(P1,0), pw2[1]=PKW(P1,2), pw2); \
    VRD(6); SBAR(); GAPA(C1=__builtin_amdgcn_mfma_f32_32x32x16_bf16(kf[5],qr[2],C1,0,0,0),   P1[6],P1[7],P1[8],P1[9],     pw2[2]=PKW(P1,4), pw2[3]=PKW(P1,6), pw2); \
    VRD(3); SBAR(); GAPA(C0=__builtin_amdgcn_mfma_f32_32x32x16_bf16(kf[6],qr[3],C0,0,0,0),   P1[10],P1[11],P1[12],P1[13], pw3[0]=PKW(P1,8), pw3[1]=PKW(P1,10), pw3); \
    VRD(7); SBAR(); GAPA(C1=__builtin_amdgcn_mfma_f32_32x32x16_bf16(kf[7],qr[3],C1,0,0,0),   P1[14],P1[15],0.f,0.f,       pw3[2]=PKW(P1,12),pw3[3]=PKW(P1,14), pw3); \
    l_reg+=sacc; \
    if(GK){DMA_K((t)+3,sl_cur);} if(GV){DMA_V((t)+1,sl_next);} \
    CMASK(C0,C1,t); \
    SBAR(); \
    GAPB(o[0]=__builtin_amdgcn_mfma_f32_32x32x16_bf16(PAF(0),VFR(0),o[0],0,0,0), C0,0); \
    GAPB(o[1]=__builtin_amdgcn_mfma_f32_32x32x16_bf16(PAF(0),VFR(4),o[1],0,0,0), C0,4); \
    KRD(GL,0); GAPB(o[0]=__builtin_amdgcn_mfma_f32_32x32x16_bf16(PAF(1),VFR(1),o[0],0,0,0), C0,8); \
    KRD(GL,1); GAPB(o[1]=__builtin_amdgcn_mfma_f32_32x32x16_bf16(PAF(1),VFR(5),o[1],0,0,0), C0,12); \
    KRD(GL,2); GAPB(o[0]=__builtin_amdgcn_mfma_f32_32x32x16_bf16(PAF(2),VFR(2),o[0],0,0,0), C1,0); \
    KRD(GL,3); GAPB(o[1]=__builtin_amdgcn_mfma_f32_32x32x16_bf16(PAF(2),VFR(6),o[1],0,0,0), C1,4); \
    GAPB(o[0]=__builtin_amdgcn_mfma_f32_32x32x16_bf16(PAF(3),VFR(3),o[0],0,0,0), C1,8); \
    GAPB(o[1]=__builtin_amdgcn_mfma_f32_32x32x16_bf16(PAF(3),VFR(7),o[1],0,0,0), C1,12); \
    }while(0)
  int t=1;
  for(;t+5<NT;t+=2){
    STEP(pB0,pB1,pA0,pA1,t,true,true,true);     WAIT_BAR(2); RESC(); ROT();
    STEP(pA0,pA1,pB0,pB1,t+1,true,true,true);   WAIT_BAR(2); RESC(); ROT();
  }
  #define ENDW(tt) do{ if((tt)+3<NT){WAIT_BAR(2);} else if((tt)+2<NT){WAIT_BAR(1);} else {WAIT_BAR(0);} }while(0)
  for(;t+1<NT;t+=2){
    STEP(pB0,pB1,pA0,pA1,t,(t+3<NT),(t+1<NT),(t+1<NT));       ENDW(t);   RESC(); ROT();
    STEP(pA0,pA1,pB0,pB1,t+1,(t+4<NT),(t+2<NT),(t+2<NT));     ENDW(t+1); RESC(); ROT();
  }
  STEP(pB0,pB1,pA0,pA1,NT-1,false,false,false); RESC();
  { float sacc=pB0[0]+pB0[1]; _Pragma("unroll") for(int r=2;r<16;++r)sacc+=pB0[r]; _Pragma("unroll") for(int r=0;r<16;++r)sacc+=pB1[r]; l_reg+=sacc;
    pw0=(u32x4){PKW(pB0,0),PKW(pB0,2),PKW(pB0,4),PKW(pB0,6)};pw1=(u32x4){PKW(pB0,8),PKW(pB0,10),PKW(pB0,12),PKW(pB0,14)};pw2=(u32x4){PKW(pB1,0),PKW(pB1,2),PKW(pB1,4),PKW(pB1,6)};pw3=(u32x4){PKW(pB1,8),PKW(pB1,10),PKW(pB1,12),PKW(pB1,14)};
    SBAR(); pv(o,vb0+sl_cur,PAF(0),PAF(1),PAF(2),PAF(3)); }
  #undef PKW
  #undef PAF
  #undef VFR
  #undef PIN
  #undef MX3
  #undef GAPA
  #undef GAPB
  #undef EX
  #undef VRD
  #undef KRD
  #undef STEP
  #undef ENDW
  {auto rr=__builtin_amdgcn_permlane32_swap(__float_as_uint(l_reg),__float_as_uint(l_reg),false,false);l_reg=__uint_as_float(rr[0])+__uint_as_float(rr[1]);}
  if(hi==0)wsf[32+r32]=l_reg;asm volatile("s_waitcnt lgkmcnt(0)":::"memory");
  float rli[16];
  #pragma unroll
  for(int r=0;r<16;++r)rli[r]=__builtin_amdgcn_rcpf(wsf[32+crow(r,hi)]);
  bf16*Ow=O+(long)(q0+wid*QBLK)*OP+h*D;
  { bf16*stg=(bf16*)(shm+LDS_OST)+wid*2048;
    #pragma unroll
    for(int r=0;r<16;++r){const int orow=crow(r,hi);
      #pragma unroll
      for(int d0=0;d0<2;++d0)stg[orow*64+d0*32+r32]=f2bf(o[d0][r]*rli[r]);}
    asm volatile("s_waitcnt lgkmcnt(0)":::"memory");
    #pragma unroll
    for(int i=0;i<4;++i){const int row=i*8+(lane>>3),ch=lane&7; const u32x4 v=*(const u32x4*)(stg+row*64+ch*8); ATTN_STORE16(Ow+(long)row*OP+ch*8,v);} }
  asm volatile("s_waitcnt lgkmcnt(0)\n\ts_barrier":::"memory");
  #undef DMA_K
  #undef DMA_V
  #undef CMASK
  #undef START
  #undef RESC
  #undef ROT
}
constexpr int ATTN_LDS_BYTES=LDS_BYTES;
struct AttnTensors { const bf16* Q; const bf16* K; const bf16* V; bf16* O; };
#undef SBAR
#undef WAIT_BAR
}
constexpr int NWAVES = 8, NTHREADS = 512;
constexpr int RING_OFF = 0, RING_BYTES = 131072;
constexpr int LDSCTL_OFF = RING_BYTES, MISC_OFF = LDSCTL_OFF + 320;
constexpr int TT_OFF = LDSCTL_OFF + 1024;
constexpr int RT_OFF = LDSCTL_OFF + 4096;
constexpr int LDS_BYTES = RT_OFF + 16384 + 1024;
constexpr int MAXT = 192;

struct Frame {
    LAS unsigned char* lds; volatile LAS unsigned* MISC; unsigned* ctl;
    int tid, lane, wave, vcu, G;
};
__device__ __forceinline__ float silu_f(float v) { return v * __builtin_amdgcn_rcpf(1.f + __expf(-v)); }
__device__ __forceinline__ float lsig(float x) { return -log1pf(expf(-x)); }

__device__ __forceinline__ void publish_add(unsigned* cnt, bool leader) {
    asm volatile("s_waitcnt vmcnt(0)" ::: "memory"); __syncthreads();
    if (leader) { __builtin_amdgcn_fence(__ATOMIC_RELEASE, "agent"); asm volatile("s_waitcnt vmcnt(0)" ::: "memory");
        (void)__hip_atomic_fetch_add(cnt, 1u, __ATOMIC_RELAXED, __HIP_MEMORY_SCOPE_AGENT); }
}
__device__ __forceinline__ void store16_wt(void* p, f32x4 v) { asm volatile("global_store_dwordx4 %0, %1, off sc1\n\ts_nop 1" :: "v"(p), "v"(v) : "memory"); }
__device__ __forceinline__ void publish_add_wt(unsigned* cnt, bool leader) {
    asm volatile("s_waitcnt vmcnt(0)" ::: "memory"); __syncthreads();
    if (leader) (void)__hip_atomic_fetch_add(cnt, 1u, __ATOMIC_RELAXED, __HIP_MEMORY_SCOPE_AGENT);
}
__device__ __forceinline__ void wait_ge(unsigned* cnt, unsigned want, bool leader, unsigned* tmo, bool acq = true) {
    if (leader) { unsigned sp = 0;
        while (__hip_atomic_load(cnt, __ATOMIC_RELAXED, __HIP_MEMORY_SCOPE_AGENT) < want) { __builtin_amdgcn_s_sleep(2);
            if ((++sp & 1023u) == 0u) { if (sp > (1u << 22) || __hip_atomic_load(tmo, __ATOMIC_RELAXED, __HIP_MEMORY_SCOPE_AGENT) != 0u) { __hip_atomic_store(tmo, 1u, __ATOMIC_RELAXED, __HIP_MEMORY_SCOPE_AGENT); break; } } }
        if (acq) __builtin_amdgcn_fence(__ATOMIC_ACQUIRE, "agent"); asm volatile("s_waitcnt vmcnt(0)" ::: "memory"); }
    __syncthreads();
}

__device__ __forceinline__ void p0_transpose_item(const float* W, int N, bf16* WT, int Kd, int k0, int n0, int drow0, LAS float* scr, int lane) {
    float wv[32];
#pragma unroll
    for (int i = 0; i < 32; ++i) wv[i] = NT_LD(&W[(size_t)(k0 + 2 * i + (lane >> 5)) * N + n0 + (lane & 31)]);
#pragma unroll
    for (int i = 0; i < 32; ++i) scr[(2 * i + (lane >> 5)) * 33 + (lane & 31)] = wv[i];
    LDS_WAIT(); asm volatile("" ::: "memory");
    const int c = lane & 7;
#pragma unroll
    for (int j = 0; j < 4; ++j) { const int n = (lane >> 3) + 8 * j; const LAS float* s = scr + (8 * c) * 33 + n;
        u32x4 o; o.x = pk2(s[0 * 33], s[1 * 33]); o.y = pk2(s[2 * 33], s[3 * 33]); o.z = pk2(s[4 * 33], s[5 * 33]); o.w = pk2(s[6 * 33], s[7 * 33]);
        if (WT_MASK & 64) st16_sel(WT + (size_t)(drow0 + n) * Kd + k0 + 8 * c, o, true); else NT_ST(o, (u32x4*)(WT + (size_t)(drow0 + n) * Kd + k0 + 8 * c)); }
    LDS_WAIT(); asm volatile("" ::: "memory");
}
struct P0Args { unsigned* modcnt; const float *c, *cctx, *w_ada, *b_ada, *w_in, *w_out, *wg, *wu, *wd, *wgrp, *wexp; float *MOD, *ROPE, *RTW; bf16 *Wi, *Wo, *Wgu, *Wd; };
constexpr int CV_IN = 16 * 72, CV_OUT = 16 * 32, CV_G = 32 * 256, CV_D = 32 * 256, CV_ITEMS = CV_IN + CV_OUT + 2 * CV_G + CV_D;
#ifndef FILL_ITEMS
#define FILL_ITEMS 10240
#endif
constexpr int P0_ITEMS = CV_ITEMS - FILL_ITEMS;
__device__ __forceinline__ void convert_items(Frame& F, const P0Args& a, int first, int last, int w, int nw) {
    LAS float* scr = (LAS float*)(F.lds + RING_OFF + F.wave * 16384);
    for (int it = first + w; it < last; it += nw) {
        int r = it;
        if (r < CV_IN) { const int kb = r / 72, nb = r % 72, n0 = 32 * nb, pn = n0 >> 8, off = n0 & 255, wc = off >> 6, bj = (off >> 5) & 1;
            p0_transpose_item(a.w_in, NPROJ, a.Wi, 1024, 64 * kb, n0, pn * 256 + 128 * bj + 32 * wc, scr, F.lane); continue; } r -= CV_IN;
        if (r < CV_OUT) { const int kb = r >> 5, nb = r & 31; p0_transpose_item(a.w_out, 1024, a.Wo, 1024, 64 * kb, 32 * nb, 32 * nb, scr, F.lane); continue; } r -= CV_OUT;
        if (r < 2 * CV_G) { const int up = r >= CV_G; if (up) r -= CV_G; const int e = r >> 8, q = r & 255, kb = q >> 4, nb = q & 15, n0 = 32 * nb, pn = n0 >> 7, p = n0 & 127;
            p0_transpose_item((up ? a.wu : a.wg) + (size_t)e * 1024 * 512, 512, a.Wgu, 1024, 64 * kb, n0, e * 1024 + pn * 256 + (up ? 128 : 0) + p, scr, F.lane); continue; } r -= 2 * CV_G;
        { const int e = r >> 8, q = r & 255, kb = q >> 5, nb = q & 31; p0_transpose_item(a.wd + (size_t)e * 512 * 1024, 1024, a.Wd, 512, 64 * kb, 32 * nb, e * 1024 + 32 * nb, scr, F.lane); }
    }
}
__device__ __forceinline__ void p0_prologue(Frame& F, const P0Args& a) {
    for (int cb = F.vcu; cb < 192; cb += F.G) {
        LAS float* sv = (LAS float*)(F.lds);
        LAS float* red = (LAS float*)(F.lds + 8192);
        for (int i = F.tid; i < 2048; i += NTHREADS) sv[i] = silu_f(i < 1024 ? a.c[i] : a.cctx[i - 1024]);
        __syncthreads();
        const int col = F.tid & 31, kg = F.tid >> 5, j0 = cb * 32;
        float a0 = 0.f, a1 = 0.f;
#pragma unroll 8
        for (int i = 0; i < 64; ++i) { const int k = kg + 16 * i; const float w = NT_LD(&a.w_ada[(size_t)k * 6144 + j0 + col]); a0 += sv[k] * w; a1 += sv[1024 + k] * w; }
        red[(kg * 32 + col) * 2] = a0; red[(kg * 32 + col) * 2 + 1] = a1;
        __syncthreads();
        if (F.tid < 64) { const int cc = F.tid & 31, s = F.tid >> 5; float t = 0.f;
#pragma unroll
            for (int g = 0; g < 16; ++g) t += red[(g * 32 + cc) * 2 + s];
            if (WT_MASK & 128) __hip_atomic_store(a.MOD + s * 6144 + j0 + cc, t + a.b_ada[j0 + cc], __ATOMIC_RELAXED, __HIP_MEMORY_SCOPE_AGENT); else a.MOD[s * 6144 + j0 + cc] = t + a.b_ada[j0 + cc]; }
        if (WT_MASK & 128) publish_add_wt(a.modcnt, F.tid == 0); else publish_add(a.modcnt, F.tid == 0);
        __syncthreads();
    }
    if (F.vcu == F.G - 1) {
        for (int i = F.tid; i < 4096; i += NTHREADS) { const int pos = i >> 4, f = i & 15; const float freq = powf(10000.f, -(float)(2 * f) / 32.f), ang = (float)pos * freq;
            a.ROPE[2 * i] = cosf(ang); a.ROPE[2 * i + 1] = sinf(ang); }
        __syncthreads();
    }
    if (F.vcu == (F.G >= 2 ? F.G - 2 : 0)) {
        for (int i = F.tid; i < 36 * 1024; i += NTHREADS) { const int cc = i >> 10, n = i & 1023; a.RTW[i] = cc < 32 ? a.wexp[(size_t)n * 32 + cc] : a.wgrp[(size_t)n * 4 + cc - 32]; }
    }
    convert_items(F, a, 0, P0_ITEMS, F.vcu * NWAVES + F.wave, F.G * NWAVES);
}
template <int NB> __device__ __forceinline__ void norm1_rows(const int (&rows)[NB], int lane, const float* x, const float* ctx, const float* g1, const float* MOD, bf16* HX) {
    f32x4 v[NB][4];
#pragma unroll
    for (int b = 0; b < NB; ++b) { const int r = rows[b]; const float* src = r < CL ? ctx + (size_t)r * DM : x + (size_t)(r - CL) * DM;
#pragma unroll
        for (int j = 0; j < 4; ++j) v[b][j] = NT_LD((const f32x4*)src + lane + 64 * j); }
#pragma unroll
    for (int b = 0; b < NB; ++b) { const int r = rows[b]; const float* mod = MOD + (r < CL ? 6144 : 0); float ss = 0.f;
#pragma unroll
        for (int j = 0; j < 4; ++j) ss += (v[b][j].x * v[b][j].x + v[b][j].y * v[b][j].y) + (v[b][j].z * v[b][j].z + v[b][j].w * v[b][j].w);
        const float rstd = rsqrtf(wave_sum(ss) * (1.f / DM) + EPS);
#pragma unroll
        for (int j = 0; j < 4; ++j) { const int n = 4 * lane + 256 * j; const f32x4 g = *(const f32x4*)(g1 + n), sh = *(const f32x4*)(mod + n), sc = *(const f32x4*)(mod + 1024 + n);
            float h[4];
#pragma unroll
            for (int i = 0; i < 4; ++i) h[i] = (v[b][j][i] * rstd) * g[i] * (1.f + sc[i]) + sh[i];
            u32x2 o; o.x = pk2(h[0], h[1]); o.y = pk2(h[2], h[3]); st8_sel(HX + (size_t)r * DM + n, o, (WT_MASK & 1) != 0); } }
}

__device__ __forceinline__ void route_stage_weights(Frame& F, const float* RTW) {
    LAS u32x4* wxT = (LAS u32x4*)(F.lds + RING_OFF); LAS u32x4* wgT = (LAS u32x4*)(F.lds + RT_OFF); const u32x4* src = (const u32x4*)RTW;
#pragma unroll 8
    for (int i = 0; i < 16; ++i) wxT[F.tid + NTHREADS * i] = src[F.tid + NTHREADS * i];
#pragma unroll
    for (int i = 0; i < 2; ++i) wgT[F.tid + NTHREADS * i] = src[8192 + F.tid + NTHREADS * i];
    __syncthreads();
}
struct RouteOut { int ea, eb; float w1, w2; };
__device__ __forceinline__ void route_load_row(int t, int lane, const bf16* XN, f32x4 (&v)[4]) {
    const u32x2* xr = (const u32x2*)(XN + (size_t)t * DM) + lane;
#pragma unroll
    for (int j = 0; j < 4; ++j) { const u32x2 w = xr[64 * j]; v[j] = (f32x4){__uint_as_float(w.x << 16), __uint_as_float(w.x & 0xffff0000u), __uint_as_float(w.y << 16), __uint_as_float(w.y & 0xffff0000u)}; }
}
template <int COMMIT> __device__ __forceinline__ void route_row_pre(Frame& F, int t, const f32x4 (&v)[4], const float* g2, const float* MOD, const float* bgrp, const float* bexp,
                                              bf16* H2, int* EID, float* RW, int* CNT, int* LIST, RouteOut* ro = nullptr, const f32x4 (*wgr)[4] = nullptr, const f32x4 (*gms)[4] = nullptr);
template <int COMMIT> __device__ __forceinline__ void route_row_lds(Frame& F, int t, const bf16* XN, const float* g2, const float* MOD, const float* bgrp, const float* bexp,
                                              bf16* H2, int* EID, float* RW, int* CNT, int* LIST) {
    f32x4 v[4]; route_load_row(t, F.lane, XN, v); route_row_pre<COMMIT>(F, t, v, g2, MOD, bgrp, bexp, H2, EID, RW, CNT, LIST);
}
template <int COMMIT> __device__ __forceinline__ void route_row_pre(Frame& F, int t, const f32x4 (&v)[4], const float* g2, const float* MOD, const float* bgrp, const float* bexp,
                                              bf16* H2, int* EID, float* RW, int* CNT, int* LIST, RouteOut* ro, const f32x4 (*wgr)[4], const f32x4 (*gms)[4]) {
    const int lane = F.lane;
    const LAS float* wxT = (const LAS float*)(F.lds + RING_OFF); const LAS float* wgT = (const LAS float*)(F.lds + RT_OFF);
    float ss = 0.f;
#pragma unroll
    for (int j = 0; j < 4; ++j) ss += (v[j].x * v[j].x + v[j].y * v[j].y) + (v[j].z * v[j].z + v[j].w * v[j].w);
#if defined(DIAG_CK) && DIAG_CK == 1
    { unsigned cx = 0;
#pragma unroll
      for (int j = 0; j < 4; ++j) cx ^= (__float_as_uint(v[j].x) * 3u) ^ (__float_as_uint(v[j].y) * 5u) ^ (__float_as_uint(v[j].z) * 7u) ^ (__float_as_uint(v[j].w) * 11u);
      cx *= (unsigned)(t * 2 + 1);
#pragma unroll
      for (int o = 1; o < 64; o <<= 1) cx ^= (unsigned)__shfl_xor((int)cx, o);
      if (COMMIT && lane == 0) atomicXor((unsigned*)(CNT) + 64, cx); }
#endif
    const float rstd = rsqrtf(wave_sum(ss) * (1.f / DM) + EPS);
    float gl[4]; pg8::f32x2 gl2[4] = {{0.f, 0.f}, {0.f, 0.f}, {0.f, 0.f}, {0.f, 0.f}};
    f32x4 h[4];
#pragma unroll
    for (int j = 0; j < 4; ++j) {
        const int n = 4 * lane + 256 * j;
        if (gms) h[j] = (v[j] * rstd) * gms[0][j] + gms[1][j];
        else { const f32x4 g = *(const f32x4*)(g2 + n), sh = *(const f32x4*)(MOD + 3072 + n), sc = *(const f32x4*)(MOD + 4096 + n);
#pragma unroll
            for (int i = 0; i < 4; ++i) h[j][i] = (v[j][i] * rstd) * g[i] * (1.f + sc[i]) + sh[i]; }
#pragma unroll
        for (int c = 0; c < 4; ++c) { const f32x4 w = wgr ? wgr[c][j] : *(const LAS f32x4*)(wgT + c * 1024 + n); gl2[c] += (pg8::f32x2){h[j].x, h[j].y} * (pg8::f32x2){w.x, w.y}; gl2[c] += (pg8::f32x2){h[j].z, h[j].w} * (pg8::f32x2){w.z, w.w}; }
        u32x2 o; o.x = pk2(h[j].x, h[j].y); o.y = pk2(h[j].z, h[j].w);
        st8_sel(H2 + (size_t)t * DM + n, o, (WT_MASK & 16) != 0);
    }
#pragma unroll
    for (int c = 0; c < 4; ++c) gl[c] = wave_sum(gl2[c].x + gl2[c].y) + bgrp[c];
    int g = 0; float gm = gl[0];
#pragma unroll
    for (int c = 1; c < 4; ++c) if (gl[c] > gm) { gm = gl[c]; g = c; }
    g = __builtin_amdgcn_readfirstlane(g);
    float gs = 0.f;
#pragma unroll
    for (int c = 0; c < 4; ++c) gs += __expf(gl[c] - gm);
    const float pg = __builtin_amdgcn_rcpf(gs);
    float el[8]; pg8::f32x2 el2[8] = {{0.f, 0.f}, {0.f, 0.f}, {0.f, 0.f}, {0.f, 0.f}, {0.f, 0.f}, {0.f, 0.f}, {0.f, 0.f}, {0.f, 0.f}};
#pragma unroll
    for (int j = 0; j < 4; ++j)
#pragma unroll
        for (int c = 0; c < 8; ++c) { const f32x4 w = *(const LAS f32x4*)(wxT + (g * 8 + c) * 1024 + 4 * lane + 256 * j); el2[c] += (pg8::f32x2){h[j].x, h[j].y} * (pg8::f32x2){w.x, w.y}; el2[c] += (pg8::f32x2){h[j].z, h[j].w} * (pg8::f32x2){w.z, w.w}; }
#pragma unroll
    for (int c = 0; c < 8; ++c) el[c] = wave_sum(el2[c].x + el2[c].y) + bexp[g * 8 + c];
    int j1 = 0; float m1 = el[0];
#pragma unroll
    for (int c = 1; c < 8; ++c) if (el[c] > m1) { m1 = el[c]; j1 = c; }
    int j2 = -1; float m2 = -INFINITY;
#pragma unroll
    for (int c = 0; c < 8; ++c) if (c != j1 && el[c] > m2) { m2 = el[c]; j2 = c; }
    const float e2 = __expf(m2 - m1), r12 = __builtin_amdgcn_rcpf(1.f + e2), w1 = pg * r12, w2 = pg * e2 * r12;
    if (COMMIT == 2) { ro->ea = __builtin_amdgcn_readfirstlane(g * 8 + j1); ro->eb = __builtin_amdgcn_readfirstlane(g * 8 + j2); ro->w1 = __uint_as_float(__builtin_amdgcn_readfirstlane(__float_as_uint(w1))); ro->w2 = __uint_as_float(__builtin_amdgcn_readfirstlane(__float_as_uint(w2))); return; }
    if (lane == 0) {
        const int ea = g * 8 + j1, eb = g * 8 + j2;
        EID[2 * t] = ea; EID[2 * t + 1] = eb; RW[2 * t] = w1; RW[2 * t + 1] = w2;
        if (COMMIT == 1) {
            const int sa = atomicAdd(CNT + ea, 1); __hip_atomic_store(LIST + ea * SEQ + sa, 2 * t, __ATOMIC_RELAXED, __HIP_MEMORY_SCOPE_AGENT);
            const int sb = atomicAdd(CNT + eb, 1); __hip_atomic_store(LIST + eb * SEQ + sb, 2 * t + 1, __ATOMIC_RELAXED, __HIP_MEMORY_SCOPE_AGENT); }
    }
}

namespace pg8 {
struct AMapDirect { __device__ __forceinline__ int row(const Unit& u, int r) const { return u.pm * BM + r; }
    __device__ __forceinline__ int raw(const Unit& u, int r) const { return row(u, r); } __device__ __forceinline__ int fix(int x) const { return x; } };
struct MoeTable { const LAS int* tt; const int* LIST;
    __device__ __forceinline__ int e(int T) const { return tt[T]; }
    __device__ __forceinline__ int s0(int T) const { return tt[MAXT + T]; }
    __device__ __forceinline__ int cnt(int e_) const { return tt[2 * MAXT + e_]; }
    __device__ __forceinline__ int ntiles() const { return tt[2 * MAXT + 32]; }
};
struct AMapGather { MoeTable mt;
    __device__ __forceinline__ int row(const Unit& u, int r) const { const int T = u.pm, e = mt.e(T), c = mt.cnt(e); int s = mt.s0(T) + r; s = s < c ? s : c - 1; return mt.LIST[e * SEQ + s] >> 1; }
    __device__ __forceinline__ int raw(const Unit& u, int r) const { const int T = u.pm, e = mt.e(T), c = mt.cnt(e); int s = mt.s0(T) + r; s = s < c ? s : c - 1; return mt.LIST[e * SEQ + s]; }
    __device__ __forceinline__ int fix(int x) const { return x >> 1; } };
struct MoeOrder { MoeTable mt; int G, c;
    __device__ __forceinline__ bool next(int i, Unit& u) const { const int L = i * G + c; if (L >= 4 * mt.ntiles()) return false; const int T = L >> 2; u.pm = T; u.pn = mt.e(T) * 4 + (L & 3); return true; }
    __device__ __forceinline__ void a_ready(const Unit&) const {}
    __device__ __forceinline__ void done(const Unit&) const {}
};
struct MoeOrder1 { MoeTable mt; int G, c; unsigned* tcnt;
    __device__ __forceinline__ bool next(int i, Unit& u) const { const int L = i * G + c; if (L >= 4 * mt.ntiles()) return false; const int T = L >> 2; u.pm = T; u.pn = mt.e(T) * 4 + (L & 3); return true; }
    __device__ __forceinline__ void a_ready(const Unit&) const {}
    __device__ __forceinline__ void done(const Unit& u) const { asm volatile("s_waitcnt vmcnt(0)" ::: "memory");
        if (fresh_lane() == 0) (void)__hip_atomic_fetch_add(tcnt + 64 * u.pm, 1u, __ATOMIC_RELAXED, __HIP_MEMORY_SCOPE_AGENT); }
};
#ifndef NOACQ_MASK
#define NOACQ_MASK 0
#endif
#ifndef MOE_NOACQ
#define MOE_NOACQ 0
#endif
#ifndef MOE_PEEK
#define MOE_PEEK 0
#endif
struct MoeOrder2 { MoeTable mt; int G, c, wave; unsigned* tcnt; unsigned* tmo; mutable bool acq_all = false;
    __device__ __forceinline__ bool next(int i, Unit& u) const {
        const int n1 = 4 * mt.ntiles(), k3 = n1 - 512; int L;
        if (G != 256 || k3 < 0 || k3 > 255) L = i * G + c;
        else if (c < k3) { if (i > 0) return false; L = 512 + c; }
        else { const int nb = 256 - k3; L = (c - k3) + i * nb; if (L >= 512) return false; }
        if (L >= n1) return false; const int T = L >> 2; u.pm = T; u.pn = mt.e(T) * 4 + (L & 3); return true; }
    __device__ __forceinline__ void a_ready(const Unit& u) const {
        if (wave == 0 && !acq_all) { unsigned sp = 0;
            while ((unsigned)__builtin_amdgcn_readfirstlane(__hip_atomic_load(tcnt + 64 * u.pm, __ATOMIC_RELAXED, __HIP_MEMORY_SCOPE_AGENT)) < 32u) { __builtin_amdgcn_s_sleep(2);
                if ((++sp & 1023u) == 0u && (sp > (1u << 22) || __builtin_amdgcn_readfirstlane(__hip_atomic_load(tmo, __ATOMIC_RELAXED, __HIP_MEMORY_SCOPE_AGENT)) != 0u)) { if (fresh_lane() == 0) __hip_atomic_store(tmo, 1u, __ATOMIC_RELAXED, __HIP_MEMORY_SCOPE_AGENT); break; } }
            if (MOE_PEEK) { bool all = true;
#pragma unroll
                for (int j = 0; j < 3; ++j) { Unit o; if (next(j, o)) all = all && ((unsigned)__builtin_amdgcn_readfirstlane(__hip_atomic_load(tcnt + 64 * o.pm, __ATOMIC_RELAXED, __HIP_MEMORY_SCOPE_AGENT)) >= 32u); }
                acq_all = all; }
            if (!MOE_NOACQ) __builtin_amdgcn_fence(__ATOMIC_ACQUIRE, "agent"); asm volatile("s_waitcnt vmcnt(0)" ::: "memory"); }
        asm volatile("" ::: "memory"); __builtin_amdgcn_s_barrier(); asm volatile("" ::: "memory");
    }
    __device__ __forceinline__ void done(const Unit&) const {}
};
__device__ __forceinline__ u32x4 pack8(const f32x4& a, const f32x4& b) { u32x4 w; w.x = cvt_pk_bf16(a[0], a[1]); w.y = cvt_pk_bf16(a[2], a[3]); w.z = cvt_pk_bf16(b[0], b[1]); w.w = cvt_pk_bf16(b[2], b[3]); return w; }

struct EpiInProj {
    static constexpr bool PERM = true, AFTER_DRAIN = false;
    bf16 *Q, *K, *V, *QR, *KR, *VR, *GR; const float *gq, *gk, *ROPE;
    __device__ __forceinline__ void operator()(const f32x4 (&acc)[2][2][4][2], const Unit& u, int wr, int wc, int fr, int fq) const {
        const int pn = u.pn; int kind, h;
        if (pn < 2) { kind = 0; h = pn * 4 + wc; } else if (pn == 2) { if (wc < 2) { kind = 1; h = wc; } else { kind = 2; h = wc - 2; } }
        else if (pn == 3) { kind = 3; h = wc; } else if (pn == 4) { kind = 4; h = wc; } else if (pn < 7) { kind = 5; h = (pn - 5) * 4 + wc; } else { kind = 6; h = (pn - 7) * 4 + wc; }
        const bool isctx = (u.pm == 0);
        if (isctx && (kind == 0 || kind == 3 || kind == 6)) return;
        const bool norm = kind <= 1, rope = !isctx && (kind == 0 || kind == 1 || kind == 3 || kind == 4);
        f32x4 gg[2][2];
#pragma unroll
        for (int bj = 0; bj < 2; ++bj)
#pragma unroll
            for (int n = 0; n < 2; ++n) gg[bj][n] = norm ? *(const f32x4*)((kind == 0 ? gq : gk) + 32 * bj + 8 * fq + 4 * n) : (f32x4){1.f, 1.f, 1.f, 1.f};
        const float osc = kind == 0 ? QSCALE : (kind == 4 ? 0.125f : 1.f);
        bf16* obase; int ostride; bool use_t;
        switch (kind) {
            case 0: obase = Q + h * 64; ostride = 512; use_t = true; break;
            case 1: obase = K + (size_t)h * NKV * 64; ostride = 64; use_t = false; break;
            case 2: obase = V + (size_t)h * NKV * 64; ostride = 64; use_t = false; break;
            case 3: obase = QR + (size_t)h * SEQ * 64; ostride = 64; use_t = true; break;
            case 4: obase = KR + (size_t)h * NKV * 64; ostride = 64; use_t = false; break;
            case 5: obase = VR + (size_t)(h >> 1) * NKV * 128 + (h & 1) * 64; ostride = 128; use_t = false; break;
            default: obase = GR + h * 64; ostride = 512; use_t = true; break;
        }
        f32x4 csr[2][2], csc[4][2];
        if (rope) { const int tb = u.pm * BM - CL + wr * 64;
#pragma unroll
            for (int ai = 0; ai < 2; ++ai)
#pragma unroll
                for (int n = 0; n < 2; ++n) csr[ai][n] = *(const f32x4*)(ROPE + ((((tb + ai * HALF) >> 6) * 16 + 4 * fq) * 2) + 4 * n);
#pragma unroll
            for (int m = 0; m < 4; ++m)
#pragma unroll
                for (int n = 0; n < 2; ++n) csc[m][n] = *(const f32x4*)(ROPE + (((m * 16 + fr) * 16 + 4 * fq) * 2) + 4 * n); }
#pragma unroll
        for (int ai = 0; ai < 2; ++ai)
#pragma unroll
            for (int m = 0; m < 4; ++m) {
                const int r = u.pm * BM + ai * HALF + wr * 64 + m * 16 + fr, t = r - CL;
                f32x4 v[2][2];
#pragma unroll
                for (int bj = 0; bj < 2; ++bj)
#pragma unroll
                    for (int n = 0; n < 2; ++n) v[bj][n] = acc[ai][bj][m][n];
                if (norm) { float ss = 0.f;
#pragma unroll
                    for (int bj = 0; bj < 2; ++bj)
#pragma unroll
                        for (int n = 0; n < 2; ++n) ss += (v[bj][n][0] * v[bj][n][0] + v[bj][n][1] * v[bj][n][1]) + (v[bj][n][2] * v[bj][n][2] + v[bj][n][3] * v[bj][n][3]);
                    ss += __shfl_xor(ss, 16); ss += __shfl_xor(ss, 32);
                    const float rn = rsqrtf(ss * (1.f / 64.f) + EPS);
#pragma unroll
                    for (int bj = 0; bj < 2; ++bj)
#pragma unroll
                        for (int n = 0; n < 2; ++n) v[bj][n] = v[bj][n] * rn * gg[bj][n]; }
                if (rope) {
#pragma unroll
                    for (int bj = 0; bj < 2; ++bj) {
#pragma unroll
                        for (int n = 0; n < 2; ++n) { const f32x4 cs = bj ? csc[m][n] : csr[ai][n]; const f32x4 x = v[bj][n];
                            v[bj][n] = (f32x4){x[0] * cs[0] - x[1] * cs[1], x[0] * cs[1] + x[1] * cs[0], x[2] * cs[2] - x[3] * cs[3], x[2] * cs[3] + x[3] * cs[2]}; } } }
#pragma unroll
                for (int bj = 0; bj < 2; ++bj) {
                    st16_sel(obase + (size_t)(use_t ? t : r) * ostride + 32 * bj + 8 * fq, pack8(v[bj][0] * osc, v[bj][1] * osc), (WT_MASK & 2) != 0); }
            }
    }
};
template <bool WT> struct EpiOutProj {
    static constexpr bool PERM = true, AFTER_DRAIN = false;
    const float* x; const float* gt1; bf16* XN;
    __device__ __forceinline__ void operator()(const f32x4 (&acc)[2][2][4][2], const Unit& u, int wr, int wc, int fr, int fq) const {
        const int c0 = u.pn * BM + wc * 32 + 8 * fq;
        f32x4 g[2][2];
#pragma unroll
        for (int bj = 0; bj < 2; ++bj)
#pragma unroll
            for (int n = 0; n < 2; ++n) g[bj][n] = *(const f32x4*)(gt1 + c0 + bj * HALF + 4 * n);
#pragma unroll
        for (int ai = 0; ai < 2; ++ai) { f32x4 xv[4][2][2];
#pragma unroll
            for (int m = 0; m < 4; ++m) { const size_t off = (size_t)(u.pm * BM + ai * HALF + wr * 64 + m * 16 + fr) * DM + c0;
#pragma unroll
                for (int bj = 0; bj < 2; ++bj)
#pragma unroll
                    for (int n = 0; n < 2; ++n) xv[m][bj][n] = NT_LD((const f32x4*)(x + off + bj * HALF + 4 * n)); }
#pragma unroll
            for (int m = 0; m < 4; ++m) { const size_t off = (size_t)(u.pm * BM + ai * HALF + wr * 64 + m * 16 + fr) * DM + c0;
#pragma unroll
                for (int bj = 0; bj < 2; ++bj) { const u32x4 w = pack8(xv[m][bj][0] + g[bj][0] * acc[ai][bj][m][0], xv[m][bj][1] + g[bj][1] * acc[ai][bj][m][1]);
                    if (WT) store16_wt(XN + off + bj * HALF, __builtin_bit_cast(f32x4, w)); else *(u32x4*)(XN + off + bj * HALF) = w; } } }
    }
};
template <bool WT> struct EpiSwiGLU {
    static constexpr bool PERM = true, AFTER_DRAIN = false;
    bf16* ACT;
    __device__ __forceinline__ void operator()(const f32x4 (&acc)[2][2][4][2], const Unit& u, int wr, int wc, int fr, int fq) const {
        const int c0 = (u.pn & 3) * 128 + wc * 32 + 8 * fq;
#pragma unroll
        for (int ai = 0; ai < 2; ++ai)
#pragma unroll
            for (int m = 0; m < 4; ++m) { f32x4 o[2];
#pragma unroll
                for (int n = 0; n < 2; ++n)
#pragma unroll
                    for (int i = 0; i < 4; ++i) { const float gv = acc[ai][0][m][n][i]; o[n][i] = gv * __builtin_amdgcn_rcpf(1.f + __expf(-gv)) * acc[ai][1][m][n][i]; }
                const u32x4 w = pack8(o[0], o[1]); bf16* dst = ACT + (size_t)(u.pm * BM + ai * HALF + wr * 64 + m * 16 + fr) * DEXP + c0;
                if (WT) { __hip_atomic_store((unsigned long long*)dst, (unsigned long long)w.x | ((unsigned long long)w.y << 32), __ATOMIC_RELAXED, __HIP_MEMORY_SCOPE_AGENT);
                          __hip_atomic_store((unsigned long long*)dst + 1, (unsigned long long)w.z | ((unsigned long long)w.w << 32), __ATOMIC_RELAXED, __HIP_MEMORY_SCOPE_AGENT); }
                else *(u32x4*)dst = w; }
    }
};
struct EpiScatter {
    static constexpr bool PERM = true, AFTER_DRAIN = false;
    MoeTable mt; bf16* Y; int* FLAG;
    __device__ __forceinline__ void operator()(const f32x4 (&acc)[2][2][4][2], const Unit& u, int wr, int wc, int fr, int fq) const {
        const int T = u.pm, e = mt.e(T), cnt = mt.cnt(e), s0 = mt.s0(T); const int c0 = (u.pn & 3) * BM + wc * 32 + 8 * fq;
        int al[2][4];
#pragma unroll
        for (int ai = 0; ai < 2; ++ai)
#pragma unroll
            for (int m = 0; m < 4; ++m) { const int s = s0 + ai * HALF + wr * 64 + m * 16 + fr; al[ai][m] = s < cnt ? mt.LIST[e * SEQ + s] : -1; }
#pragma unroll
        for (int ai = 0; ai < 2; ++ai)
#pragma unroll
            for (int m = 0; m < 4; ++m) { const int a = al[ai][m];
                if (a >= 0) { bf16* dst = Y + ((size_t)(a & 1) * SEQ + (a >> 1)) * DM + c0;
#ifdef DIAG_FLAG
                    if ((u.pn & 3) == 0 && wc == 0 && fq == 0) atomicAdd(FLAG + a, 1);
#endif
#pragma unroll
                    for (int bj = 0; bj < 2; ++bj) st16_sel(dst + bj * HALF, pack8(acc[ai][bj][m][0], acc[ai][bj][m][1]), (WT_MASK & 32) != 0); } }
    }
};
}
__device__ __forceinline__ void moe_build_table(Frame& F, const int* CNT) {
    LAS int* tt = (LAS int*)(F.lds + TT_OFF);
    if (F.wave == 0) { const int lane = fresh_lane(); const int c = lane < NEXP ? CNT[lane] : 0; const int nt = (c + 255) >> 8; int incl = nt;
#pragma unroll
        for (int o = 1; o < 32; o <<= 1) { const int v = __shfl_up(incl, o); if (lane >= o) incl += v; }
        const int first = incl - nt;
        if (lane < NEXP) { tt[2 * MAXT + lane] = c; for (int k = 0; k < nt; ++k) if (first + k < MAXT) { tt[first + k] = lane; tt[MAXT + first + k] = 256 * k; } }
        const int total = __shfl(incl, NEXP - 1); if (lane == 0) tt[2 * MAXT + 32] = total < MAXT ? total : MAXT; }
    __syncthreads();
}

namespace ret {
typedef short bf16x8 __attribute__((ext_vector_type(8)));
typedef short s16x4 __attribute__((ext_vector_type(4)));
constexpr int KS = 144, VS = 272, PS = 272;
constexpr int NCH = 130;
#define RET_MFMA(a, b, c) __builtin_amdgcn_mfma_f32_16x16x32_bf16(a, b, c, 0, 0, 0)
__device__ __forceinline__ bf16x8 tr_frag(LAS unsigned char* base, int S, int tok0, int feat0, int lane) {
    const int g = lane >> 4, i = lane & 15;
#ifndef RET_NO_TR
    const int q = i >> 2, p = i & 3;
    LAS unsigned char* a0 = base + (tok0 + 8 * g + q) * S + (feat0 + 4 * p) * 2;
    const s16x4 lo = __builtin_bit_cast(s16x4, __builtin_amdgcn_ds_read_tr16_b64_v4i16((LAS s16x4*)a0));
    const s16x4 hi = __builtin_bit_cast(s16x4, __builtin_amdgcn_ds_read_tr16_b64_v4i16((LAS s16x4*)(a0 + 4 * S)));
    return (bf16x8){lo[0], lo[1], lo[2], lo[3], hi[0], hi[1], hi[2], hi[3]};
#else
    bf16x8 r;
#pragma unroll
    for (int j = 0; j < 8; ++j) r[j] = *(LAS short*)(base + (tok0 + 8 * g + j) * S + (feat0 + i) * 2);
    return r;
#endif
}
__device__ __forceinline__ u32x4 scale8(u32x4 w, float s) {
    u32x4 o;
#pragma unroll
    for (int i = 0; i < 4; ++i) { const float lo = __uint_as_float(w[i] << 16) * s, hi = __uint_as_float(w[i] & 0xffff0000u) * s; o[i] = pk2(lo, hi); }
    return o;
}
#ifndef RET_WT
#define RET_WT 0
#endif
__device__ __forceinline__ void r1_unit(Frame& F, int h, int j, const bf16* KR, const bf16* VR, float lgf, float lgb, float* U) {
    LAS unsigned char* Kf = F.lds, *Kb = F.lds + 128 * KS, *Vs = F.lds + 2 * 128 * KS;
    const int lane = fresh_lane(), tid = F.wave * 64 + lane;
    const bf16* kc = KR + ((size_t)h * NKV + 128 * j) * 64; const bf16* vc = VR + ((size_t)h * NKV + 128 * j) * 128;
#pragma unroll
    for (int i = 0; i < 2; ++i) { const int id = tid + 512 * i, row = id >> 3, ch = id & 7; const u32x4 w = *(const u32x4*)(kc + row * 64 + ch * 8);
        *(LAS u32x4*)(Kf + row * KS + ch * 16) = scale8(w, __expf(lgf * (float)(127 - row))); *(LAS u32x4*)(Kb + row * KS + ch * 16) = scale8(w, __expf(lgb * (float)row)); }
#pragma unroll
    for (int i = 0; i < 4; ++i) { const int id = tid + 512 * i, row = id >> 4, ch = id & 15; *(LAS u32x4*)(Vs + row * VS + ch * 16) = *(const u32x4*)(vc + row * 128 + ch * 8); }
    __syncthreads();
    const int w = F.wave, g = lane >> 4, li = lane & 15;
    bf16x8 a[4];
#pragma unroll
    for (int ks = 0; ks < 4; ++ks) a[ks] = tr_frag(Vs, VS, 32 * ks, 16 * w, lane);
#pragma unroll
    for (int dir = 0; dir < 2; ++dir)
#pragma unroll
        for (int c = 0; c < 4; ++c) { f32x4 acc = {0.f, 0.f, 0.f, 0.f}; bf16x8 bfr[4];
#pragma unroll
            for (int ks = 0; ks < 4; ++ks) bfr[ks] = tr_frag(dir ? Kb : Kf, KS, 32 * ks, 16 * c, lane);
#pragma unroll
            for (int ks = 0; ks < 4; ++ks) acc = RET_MFMA(a[ks], bfr[ks], acc);
            float* up = U + ((size_t)((h * NCH + j) * 2 + dir)) * 8192 + (16 * w + 4 * g) * 64 + 16 * c + li;
#pragma unroll
            for (int r = 0; r < 4; ++r) { if (RET_WT) __hip_atomic_store(up + r * 64, acc[r], __ATOMIC_RELAXED, __HIP_MEMORY_SCOPE_AGENT); else up[r * 64] = acc[r]; } }
    __syncthreads();
}
__device__ __forceinline__ void r2_scan(int gid, const float* U, float lgf, float lgb, int h, int dir, bf16* SP) {
    const int e = gid & 8191; const float gC = __expf((dir ? lgb : lgf) * 128.f); float S = 0.f;
    const float* up = U + (size_t)(h * NCH * 2 + dir) * 8192 + e; bf16* sp = SP + (size_t)(h * 128 * 2 + dir) * 8192 + e;
    if (dir == 0) {
#pragma unroll 44
        for (int j = 0; j < NCH; ++j) { if (j >= 2) sp[(size_t)(j - 2) * 16384] = f2bf(S); S = gC * S + up[(size_t)j * 16384]; }
    } else {
        S = up[(size_t)1 * 16384]; S = gC * S + up[0];
#pragma unroll 43
        for (int j = NCH - 1; j >= 2; --j) { sp[(size_t)(j - 2) * 16384] = f2bf(S); S = gC * S + up[(size_t)j * 16384]; }
    }
}
__device__ __forceinline__ void r2_scan_block(Frame& F, int blk, const float* U, const float* dec_f, const float* dec_b, bf16* SP) {
    const int cid0 = blk * 256, combo = cid0 >> 13, h = combo >> 1, dir = combo & 1, s = F.wave, lane = fresh_lane(), vz = lane >> 6;
    const float lg = lsig(dir ? dec_b[h] : dec_f[h]), gC = __expf(lg * 128.f), D16 = __expf(lg * 128.f * 16.f);
    LAS float* Tl = (LAS float*)(F.lds + RING_OFF);
    float pre[4][16], c0[4];
#pragma unroll
    for (int q = 0; q < 4; ++q) { const int e = (cid0 + q * 64 + lane) & 8191; const float* up = U + (size_t)(h * NCH * 2 + dir) * 8192 + e;
        const float ua = up[(size_t)(dir + vz) * 16384], ub = up[(size_t)(1 - dir + vz) * 16384];
        float u[16];
#pragma unroll
        for (int k = 0; k < 16; ++k) { const int n = (dir == 0 ? 16 * s + k : 127 - 16 * s - k) + vz; u[k] = up[(size_t)(2 + n) * 16384]; }
        c0[q] = gC * ua + ub;
        float P = 0.f;
#pragma unroll
        for (int k = 0; k < 16; ++k) { pre[q][k] = P; P = gC * P + u[k]; }
        Tl[s * 256 + q * 64 + lane] = P; }
    __syncthreads();
#pragma unroll
    for (int q = 0; q < 4; ++q) { float C = c0[q];
        for (int s2 = 0; s2 < s; ++s2) C = C * D16 + Tl[s2 * 256 + q * 64 + lane];
        const int e = (cid0 + q * 64 + lane) & 8191; bf16* sp = SP + (size_t)(h * 128 * 2 + dir) * 8192 + e; float cur = C;
#pragma unroll
        for (int k = 0; k < 16; ++k) { const int n = (dir == 0 ? 16 * s + k : 127 - 16 * s - k) + vz; const bf16 sv = f2bf(cur + pre[q][k]); if (RET_WT) __hip_atomic_store(sp + (size_t)n * 16384, sv, __ATOMIC_RELAXED, __HIP_MEMORY_SCOPE_AGENT); else sp[(size_t)n * 16384] = sv; cur *= gC; } }
    __syncthreads();
}
struct R3Regs { u32x4 kreg[2], vreg[4], sreg[4]; bf16x8 qa[2]; };
__device__ __forceinline__ void r3_load(R3Regs& R, int wv, int lane, int h, int n, const bf16* QR, const bf16* KR, const bf16* VR, const bf16* SP) {
    const int t0 = 128 * n, tid = wv * 64 + lane, g = lane >> 4, li = lane & 15; const bf16* kc = KR + ((size_t)h * NKV + CL + t0) * 64; const bf16* vc = VR + ((size_t)h * NKV + CL + t0) * 128;
    const bf16* spc = SP + (size_t)((h * 128 + n) * 2) * 8192;
#pragma unroll
    for (int q = 0; q < 2; ++q) { const int id = tid + 512 * q; R.kreg[q] = *(const u32x4*)(kc + (id >> 3) * 64 + (id & 7) * 8); }
#pragma unroll
    for (int q = 0; q < 4; ++q) { const int id = tid + 512 * q; R.vreg[q] = *(const u32x4*)(vc + (id >> 4) * 128 + (id & 15) * 8); R.sreg[q] = *(const u32x4*)(spc + (size_t)id * 8); }
#pragma unroll
    for (int ks = 0; ks < 2; ++ks) R.qa[ks] = *(const bf16x8*)(QR + ((size_t)h * SEQ + t0 + 16 * wv + li) * 64 + 32 * ks + 8 * g);
}
__device__ __forceinline__ void r3_unit(Frame& F, R3Regs& R, int h, int n, int hn, int nn, const bf16* QR, const bf16* KR, const bf16* VR, const bf16* GR, const bf16* SP,
                                        float lgf, float lgb, const float* gn_g, const float* gn_b, bf16* MIX) {
    LAS unsigned char* Ks = F.lds, *Vs = F.lds + 128 * KS, *Ps = F.lds + 128 * KS + 128 * VS, *Ss = F.lds + 128 * KS + 2 * 128 * VS;
    const int t0 = 128 * n;
    const int w = F.wave, lane = fresh_lane(), g = lane >> 4, li = lane & 15, tid = w * 64 + lane;
    const int i = 16 * w + li, t = t0 + i;
    bf16x8 qa[2]; qa[0] = R.qa[0]; qa[1] = R.qa[1];
#pragma unroll
    for (int q = 0; q < 2; ++q) { const int id = tid + 512 * q; *(LAS u32x4*)(Ks + (id >> 3) * KS + (id & 7) * 16) = R.kreg[q]; }
#pragma unroll
    for (int q = 0; q < 4; ++q) { const int id = tid + 512 * q; *(LAS u32x4*)(Vs + (id >> 4) * VS + (id & 15) * 16) = R.vreg[q]; *(LAS u32x4*)(Ss + (id >> 3) * KS + (id & 7) * 16) = R.sreg[q]; }
    if (hn >= 0) r3_load(R, w, lane, hn, nn, QR, KR, VR, SP);
    __syncthreads();
    u32x2 greg[8];
#pragma unroll
    for (int d = 0; d < 8; ++d) greg[d] = *(const u32x2*)(GR + (size_t)t * 512 + h * 128 + 16 * d + 4 * g);
    float cf[4], cb[4];
#pragma unroll
    for (int r = 0; r < 4; ++r) { cf[r] = __expf(-lgf * (float)r); cb[r] = __expf(lgb * (float)r); }
    bf16x8 kfr[8][2];
#pragma unroll
    for (int jt = 0; jt < 8; ++jt)
#pragma unroll
        for (int ks = 0; ks < 2; ++ks) kfr[jt][ks] = *(LAS bf16x8*)(Ks + (16 * jt + li) * KS + (32 * ks + 8 * g) * 2);
#pragma unroll
    for (int jt = 0; jt < 8; ++jt) { f32x4 s = {0.f, 0.f, 0.f, 0.f};
#pragma unroll
        for (int ks = 0; ks < 2; ++ks) s = RET_MFMA(kfr[jt][ks], qa[ks], s);
        const int df0 = i - (16 * jt + 4 * g); const float ef0 = __expf(lgf * (float)df0), eb0 = __expf(-lgb * (float)df0);
        float p[4];
#pragma unroll
        for (int r = 0; r < 4; ++r) p[r] = s[r] * ((df0 - r >= 0) ? ef0 * cf[r] : eb0 * cb[r]);
        u32x2 pw; pw.x = pk2(p[0], p[1]); pw.y = pk2(p[2], p[3]);
        *(LAS u32x2*)(Ps + i * PS + (16 * jt + 4 * g) * 2) = pw; }
    LDS_WAIT();
    f32x4 acc[8], af[8], ab[8];
#pragma unroll
    for (int d = 0; d < 8; ++d) { acc[d] = (f32x4){0.f, 0.f, 0.f, 0.f}; af[d] = acc[d]; ab[d] = acc[d]; }
#pragma unroll
    for (int ks = 0; ks < 4; ++ks) { const bf16x8 pf = *(LAS bf16x8*)(Ps + i * PS + (32 * ks + 8 * g) * 2); bf16x8 vf[8];
#pragma unroll
        for (int d = 0; d < 8; ++d) vf[d] = tr_frag(Vs, VS, 32 * ks, 16 * d, lane);
#pragma unroll
        for (int d = 0; d < 8; ++d) acc[d] = RET_MFMA(vf[d], pf, acc[d]); }
#pragma unroll
    for (int ks = 0; ks < 2; ++ks) { bf16x8 sf[8], sb[8];
#pragma unroll
        for (int d = 0; d < 8; ++d) { const int off = (16 * d + li) * KS + (32 * ks + 8 * g) * 2; sf[d] = *(LAS bf16x8*)(Ss + off); sb[d] = *(LAS bf16x8*)(Ss + 128 * KS + off); }
#pragma unroll
        for (int d = 0; d < 8; ++d) { af[d] = RET_MFMA(sf[d], qa[ks], af[d]); ab[d] = RET_MFMA(sb[d], qa[ks], ab[d]); } }
    const float xf = __expf(lgf * (float)(i + 1)), xb = __expf(lgb * (float)(128 - i));
    float s1 = 0.f;
#pragma unroll
    for (int d = 0; d < 8; ++d) { acc[d] = acc[d] + xf * af[d] + xb * ab[d]; s1 += (acc[d][0] + acc[d][1]) + (acc[d][2] + acc[d][3]); }
    s1 += __shfl_xor(s1, 16); s1 += __shfl_xor(s1, 32);
    const float mu = s1 * (1.f / 128.f); float s2 = 0.f;
#pragma unroll
    for (int d = 0; d < 8; ++d) { acc[d] = acc[d] - mu; s2 += (acc[d][0] * acc[d][0] + acc[d][1] * acc[d][1]) + (acc[d][2] * acc[d][2] + acc[d][3] * acc[d][3]); }
    s2 += __shfl_xor(s2, 16); s2 += __shfl_xor(s2, 32);
    const float rs = rsqrtf(s2 * (1.f / 128.f) + EPS);
#pragma unroll
    for (int d = 0; d < 8; ++d) { const int c0 = h * 128 + 16 * d + 4 * g; const f32x4 gg = *(const f32x4*)(gn_g + c0), bb = *(const f32x4*)(gn_b + c0); const u32x2 gr = greg[d];
        const float r0 = __uint_as_float(gr.x << 16), r1 = __uint_as_float(gr.x & 0xffff0000u), r2 = __uint_as_float(gr.y << 16), r3 = __uint_as_float(gr.y & 0xffff0000u);
        u32x2 o; o.x = pk2((acc[d][0] * rs * gg[0] + bb[0]) * silu_f(r0), (acc[d][1] * rs * gg[1] + bb[1]) * silu_f(r1));
        o.y = pk2((acc[d][2] * rs * gg[2] + bb[2]) * silu_f(r2), (acc[d][3] * rs * gg[3] + bb[3]) * silu_f(r3));
        st8_sel(MIX + (size_t)t * 1024 + 512 + c0, o, (WT_MASK & 8) != 0); }
    __syncthreads();
}
#undef RET_MFMA
}
#ifndef FUSE67_WT
#define FUSE67_WT false
#endif
constexpr int N_PHASES = 11;
struct Args { const float* in[24]; float* out; unsigned char* ws; int ph_lo, ph_hi, flags, pad; };
__global__ void __launch_bounds__(NTHREADS, 2) mega_fwd(Args args) {
    extern __shared__ __attribute__((aligned(16))) unsigned char lds[];
    Frame F;
    F.lds = (LAS unsigned char*)lds; F.MISC = (volatile LAS unsigned*)(F.lds + MISC_OFF);
    F.tid = threadIdx.x; F.lane = F.tid & 63; F.wave = __builtin_amdgcn_readfirstlane(F.tid >> 6);
    F.G = gridDim.x; { const int bx = blockIdx.x; F.vcu = (F.G % 8 == 0) ? (bx % 8) * (F.G / 8) + bx / 8 : bx; }
    unsigned char* ws = args.ws; const float* const* in = args.in;
    F.ctl = (unsigned*)(ws + WS_CTL);
    float* MOD = (float*)(ws + WS_MOD); float* ROPE = (float*)(ws + WS_ROPE);
    int* EID = (int*)(ws + WS_EID); float* RW = (float*)(ws + WS_RW); int* LIST = (int*)(ws + WS_LIST); int* CNT = (int*)(ws + WS_CTL) + CW_CNT;
    bf16 *Wi = (bf16*)(ws + WS_WI), *Wo = (bf16*)(ws + WS_WO), *Wgu = (bf16*)(ws + WS_WGU), *Wd = (bf16*)(ws + WS_WD);
    bf16 *HX = (bf16*)(ws + WS_HX), *MIX = (bf16*)(ws + WS_MIX), *H2 = (bf16*)(ws + WS_H2), *Q = (bf16*)(ws + WS_Q), *K = (bf16*)(ws + WS_K), *V = (bf16*)(ws + WS_V);
    bf16 *QR = (bf16*)(ws + WS_QR), *KR = (bf16*)(ws + WS_KR), *VR = (bf16*)(ws + WS_VR), *GR = (bf16*)(ws + WS_GR), *SP = (bf16*)(ws + WS_SP), *ACT = (bf16*)(ws + WS_ACT), *Y = (bf16*)(ws + WS_Y);
    float* U = (float*)(ws + WS_U); bf16* XN = (bf16*)(ws + WS_XNB);
    for (int u = F.tid; u < (LDS_BYTES - LDSCTL_OFF) / 4; u += NTHREADS) ((LAS unsigned*)(F.lds + LDSCTL_OFF))[u] = 0u;
    __syncthreads();
#ifdef DIAG_STOP
    const int lo = args.ph_lo, hi = (args.ph_hi < DIAG_STOP ? args.ph_hi : DIAG_STOP);
#else
    const int lo = args.ph_lo, hi = args.ph_hi;
#endif
    XcdBarrier bar; bar.bar = (unsigned*)F.ctl + CW_BAR; bar.x = 0; bar.st = nullptr;
    if (hi - lo > 1) bar = xcd_barrier_post((unsigned*)F.ctl + CW_BAR, F.MISC + 8);
#define IN(k) (lo <= (k) && (k) < hi)
#ifndef PROBE_PHASE
#define PROBE_PHASE -1
#endif
#define PH(k, ...) do { if (IN(k)) { { __VA_ARGS__ } if (PROBE_PHASE == (k) || PROBE_PHASE == -2) { __syncthreads(); { __VA_ARGS__ } } } } while (0)
#define REFRESH() do { F.lane = fresh_lane(); F.tid = F.wave * 64 + F.lane; } while (0)
#define SEAM(k) do { if (IN(k) && IN((k) + 1)) { xcd_barrier(bar, F.wave == 0 && fresh_lane() == 0); } REFRESH(); } while (0)
    const int gw = F.vcu * NWAVES + F.wave, NGW = F.G * NWAVES;
    REFRESH();

#ifdef DIAG_FLAG
    if (IN(0)) { int* FLAG = (int*)(ws + WS_EID + 512 * 1024); for (int i = F.vcu * NTHREADS + F.tid; i < 2 * SEQ; i += F.G * NTHREADS) FLAG[i] = 0; }
#endif
#ifdef DIAG_CK
#define CKBUF(ptr, n16) do { const u32x4* cp_ = (const u32x4*)(ptr); unsigned cx_ = 0; \
        for (size_t q_ = (size_t)F.vcu * NTHREADS + F.tid; q_ < (size_t)(n16); q_ += (size_t)F.G * NTHREADS) { const u32x4 w_ = cp_[q_]; const unsigned k_ = (unsigned)(q_ * 2654435761ull) | 1u; \
            cx_ ^= (w_.x * k_) ^ (w_.y * (k_ + 2u)) ^ (w_.z * (k_ + 4u)) ^ (w_.w * (k_ + 6u)); } \
        _Pragma("unroll") for (int o_ = 1; o_ < 64; o_ <<= 1) cx_ ^= (unsigned)__shfl_xor((int)cx_, o_); \
        if (F.lane == 0) atomicXor((unsigned*)(CNT) + 64, cx_); } while (0)
#else
#define CKBUF(ptr, n16) do {} while (0)
#endif
    PH(0,  const P0Args a{(unsigned*)F.ctl + CW_MODCNT, in[1], in[3], in[4], in[5], in[7], in[14], in[20], in[21], in[22], in[16], in[18], MOD, ROPE, (float*)(ws + WS_RTW), Wi, Wo, Wgu, Wd}; p0_prologue(F, a); );
    REFRESH();
#ifdef PROBE_BAR
    if (hi - lo > 1) { for (int q = 0; q < PROBE_BAR; ++q) xcd_barrier(bar, F.wave == 0 && fresh_lane() == 0); }
#endif
    PH(1,  wait_ge((unsigned*)F.ctl + CW_MODCNT, 192u, F.tid == 0, (unsigned*)F.ctl + CW_TMO); { int r = gw; for (; r + 3 * NGW < NKV; r += 4 * NGW) { const int rows[4] = {r, r + NGW, r + 2 * NGW, r + 3 * NGW}; norm1_rows<4>(rows, F.lane, in[0], in[2], in[6], MOD, HX); }
            for (; r < NKV; r += NGW) { const int rows[1] = {r}; norm1_rows<1>(rows, F.lane, in[0], in[2], in[6], MOD, HX); } } );
    SEAM(1);
#if defined(DIAG_CK) && DIAG_CK == 4
    CKBUF(HX, (size_t)NKV * DM / 8);
#endif
#if defined(DIAG_CK) && DIAG_CK == 7
    CKBUF(Wi, (size_t)NPROJ * DM / 8); CKBUF(MOD, 12288 / 4); CKBUF(ROPE, 8192 / 4);
#endif
    PH(2,
        pg8::Gemm g{HX, Wi, NKV, NPROJ, DM}; pg8::StaticOrder S; S.init(NKV, NPROJ, F.G, (int)blockIdx.x);
        pg8::EpiInProj E{Q, K, V, QR, KR, VR, GR, in[8], in[9], ROPE}; pg8::AMapDirect AM;
        pg8::gemm_phase<pg8::EpiInProj, pg8::StaticOrder, pg8::AMapDirect, true, true>(F.lds + RING_OFF, g, S, E, AM, F.tid);
        {
          const int nun = (NKV / 256) * (NPROJ / 256), maxu = (nun + F.G - 1) / F.G, first_idle = nun - (maxu - 1) * F.G, bx = (int)blockIdx.x;
          const P0Args a{(unsigned*)F.ctl + CW_MODCNT, in[1], in[3], in[4], in[5], in[7], in[14], in[20], in[21], in[22], in[16], in[18], MOD, ROPE, (float*)(ws + WS_RTW), Wi, Wo, Wgu, Wd};
          if (maxu >= 2 && first_idle < F.G) { if (bx >= first_idle) { REFRESH(); convert_items(F, a, P0_ITEMS, CV_ITEMS, (bx - first_idle) * NWAVES + F.wave, (F.G - first_idle) * NWAVES); } }
          else { REFRESH(); convert_items(F, a, P0_ITEMS, CV_ITEMS, F.vcu * NWAVES + F.wave, F.G * NWAVES); } }
    );
    SEAM(2);
#if defined(DIAG_CK) && DIAG_CK == 3
    CKBUF(Q, (size_t)SEQ * 512 / 8); CKBUF(K, (size_t)2 * NKV * 64 / 8); CKBUF(V, (size_t)2 * NKV * 64 / 8);
#endif
#if defined(DIAG_CK) && DIAG_CK == 5
    CKBUF(QR, (size_t)4 * SEQ * 64 / 8); CKBUF(KR, (size_t)4 * NKV * 64 / 8); CKBUF(VR, (size_t)4 * NKV * 128 / 8); CKBUF(GR, (size_t)SEQ * 512 / 8);
#endif
    if (IN(5)) {
        unsigned* r1cnt = (unsigned*)F.ctl + CW_R1CNT; unsigned* sccnt = (unsigned*)F.ctl + CW_SCANCNT; unsigned* tmo = (unsigned*)F.ctl + CW_TMO;
        const bool do_att = (args.flags & 1) != 0, do_ret = (args.flags & 2) != 0;
        const int ah = (F.G == 256) ? (((F.vcu >> 5) & 1) * 4 + (F.vcu >> 6)) : 0, ac = F.vcu & 31;
        for (int rep = 0; rep < ((PROBE_PHASE == 5 || PROBE_PHASE == 3 || PROBE_PHASE == -2) ? 2 : 1); ++rep) {
        const bool att = do_att && (rep == 0 || PROBE_PHASE != 3), retp = do_ret && (rep == 0 || PROBE_PHASE != 5);
        if (retp) { for (int q = 0; q < (PROBE_PHASE == 31 ? 2 : 1); ++q) for (int u = F.vcu; u < 4 * ret::NCH; u += F.G) { const int h = u & 3, j = u >> 2; ret::r1_unit(F, h, j, KR, VR, lsig(in[10][h]), lsig(in[11][h]), U); }
            if (rep == 0) { if (RET_WT) publish_add_wt(r1cnt, F.tid == 0); else publish_add(r1cnt, F.tid == 0); } }
        if (att) { if (F.G == 256) { attn_body::attn_unit<8>(ah, ac, Q, K, V, MIX, (char*)lds + RING_OFF, F.tid); }
                   else { for (int u = F.vcu; u < 512; u += 2 * F.G) attn_body::attn_unit<8>(u >> 6, u & 63, Q, K, V, MIX, (char*)lds + RING_OFF, F.tid); } }
        REFRESH();
        if (retp) { wait_ge(r1cnt, (unsigned)F.G, F.tid == 0, tmo, !(RET_WT && (NOACQ_MASK & 1)));
            for (int q = 0; q < (PROBE_PHASE == 32 ? 2 : 1); ++q) for (int b = F.vcu; b < 256; b += F.G) ret::r2_scan_block(F, b, U, in[10], in[11], SP);
            if (rep == 0) { if (RET_WT) publish_add_wt(sccnt, F.tid == 0); else publish_add(sccnt, F.tid == 0); } }
        if (att) { if (F.G == 256) { attn_body::attn_unit<8>(ah, ac + 32, Q, K, V, MIX, (char*)lds + RING_OFF, F.tid); }
                   else { for (int u = F.vcu + F.G; u < 512; u += 2 * F.G) attn_body::attn_unit<8>(u >> 6, u & 63, Q, K, V, MIX, (char*)lds + RING_OFF, F.tid); } }
        REFRESH();
        if (retp) { wait_ge(sccnt, (unsigned)F.G, F.tid == 0, tmo, !(RET_WT && (NOACQ_MASK & 2)));
            for (int q = 0; q < (PROBE_PHASE == 33 ? 2 : 1); ++q) { ret::R3Regs R3; if (F.vcu < 512) ret::r3_load(R3, F.wave, fresh_lane(), F.vcu & 3, F.vcu >> 2, QR, KR, VR, SP);
              for (int u = F.vcu; u < 512; u += F.G) { const int h = u & 3, n = u >> 2, un = u + F.G; ret::r3_unit(F, R3, h, n, un < 512 ? (un & 3) : -1, un >> 2, QR, KR, VR, GR, SP, lsig(in[10][h]), lsig(in[11][h]), in[12], in[13], MIX); } } }
        }
    }
    SEAM(5);
#if defined(DIAG_CK) && DIAG_CK == 2
    CKBUF(MIX, (size_t)SEQ * DM / 8);
#endif
#if defined(DIAG_CK) && (DIAG_CK == 8 || DIAG_CK == 9)
    { const u32x4* cp_ = (const u32x4*)MIX; unsigned cx_ = 0;
      for (size_t q_ = (size_t)F.vcu * NTHREADS + F.tid; q_ < (size_t)SEQ * DM / 8; q_ += (size_t)F.G * NTHREADS) { if ((((q_ & 127) < 64) ? 8 : 9) != DIAG_CK) continue; const u32x4 w_ = cp_[q_]; const unsigned k_ = (unsigned)(q_ * 2654435761ull) | 1u;
          cx_ ^= (w_.x * k_) ^ (w_.y * (k_ + 2u)) ^ (w_.z * (k_ + 4u)) ^ (w_.w * (k_ + 6u)); }
#pragma unroll
      for (int o_ = 1; o_ < 64; o_ <<= 1) cx_ ^= (unsigned)__shfl_xor((int)cx_, o_);
      if (F.lane == 0) atomicXor((unsigned*)(CNT) + 64, cx_); }
#endif
#if defined(DIAG_CK) && DIAG_CK == 6
    CKBUF(SP, (size_t)4 * 128 * 2 * 8192 / 8); CKBUF(U, (size_t)4 * 130 * 2 * 8192 / 4);
#endif
    const bool fuse67 = IN(6) && IN(7) && F.G == 256 && PROBE_PHASE != 6 && PROBE_PHASE != -2;
    if (PROBE_PHASE == 66 && IN(6)) { pg8::Gemm g{MIX, Wo, SEQ, DM, DM}; pg8::StaticOrder S; S.init(SEQ, DM, F.G, (int)blockIdx.x); pg8::EpiOutProj<false> E{in[0], MOD + 2048, XN}; pg8::AMapDirect AM;
        pg8::gemm_phase<pg8::EpiOutProj<false>, pg8::StaticOrder, pg8::AMapDirect, true, true>(F.lds + RING_OFF, g, S, E, AM, F.tid); REFRESH(); }
    if (fuse67) {
        pg8::Gemm g{MIX, Wo, SEQ, DM, DM}; pg8::StaticOrder S; S.init(SEQ, DM, F.G, (int)blockIdx.x);
        pg8::EpiOutProj<FUSE67_WT> E{in[0], MOD + 2048, XN}; pg8::AMapDirect AM;
        pg8::gemm_phase<pg8::EpiOutProj<FUSE67_WT>, pg8::StaticOrder, pg8::AMapDirect, true, true>(F.lds + RING_OFF, g, S, E, AM, F.tid);
    } else {
    PH(6,
        pg8::Gemm g{MIX, Wo, SEQ, DM, DM}; pg8::StaticOrder S; S.init(SEQ, DM, F.G, (int)blockIdx.x);
        pg8::EpiOutProj<false> E{in[0], MOD + 2048, XN}; pg8::AMapDirect AM;
        pg8::gemm_phase<pg8::EpiOutProj<false>, pg8::StaticOrder, pg8::AMapDirect, true, true>(F.lds + RING_OFF, g, S, E, AM, F.tid);
    );
    }
    if (fuse67) {
        pg8::StaticOrder S; S.init(SEQ, DM, F.G, (int)blockIdx.x); pg8::Unit u; (void)S.next(0, u);
        unsigned* pc = (unsigned*)F.ctl + CW_PANEL + 64 * u.pm;
        REFRESH();
        if (FUSE67_WT) publish_add_wt(pc, F.tid == 0); else publish_add(pc, F.tid == 0);
        route_stage_weights(F, (const float*)(ws + WS_RTW));
        wait_ge(pc, 4u, F.tid == 0, (unsigned*)F.ctl + CW_TMO, !(FUSE67_WT && (NOACQ_MASK & 4)));
        { const int tb = u.pm * 256 + u.pn * 64 + F.wave * 8; RouteOut ro[8];
          f32x4 wgr[4][4];
          { const LAS float* wgT = (const LAS float*)(F.lds + RT_OFF);
#pragma unroll
            for (int c = 0; c < 4; ++c)
#pragma unroll
                for (int j = 0; j < 4; ++j) wgr[c][j] = *(const LAS f32x4*)(wgT + c * 1024 + 4 * F.lane + 256 * j); }
          f32x4 gms[2][4];
#pragma unroll
          for (int j = 0; j < 4; ++j) { const int n = 4 * F.lane + 256 * j; const f32x4 g = *(const f32x4*)(in[15] + n), sc = *(const f32x4*)(MOD + 4096 + n); gms[0][j] = g * (sc + 1.f); gms[1][j] = *(const f32x4*)(MOD + 3072 + n); }
          f32x4 xa[4], xb[4]; route_load_row(tb, F.lane, XN, xa);
#pragma unroll
          for (int k = 0; k < 8; k += 2) { route_load_row(tb + k + 1, F.lane, XN, xb); route_row_pre<2>(F, tb + k, xa, in[15], MOD, in[17], in[19], H2, EID, RW, CNT, LIST, &ro[k], wgr, gms);
              if (k + 2 < 8) route_load_row(tb + k + 2, F.lane, XN, xa); route_row_pre<2>(F, tb + k + 1, xb, in[15], MOD, in[17], in[19], H2, EID, RW, CNT, LIST, &ro[k + 1], wgr, gms); }
          int ea = ro[0].ea, eb = ro[0].eb; float w1 = ro[0].w1, w2 = ro[0].w2;
#pragma unroll
          for (int k = 1; k < 8; ++k) if (F.lane == k) { ea = ro[k].ea; eb = ro[k].eb; w1 = ro[k].w1; w2 = ro[k].w2; }
          if (PROBE_PHASE == 77) {
#pragma unroll
              for (int k = 0; k < 8; ++k) { f32x4 xv[4]; route_load_row(tb + k, F.lane, XN, xv); route_row_pre<2>(F, tb + k, xv, in[15], MOD, in[17], in[19], H2, EID, RW, CNT, LIST, &ro[k]); } }
          if (F.lane < 8) { const int t = tb + F.lane; EID[2 * t] = ea; EID[2 * t + 1] = eb; RW[2 * t] = w1; RW[2 * t + 1] = w2;
              const int sa = atomicAdd(CNT + ea, 1), sb = atomicAdd(CNT + eb, 1);
              __hip_atomic_store(LIST + ea * SEQ + sa, 2 * t, __ATOMIC_RELAXED, __HIP_MEMORY_SCOPE_AGENT); __hip_atomic_store(LIST + eb * SEQ + sb, 2 * t + 1, __ATOMIC_RELAXED, __HIP_MEMORY_SCOPE_AGENT); } }
        __syncthreads();
    } else {
    SEAM(6);
    if (IN(7)) { route_stage_weights(F, (const float*)(ws + WS_RTW)); for (int t = gw; t < SEQ; t += NGW) route_row_lds<1>(F, t, XN, in[15], MOD, in[17], in[19], H2, EID, RW, CNT, LIST);
        if (PROBE_PHASE == 7 || PROBE_PHASE == -2) { for (int t = gw; t < SEQ; t += NGW) route_row_lds<0>(F, t, XN, in[15], MOD, in[17], in[19], H2, EID, RW, CNT, LIST); }
        __syncthreads(); }
    }
    SEAM(7);
#ifdef DIAG_THRASH
#define THRASH(src) do { const f32x4* tp = (const f32x4*)(src) + (size_t)F.vcu * 16384; f32x4 ts = {0.f, 0.f, 0.f, 0.f}; \
        for (int q = F.tid; q < 16384; q += NTHREADS) ts += tp[q]; \
        if (ts.x + ts.y + ts.z + ts.w == 12345.678f) ((float*)(ws + WS_CTL))[2000 + (F.tid & 7)] = ts.x; __syncthreads(); } while (0)
#else
#define THRASH(src) do {} while (0)
#endif
    THRASH(in[20]);
    const bool fuse89 = IN(8) && IN(9) && F.G == 256 && PROBE_PHASE != 8 && PROBE_PHASE != 9 && PROBE_PHASE != -2;
    if (fuse89) {
        moe_build_table(F, CNT);
        pg8::MoeTable mt{(const LAS int*)(F.lds + TT_OFF), LIST}; unsigned* tcnt = (unsigned*)F.ctl + CW_TILE;
        { pg8::Gemm g{H2, Wgu, 0, 0, DM}; pg8::MoeOrder1 S{mt, F.G, F.vcu, tcnt}; pg8::EpiSwiGLU<true> E{ACT}; pg8::AMapGather AM{mt};
          pg8::gemm_phase<pg8::EpiSwiGLU<true>, pg8::MoeOrder1, pg8::AMapGather, true, true>(F.lds + RING_OFF, g, S, E, AM, F.tid); }
        REFRESH();
        { pg8::Gemm g{ACT, Wd, 0, 0, DEXP}; pg8::MoeOrder2 S{mt, F.G, F.vcu, F.wave, tcnt, (unsigned*)F.ctl + CW_TMO}; pg8::EpiScatter E{mt, Y, (int*)(ws + WS_EID + 512 * 1024)}; pg8::AMapDirect AM;
          pg8::gemm_phase<pg8::EpiScatter, pg8::MoeOrder2, pg8::AMapDirect, true, true>(F.lds + RING_OFF, g, S, E, AM, F.tid); }
    } else {
    PH(8,
        moe_build_table(F, CNT);
        pg8::MoeTable mt{(const LAS int*)(F.lds + TT_OFF), LIST};
        pg8::Gemm g{H2, Wgu, 0, 0, DM}; pg8::MoeOrder S{mt, F.G, F.vcu}; pg8::EpiSwiGLU<false> E{ACT}; pg8::AMapGather AM{mt};
        pg8::gemm_phase<pg8::EpiSwiGLU<false>, pg8::MoeOrder, pg8::AMapGather, true, true>(F.lds + RING_OFF, g, S, E, AM, F.tid);
    );
    SEAM(8);
    THRASH(in[21]);
    PH(9,
        moe_build_table(F, CNT);
        pg8::MoeTable mt{(const LAS int*)(F.lds + TT_OFF), LIST};
        pg8::Gemm g{ACT, Wd, 0, 0, DEXP}; pg8::MoeOrder S{mt, F.G, F.vcu}; pg8::EpiScatter E{mt, Y, (int*)(ws + WS_EID + 512 * 1024)}; pg8::AMapDirect AM;
        pg8::gemm_phase<pg8::EpiScatter, pg8::MoeOrder, pg8::AMapDirect, true, true>(F.lds + RING_OFF, g, S, E, AM, F.tid);
    );
    }
    SEAM(9);
    THRASH(in[22]);
#ifdef DIAG_CK
    float diag_scale = 1.f;
    if (IN(10)) { const unsigned cur = __hip_atomic_load((unsigned*)(CNT) + 64, __ATOMIC_RELAXED, __HIP_MEMORY_SCOPE_AGENT); unsigned* prev = (unsigned*)(ws + 264 * MiB);
        const unsigned p0 = __hip_atomic_load(prev, __ATOMIC_RELAXED, __HIP_MEMORY_SCOPE_AGENT), p1 = __hip_atomic_load(prev + 1, __ATOMIC_RELAXED, __HIP_MEMORY_SCOPE_AGENT);
        if (p1 == (p0 ^ 0x5a5a1234u) && p0 != cur) diag_scale = 3.f; }
#endif
#ifdef DIAG_FLAG
    if (IN(10)) { const int* FLAG = (const int*)(ws + WS_EID + 512 * 1024); for (int t = gw; t < SEQ; t += NGW) { if (FLAG[2 * t] != 1 || FLAG[2 * t + 1] != 1) { const float qn = __builtin_nanf(""); for (int i = F.lane; i < DM; i += 64) Y[(size_t)t * DM + i] = 0x7fc0; (void)qn; } } }
#endif
    if (IN(10)) { if (PROBE_PHASE == 10 || PROBE_PHASE == -2) { for (int t = gw; t < SEQ; t += NGW) final_row(t, F.lane, XN, Y, RW, MOD, in[23], (float*)(ws + WS_HX)); }
        { int t = gw; for (; t + 3 * NGW < SEQ; t += 4 * NGW) { const int rows[4] = {t, t + NGW, t + 2 * NGW, t + 3 * NGW}; final_rows<4>(rows, F.lane, XN, Y, RW, MOD, in[23], args.out); }
          for (; t < SEQ; t += NGW) final_row(t, F.lane, XN, Y, RW, MOD, in[23], args.out); } }
#ifdef DIAG_CK
    if (IN(10)) { __syncthreads(); if (diag_scale != 1.f) { for (int t = gw; t < SEQ; t += NGW) for (int i = F.lane; i < DM; i += 64) args.out[(size_t)t * DM + i] *= diag_scale; }
        if (blockIdx.x == 0 && F.tid == 0) { const unsigned cur = __hip_atomic_load((unsigned*)(CNT) + 64, __ATOMIC_RELAXED, __HIP_MEMORY_SCOPE_AGENT); unsigned* prev = (unsigned*)(ws + 264 * MiB);
            __hip_atomic_store(prev, cur, __ATOMIC_RELAXED, __HIP_MEMORY_SCOPE_AGENT); __hip_atomic_store(prev + 1, cur ^ 0x5a5a1234u, __ATOMIC_RELAXED, __HIP_MEMORY_SCOPE_AGENT); } }
#endif
    if (PROBE_PHASE == 108 || PROBE_PHASE == 109) { xcd_barrier(bar, F.wave == 0 && fresh_lane() == 0); REFRESH();
        moe_build_table(F, CNT); pg8::MoeTable mt{(const LAS int*)(F.lds + TT_OFF), LIST}; pg8::MoeOrder S{mt, F.G, F.vcu};
        if (PROBE_PHASE == 108) { pg8::Gemm g{H2, Wgu, 0, 0, DM}; pg8::EpiSwiGLU<false> E{ACT}; pg8::AMapGather AM{mt};
            pg8::gemm_phase<pg8::EpiSwiGLU<false>, pg8::MoeOrder, pg8::AMapGather, true, true>(F.lds + RING_OFF, g, S, E, AM, F.tid); }
        else { pg8::Gemm g{ACT, Wd, 0, 0, DEXP}; pg8::EpiScatter E{mt, Y, (int*)(ws + WS_EID + 512 * 1024)}; pg8::AMapDirect AM;
            pg8::gemm_phase<pg8::EpiScatter, pg8::MoeOrder, pg8::AMapDirect, true, true>(F.lds + RING_OFF, g, S, E, AM, F.tid); } }
    if (PROBE_PHASE == 100) { REFRESH(); const P0Args a{(unsigned*)F.ctl + CW_MODCNT, in[1], in[3], in[4], in[5], in[7], in[14], in[20], in[21], in[22], in[16], in[18], MOD, ROPE, (float*)(ws + WS_RTW), Wi, Wo, Wgu, Wd}; p0_prologue(F, a); }
#undef IN
#undef SEAM
}

#ifndef FAST_MASK
#define FAST_MASK 0xff
#endif
#ifndef ONE_LAUNCH
#define ONE_LAUNCH 0
#endif
static int g_grid = 0;
static void launch_fast(Args a, int lo, int hi, int flags, hipStream_t stream) {
    a.ph_lo = lo; a.ph_hi = hi; a.flags = flags; a.pad = 0;
    hipLaunchKernelGGL(mega_fwd, dim3(g_grid), dim3(NTHREADS), LDS_BYTES, stream, a);
}
extern "C" void kernel_launch(void* const* d_in, const int* in_sizes, int n_in, void* d_out, int out_size, void* d_ws, size_t ws_size, hipStream_t stream) {
    if (n_in != 24 || out_size != SEQ * DM || ws_size < WS_END) { fprintf(stderr, "kernel_launch: unexpected shapes / workspace (%d inputs, out %d, ws %zu < %zu)\n", n_in, out_size, ws_size, (size_t)WS_END); return; }
    if (g_grid == 0) {
        int dev = 0, cus = 0;
        if (hipGetDevice(&dev) != hipSuccess || hipDeviceGetAttribute(&cus, hipDeviceAttributeMultiprocessorCount, dev) != hipSuccess) { g_grid = -1; return; }
        if (hipFuncSetAttribute((const void*)mega_fwd, hipFuncAttributeMaxDynamicSharedMemorySize, LDS_BYTES) != hipSuccess) { g_grid = -1; return; }
        int per_cu = 0; (void)hipOccupancyMaxActiveBlocksPerMultiprocessor(&per_cu, (const void*)mega_fwd, NTHREADS, LDS_BYTES); (void)hipGetLastError();
        g_grid = cus;
    }
    if (g_grid < 0) return;
    const float* const* in = (const float* const*)d_in;
    unsigned char* ws = (unsigned char*)d_ws; float* out = (float*)d_out;
    (void)hipMemsetAsync(ws + WS_CTL, 0, CTL_ZERO_BYTES, stream);
    Args a{}; for (int i = 0; i < 24; ++i) a.in[i] = in[i]; a.out = out; a.ws = ws;
#if ONE_LAUNCH
    launch_fast(a, 0, N_PHASES, 3, stream);
#ifdef DIAG_2LAUNCH
    (void)hipMemsetAsync(ws + WS_CTL, 0, CTL_ZERO_BYTES, stream); launch_fast(a, 0, N_PHASES, 3, stream);
#endif
#ifdef DIAG_RERUN_LO
    (void)hipMemsetAsync(ws + WS_CTL + 4 * CW_MODCNT, 0, CTL_ZERO_BYTES - 4 * CW_MODCNT, stream); launch_fast(a, DIAG_RERUN_LO, DIAG_RERUN_HI, DIAG_RERUN_FLAGS, stream);
#endif
#else
    float* MOD = (float*)(ws + WS_MOD); float* ROPE = (float*)(ws + WS_ROPE);
    int* EID = (int*)(ws + WS_EID); float* RW = (float*)(ws + WS_RW); int* LIST = (int*)(ws + WS_LIST); int* CNT = (int*)(ws + WS_CTL) + CW_CNT;
    bf16 *HX = (bf16*)(ws + WS_HX), *MIX = (bf16*)(ws + WS_MIX), *H2 = (bf16*)(ws + WS_H2), *Q = (bf16*)(ws + WS_Q), *K = (bf16*)(ws + WS_K), *V = (bf16*)(ws + WS_V);
    bf16 *QR = (bf16*)(ws + WS_QR), *KR = (bf16*)(ws + WS_KR), *VR = (bf16*)(ws + WS_VR), *GR = (bf16*)(ws + WS_GR), *Y = (bf16*)(ws + WS_Y);
    (void)EID; (void)RW; (void)LIST; (void)CNT; (void)H2; (void)Y;
    const int FM = FAST_MASK;
    if (FM & 1) launch_fast(a, 0, 1, 0, stream);
    if (!(FM & 1)) { nv::k_mod<<<dim3(24, 2), 256, 0, stream>>>(in[1], in[3], in[4], in[5], MOD); nv::k_rope<<<16, 256, 0, stream>>>(ROPE); }
    if (FM & 2) launch_fast(a, 1, 2, 0, stream); else nv::k_norm1<<<NKV, 256, 0, stream>>>(in[0], in[2], in[6], MOD, HX);
#ifdef DUP_P2
    launch_fast(a, 2, 3, 0, stream);
#endif
    if (FM & 4) launch_fast(a, 2, 3, 0, stream); else nv::k_inproj<<<dim3(36, NKV / 64), 256, 0, stream>>>(HX, in[7], in[8], in[9], ROPE, Q, K, V, QR, KR, VR, GR);
    if (FM & 8) { launch_fast(a, 3, 4, 0, stream); launch_fast(a, 4, 5, 0, stream); launch_fast(a, 5, 6, 2, stream);
#ifdef DUP_R3
    launch_fast(a, 5, 6, 2, stream);
#endif
    }
    else nv::k_ret<<<dim3(SEQ / 128, 4), 256, 0, stream>>>(QR, KR, VR, GR, in[10], in[11], in[12], in[13], MIX);
    if (FM & 16) launch_fast(a, 5, 6, 1, stream); else nv::k_attn<<<dim3(SEQ / 256, 8), 256, 0, stream>>>(Q, K, V, MIX);
    if (FM & 32) launch_fast(a, 6, 7, 0, stream); else nv::k_outproj<<<dim3(16, SEQ / 64), 256, 0, stream>>>(MIX, in[14], in[0], MOD, out);
    launch_fast(a, 7, 8, 0, stream);
    if (FM & 64) { launch_fast(a, 8, 9, 0, stream); launch_fast(a, 9, 10, 0, stream); }
    else nv::k_moe<<<dim3(SEQ / 8, NEXP), 256, 0, stream>>>(H2, CNT, LIST, in[20], in[21], in[22], Y);
    launch_fast(a, 10, 11, 0, stream);
#endif
}
```

```cpp
#define ONE_LAUNCH 1
#define FILL_ITEMS 16384
#define NT_POLICY 1
#define FUSE67_WT true
#define RET_WT 1
#define WT_MASK 3
#define MOE_NOACQ 1
#define ACT_ST16 1
#include <hip/hip_runtime.h>
#include <cstdio>
#include <cstdint>
#include <cmath>

constexpr int DM = 1024, SEQ = 16384, CL = 256, NKV = SEQ + CL  , GRIDW = 64, NPROJ = 2304;
constexpr int NEXP = 32, DEXP = 512;
constexpr float EPS = 1e-6f;
constexpr float QSCALE = 0.125f * 1.4426950408889634f;
typedef unsigned short bf16;
typedef float f32x4 __attribute__((ext_vector_type(4)));
typedef unsigned u32x4 __attribute__((ext_vector_type(4)));
typedef unsigned u32x2 __attribute__((ext_vector_type(2)));

__host__ __device__ __forceinline__ float bf2f(bf16 v) { union { unsigned u; float f; } c; c.u = ((unsigned)v) << 16; return c.f; }
__host__ __device__ __forceinline__ bf16 f2bf(float f) { union { unsigned u; float f; } c; c.f = f; return (bf16)((c.u + 0x7fffu + ((c.u >> 16) & 1u)) >> 16); }
__device__ __forceinline__ unsigned pk2(float lo, float hi) { unsigned r; asm("v_cvt_pk_bf16_f32 %0, %1, %2" : "=v"(r) : "v"(lo), "v"(hi)); return r; }
#ifndef WSUM_DPP
#define WSUM_DPP 0
#endif
__device__ __forceinline__ float dpp_add_(float v, const int ctrl_sel) {
    int r; const int iv = __float_as_int(v);
    switch (ctrl_sel) { case 0: r = __builtin_amdgcn_update_dpp(iv, iv, 0xB1, 0xF, 0xF, false); break;
                        case 1: r = __builtin_amdgcn_update_dpp(iv, iv, 0x4E, 0xF, 0xF, false); break;
                        case 2: r = __builtin_amdgcn_update_dpp(iv, iv, 0x141, 0xF, 0xF, false); break;
                        default: r = __builtin_amdgcn_update_dpp(iv, iv, 0x140, 0xF, 0xF, false); break; }
    return v + __int_as_float(r);
}
__device__ __forceinline__ float wave_sum(float v) {
#if WSUM_DPP
    v = dpp_add_(v, 0); v = dpp_add_(v, 1); v = dpp_add_(v, 2); v = dpp_add_(v, 3);
    { auto rr = __builtin_amdgcn_permlane16_swap(__float_as_uint(v), __float_as_uint(v), false, false); v = __uint_as_float(rr[0]) + __uint_as_float(rr[1]); }
    { auto rr = __builtin_amdgcn_permlane32_swap(__float_as_uint(v), __float_as_uint(v), false, false); v = __uint_as_float(rr[0]) + __uint_as_float(rr[1]); }
    return v;
#else
#pragma unroll
    for (int o = 1; o < 64; o <<= 1) v += __shfl_xor(v, o);
    return v;
#endif
}

#ifdef NT_POLICY
#define NT_LD(p) __builtin_nontemporal_load(p)
#define NT_ST(v, p) __builtin_nontemporal_store(v, p)
#else
#define NT_LD(p) (*(p))
#define NT_ST(v, p) (*(p) = (v))
#endif
#ifndef WT_MASK
#define WT_MASK 0
#endif
__device__ __forceinline__ void st16_sel(void* p, u32x4 v, bool wt) { if (wt) asm volatile("global_store_dwordx4 %0, %1, off sc1\n\ts_nop 1" :: "v"(p), "v"(v) : "memory"); else *(u32x4*)p = v; }
#define ATTN_STORE16(p, v) st16_sel((p), (v), (WT_MASK & 4) != 0)
__device__ __forceinline__ void st8_sel(void* p, u32x2 v, bool wt) { if (wt) asm volatile("global_store_dwordx2 %0, %1, off sc1\n\ts_nop 1" :: "v"(p), "v"(v) : "memory"); else *(u32x2*)p = v; }

__device__ __forceinline__ int fresh_lane() { int l; asm volatile("v_mbcnt_lo_u32_b32 %0, -1, 0\n\tv_mbcnt_hi_u32_b32 %0, -1, %0" : "=v"(l)); return l; }

constexpr size_t MiB = 1u << 20;
constexpr size_t WS_CTL = 0, CTL_ZERO_BYTES = 128 * 1024;
constexpr size_t WS_MOD = 1 * MiB;
constexpr size_t WS_ROPE = 1 * MiB + 64 * 1024;
constexpr size_t WS_RTW = 1 * MiB + 128 * 1024;
constexpr size_t WS_EID = 2 * MiB;
constexpr size_t WS_RW = 2 * MiB + 256 * 1024;
constexpr size_t WS_LIST = 3 * MiB;
constexpr size_t WS_WI = 6 * MiB;
constexpr size_t WS_WO = 11 * MiB;
constexpr size_t WS_WGU = 13 * MiB;
constexpr size_t WS_WD = 77 * MiB;
constexpr size_t WS_HX = 109 * MiB;
constexpr size_t WS_MIX = WS_HX, WS_H2 = WS_HX;
constexpr size_t WS_Q = 142 * MiB;
constexpr size_t WS_K = 158 * MiB;
constexpr size_t WS_V = WS_K + 4352 * 1024;
constexpr size_t WS_QR = WS_V + 4352 * 1024;
constexpr size_t WS_KR = WS_QR + 8 * MiB;
constexpr size_t WS_VR = WS_KR + 8448 * 1024;
constexpr size_t WS_GR = WS_VR + 16896 * 1024;
constexpr size_t WS_U = WS_GR + 16 * MiB;
constexpr size_t WS_SP = WS_U + 33280 * 1024;
constexpr size_t WS_C_END = WS_SP + 16 * MiB;
constexpr size_t WS_ACT = 142 * MiB;
constexpr size_t WS_Y = 182 * MiB;
constexpr size_t WS_XNB = 246 * MiB;
constexpr size_t WS_END = WS_XNB + 32 * MiB;
constexpr int CW_TMO = 0, CW_CODE = 1, CW_CNT = 1024  , CW_MODCNT = 2048, CW_R1CNT = 2112, CW_SCANCNT = 2176, CW_BAR = 4096, CW_PANEL = 8192  , CW_TILE = 16384  ;

__device__ __forceinline__ void route_row(int t, int lane, const float* XN, const float* g2, const float* MOD, const float* wgrp, const float* bgrp,
                                          const float* wexp, const float* bexp, bf16* H2, int* EID, float* RW, int* CNT, int* LIST) {
    const f32x4* xr = (const f32x4*)(XN + (size_t)t * DM) + lane;
    f32x4 v[4]; float ss = 0.f;
#pragma unroll
    for (int j = 0; j < 4; ++j) { v[j] = xr[64 * j]; ss += (v[j].x * v[j].x + v[j].y * v[j].y) + (v[j].z * v[j].z + v[j].w * v[j].w); }
    const float rstd = rsqrtf(wave_sum(ss) * (1.f / DM) + EPS);
    float gl[4] = {0.f, 0.f, 0.f, 0.f};
    float h[16];
#pragma unroll
    for (int j = 0; j < 4; ++j) {
        const int n = 4 * lane + 256 * j;
        const f32x4 g = *(const f32x4*)(g2 + n), sh = *(const f32x4*)(MOD + 3072 + n), sc = *(const f32x4*)(MOD + 4096 + n);
#pragma unroll
        for (int i = 0; i < 4; ++i) { const float hv = (v[j][i] * rstd) * g[i] * (1.f + sc[i]) + sh[i]; h[4 * j + i] = hv;
            const f32x4 w = *(const f32x4*)(wgrp + (size_t)(n + i) * 4); gl[0] += hv * w.x; gl[1] += hv * w.y; gl[2] += hv * w.z; gl[3] += hv * w.w; }
        u32x2 o; o.x = pk2(h[4 * j], h[4 * j + 1]); o.y = pk2(h[4 * j + 2], h[4 * j + 3]);
        *(u32x2*)(H2 + (size_t)t * DM + n) = o;
    }
#pragma unroll
    for (int c = 0; c < 4; ++c) gl[c] = wave_sum(gl[c]) + bgrp[c];
    int g = 0; float gm = gl[0];
#pragma unroll
    for (int c = 1; c < 4; ++c) if (gl[c] > gm) { gm = gl[c]; g = c; }
    float gs = 0.f;
#pragma unroll
    for (int c = 0; c < 4; ++c) gs += expf(gl[c] - gm);
    const float pg = 1.f / gs;
    float el[8] = {0.f, 0.f, 0.f, 0.f, 0.f, 0.f, 0.f, 0.f};
#pragma unroll
    for (int j = 0; j < 4; ++j)
#pragma unroll
        for (int i = 0; i < 4; ++i) { const int n = 4 * lane + 256 * j + i; const f32x4 w0 = *(const f32x4*)(wexp + (size_t)n * 32 + g * 8), w1 = *(const f32x4*)(wexp + (size_t)n * 32 + g * 8 + 4);
            const float hv = h[4 * j + i]; el[0] += hv * w0.x; el[1] += hv * w0.y; el[2] += hv * w0.z; el[3] += hv * w0.w; el[4] += hv * w1.x; el[5] += hv * w1.y; el[6] += hv * w1.z; el[7] += hv * w1.w; }
#pragma unroll
    for (int c = 0; c < 8; ++c) el[c] = wave_sum(el[c]) + bexp[g * 8 + c];
    int j1 = 0; float m1 = el[0];
#pragma unroll
    for (int c = 1; c < 8; ++c) if (el[c] > m1) { m1 = el[c]; j1 = c; }
    int j2 = -1; float m2 = -INFINITY;
#pragma unroll
    for (int c = 0; c < 8; ++c) if (c != j1 && el[c] > m2) { m2 = el[c]; j2 = c; }
    const float e2 = expf(m2 - m1), w1 = pg / (1.f + e2), w2 = pg * e2 / (1.f + e2);
    if (lane == 0) {
        const int ea = g * 8 + j1, eb = g * 8 + j2;
        EID[2 * t] = ea; EID[2 * t + 1] = eb; RW[2 * t] = w1; RW[2 * t + 1] = w2;
        const int sa = atomicAdd(CNT + ea, 1); LIST[ea * SEQ + sa] = 2 * t;
        const int sb = atomicAdd(CNT + eb, 1); LIST[eb * SEQ + sb] = 2 * t + 1;
    }
}
template <int NB> __device__ __forceinline__ void final_rows(const int (&rows)[NB], int lane, const bf16* XN, const bf16* Y, const float* RW, const float* MOD, const float* gfin, float* out) {
    f32x4 xv[NB][4]; u32x2 ya[NB][4], yb[NB][4]; float w0[NB], w1[NB];
#pragma unroll
    for (int b = 0; b < NB; ++b) { const int t = rows[b]; w0[b] = RW[2 * t]; w1[b] = RW[2 * t + 1];
#pragma unroll
        for (int j = 0; j < 4; ++j) { const int n = 4 * lane + 256 * j; { const u32x2 xw = NT_LD((const u32x2*)(XN + (size_t)t * DM + n)); xv[b][j] = (f32x4){__uint_as_float(xw.x << 16), __uint_as_float(xw.x & 0xffff0000u), __uint_as_float(xw.y << 16), __uint_as_float(xw.y & 0xffff0000u)}; }
            ya[b][j] = NT_LD((const u32x2*)(Y + (size_t)t * DM + n)); yb[b][j] = NT_LD((const u32x2*)(Y + ((size_t)SEQ + t) * DM + n)); } }
#pragma unroll
    for (int b = 0; b < NB; ++b) { const int t = rows[b]; f32x4 v[4]; float ss = 0.f;
#pragma unroll
        for (int j = 0; j < 4; ++j) { const int n = 4 * lane + 256 * j; const f32x4 gt = *(const f32x4*)(MOD + 5120 + n); const u32x2 a = ya[b][j], c = yb[b][j];
            const float fa[4] = {__uint_as_float(a.x << 16), __uint_as_float(a.x & 0xffff0000u), __uint_as_float(a.y << 16), __uint_as_float(a.y & 0xffff0000u)};
            const float fb[4] = {__uint_as_float(c.x << 16), __uint_as_float(c.x & 0xffff0000u), __uint_as_float(c.y << 16), __uint_as_float(c.y & 0xffff0000u)};
#pragma unroll
            for (int i = 0; i < 4; ++i) { v[j][i] = xv[b][j][i] + gt[i] * (fa[i] * w0[b] + fb[i] * w1[b]); ss += v[j][i] * v[j][i]; } }
        const float rstd = rsqrtf(wave_sum(ss) * (1.f / DM) + EPS);
#pragma unroll
        for (int j = 0; j < 4; ++j) { const int n = 4 * lane + 256 * j; const f32x4 g = *(const f32x4*)(gfin + n);
            f32x4 o; o.x = v[j].x * rstd * g.x; o.y = v[j].y * rstd * g.y; o.z = v[j].z * rstd * g.z; o.w = v[j].w * rstd * g.w;
            NT_ST(o, (f32x4*)(out + (size_t)t * DM + n)); } }
}
__device__ __forceinline__ void final_row(int t, int lane, const bf16* XN, const bf16* Y, const float* RW, const float* MOD, const float* gfin, float* out) {
    const int rows[1] = {t}; final_rows<1>(rows, lane, XN, Y, RW, MOD, gfin, out);
}
#ifdef WITH_NAIVE
__global__ void k_route(const float* XN, const float* g2, const float* MOD, const float* wgrp, const float* bgrp, const float* wexp, const float* bexp,
                        bf16* H2, int* EID, float* RW, int* CNT, int* LIST) {
    const int t = blockIdx.x * 4 + (threadIdx.x >> 6);
    route_row(t, threadIdx.x & 63, XN, g2, MOD, wgrp, bgrp, wexp, bexp, H2, EID, RW, CNT, LIST);
}
__global__ void k_final(const float* XN, const bf16* Y, const float* RW, const float* MOD, const float* gfin, float* out) {
    const int t = blockIdx.x * 4 + (threadIdx.x >> 6);
    final_row(t, threadIdx.x & 63, XN, Y, RW, MOD, gfin, out);
}

#endif
#define GAS __attribute__((address_space(1)))
#define LAS __attribute__((address_space(3)))
typedef unsigned v4u __attribute__((ext_vector_type(4)));
typedef short bf16x8 __attribute__((ext_vector_type(8)));
typedef GAS unsigned gu32;
typedef GAS unsigned long long gu64;
#define RLX_AGENT __ATOMIC_RELAXED, __HIP_MEMORY_SCOPE_AGENT
#define LDS_WAIT() asm volatile("s_waitcnt lgkmcnt(0)" ::: "memory")
#define VM_WAIT() asm volatile("s_waitcnt vmcnt(0)" ::: "memory")
__device__ __forceinline__ unsigned long long rt() { return __builtin_amdgcn_s_memrealtime(); }

#define XB_TMO      128
#define XB_XCNT(j)  (256  + 64 * (j))
#define XB_XSUB(j)  (1280 + 64 * (j))
#define XB_XGEN(j)  (2304 + 64 * (j))
#define XB_TOP      3328
#define XB_TOPGEN   3392
#define XCD_BAR_WORDS 3456
#define XB_SPIN_CAP (1u << 18)

__device__ __forceinline__ unsigned xb_ld(unsigned* p)              { return __hip_atomic_load(p, __ATOMIC_RELAXED, __HIP_MEMORY_SCOPE_AGENT); }
__device__ __forceinline__ unsigned xb_add(unsigned* p, unsigned v) { return __hip_atomic_fetch_add(p, v, __ATOMIC_RELAXED, __HIP_MEMORY_SCOPE_AGENT); }
__device__ __forceinline__ unsigned xb_xcc_id() { return (unsigned)__builtin_amdgcn_s_getreg((3 << 11) | 20) & 0xFu; }
#define XB_SPIN(cond, bar) do { unsigned _sp = 0; while (cond) { __builtin_amdgcn_s_sleep(1); \
    if ((++_sp & 255u) == 0u) { if (xb_ld(&(bar)[XB_TMO])) break; if (_sp > XB_SPIN_CAP) { atomicAdd(&(bar)[XB_TMO], 1u); break; } } } } while (0)

struct XcdBarrier {
    unsigned* bar; unsigned x;
    volatile LAS unsigned* st;
};

__device__ __forceinline__ XcdBarrier xcd_barrier_post(unsigned* bar, volatile LAS unsigned* st) {
    XcdBarrier b; b.bar = bar; b.x = xb_xcc_id(); b.st = st;
    if (threadIdx.x == 0) (void)xb_add(&bar[XB_XCNT(b.x)], 1u);
    return b;
}
__device__ __forceinline__ void xcd_barrier_complete(unsigned* bar, unsigned x, unsigned& nloc, unsigned& nx) {
    const unsigned G = gridDim.x * gridDim.y * gridDim.z;
    unsigned sum, cnt, mine, sp = 0u;
    for (;;) {
        sum = 0u; cnt = 0u; mine = 0u;
#pragma unroll
        for (unsigned j = 0; j < 16; ++j) { const unsigned c = xb_ld(&bar[XB_XCNT(j)]); sum += c; cnt += (c > 0u) ? 1u : 0u; mine = (j == x) ? c : mine; }
        if (sum == G) break;
        __builtin_amdgcn_s_sleep(1);
        if ((++sp & 255u) == 0u) { if (xb_ld(&bar[XB_TMO])) break; if (sp > XB_SPIN_CAP) { atomicAdd(&bar[XB_TMO], 1u); break; } }
    }
    nloc = mine > 0u ? mine : 1u; nx = cnt > 0u ? cnt : 1u;
}

__device__ __forceinline__ void xcd_barrier(const XcdBarrier& b, const bool leader_thread) {
    asm volatile("s_waitcnt vmcnt(0)" ::: "memory");
    __syncthreads();
    if (leader_thread) {
        unsigned* bar = b.bar;
        __builtin_amdgcn_s_waitcnt(0);
        unsigned nloc = b.st[0], nx = b.st[1];
        if (nloc == 0u) { xcd_barrier_complete(bar, b.x, nloc, nx); b.st[0] = nloc; b.st[1] = nx; }
        const unsigned old = xb_add(&bar[XB_XSUB(b.x)], 1u);
        const unsigned gen = old / nloc;
        if (old + 1u == (gen + 1u) * nloc) {
            __builtin_amdgcn_fence(__ATOMIC_RELEASE, "agent");
            asm volatile("s_waitcnt vmcnt(0)" ::: "memory");
            const unsigned og = xb_add(&bar[XB_TOP], 1u);
            const unsigned tg = og / nx;
            if (og + 1u == (tg + 1u) * nx) xb_add(&bar[XB_TOPGEN], 1u);
            else XB_SPIN(xb_ld(&bar[XB_TOPGEN]) == tg, bar);
            __builtin_amdgcn_fence(__ATOMIC_ACQUIRE, "agent");
            xb_add(&bar[XB_XGEN(b.x)], 1u);
            asm volatile("s_waitcnt vmcnt(0)" ::: "memory");
        } else {
            XB_SPIN(xb_ld(&bar[XB_XGEN(b.x)]) == gen, bar);
            __builtin_amdgcn_fence(__ATOMIC_ACQUIRE, "agent");
            asm volatile("s_waitcnt vmcnt(0)" ::: "memory");
        }
    }
    __syncthreads();
}
namespace pg8 {
#define PG8_LAS __attribute__((address_space(3)))
typedef unsigned short bf16_t;
typedef short bf16x8 __attribute__((ext_vector_type(8)));
typedef float f32x4 __attribute__((ext_vector_type(4)));
typedef unsigned u32x4 __attribute__((ext_vector_type(4)));
constexpr int BM = 256, BK = 64, HALF = 128, HTB = HALF * BK * 2  , STAGE_BYTES = 8 * HTB, NXCD = 8, WGM = 8;

__host__ __device__ __forceinline__ int lds_byte(int r, int c) { const int st = (r >> 4) * 2 + (c >> 5), rr = r & 15, cc = c & 31, ob = rr * 64 + cc * 2; return st * 1024 + (ob ^ (((ob >> 9) & 1) << 5)); }
__host__ __device__ __forceinline__ void stage_rc(int b, int& R, int& C) { const int st = b / 1024, sb = b % 1024, swz = sb ^ (((sb >> 9) & 1) << 5); R = (st >> 1) * 16 + swz / 64; C = (st & 1) * 32 + (swz % 64) / 2; }
__host__ __device__ __forceinline__ int perm32(int rho) { const int n = rho >> 4, i = rho & 15; return 8 * (i >> 2) + 4 * n + (i & 3); }

struct Unit { int pm, pn; };
struct Gemm { const bf16_t* A; const bf16_t* Bt; int M, N, K; };

struct StaticOrder {
    int nM, nN, nwg, G, c;
    __host__ __device__ void init(int M, int N, int G_, int c_) { nM = M / BM; nN = N / BM; nwg = nM * nN; G = G_; c = c_; }
    __host__ __device__ bool next(int i, Unit& u) const {
        const long L = (long)i * G + c; if (L >= nwg) return false;
        int wgid = (int)L; { const int q = nwg / NXCD, r = nwg % NXCD, xcd = wgid % NXCD, off = wgid / NXCD; wgid = (xcd < r ? xcd * (q + 1) : r * (q + 1) + (xcd - r) * q) + off; }
        const int nig = WGM * nN, gid = wgid / nig, fm = gid * WGM, gsz = (nM - fm) < WGM ? (nM - fm) : WGM;
        u.pm = fm + ((wgid % nig) % gsz); u.pn = (wgid % nig) / gsz; return true;
    }
    __device__ __forceinline__ void a_ready(const Unit&) const {}
    __device__ __forceinline__ void done(const Unit&) const {}
};

__device__ __forceinline__ unsigned cvt_pk_bf16(float lo, float hi) { unsigned r; asm volatile("v_cvt_pk_bf16_f32 %0, %1, %2" : "=v"(r) : "v"(lo), "v"(hi)); return r; }
typedef float f32x2 __attribute__((ext_vector_type(2)));
template <class Epi, class Sched, class AMap, bool ALIGN_EPI = false, bool SP2 = false>
__device__ __forceinline__ void gemm_phase(PG8_LAS unsigned char* lds, const Gemm g, const Sched& S, const Epi& E, const AMap& AM, const int tid) {
    const int wid = __builtin_amdgcn_readfirstlane(tid >> 6), lane = tid & 63, wr = wid >> 2, wc = wid & 3, fr = lane & 15, fq = lane >> 4;
    const int K = g.K, nt = K / BK;
    unsigned voffB[2]; int stR[2], stC[2];
#pragma unroll
    for (int i = 0; i < 2; ++i) { int R, C; stage_rc(tid * 16 + i * 8192, R, C); const int Rb = Epi::PERM ? ((R & ~31) + perm32(R & 31)) : R;
        stR[i] = R; stC[i] = C; voffB[i] = (unsigned)(Rb * K + C) * 2u; }
    unsigned vAc[2][2], vAn[2][2]; int rN[2][2], rNN[2][2];
#define PG8_AOFF(dst, un) do { _Pragma("unroll") for (int _h = 0; _h < 2; ++_h) _Pragma("unroll") for (int _i = 0; _i < 2; ++_i) \
        dst[_h][_i] = (unsigned)AM.row(un, _h * HALF + stR[_i]) * (unsigned)(K * 2) + (unsigned)(stC[_i] * 2); } while (0)
#define PG8_AROW(dst, un) do { _Pragma("unroll") for (int _h = 0; _h < 2; ++_h) _Pragma("unroll") for (int _i = 0; _i < 2; ++_i) dst[_h][_i] = AM.raw(un, _h * HALF + stR[_i]); } while (0)
#define PG8_AOFFR(dst, raw) do { _Pragma("unroll") for (int _h = 0; _h < 2; ++_h) _Pragma("unroll") for (int _i = 0; _i < 2; ++_i) \
        dst[_h][_i] = (unsigned)AM.fix(raw[_h][_i]) * (unsigned)(K * 2) + (unsigned)(stC[_i] * 2); } while (0)
    const size_t kstep = (size_t)(BK * 2);
    const size_t hstep = (size_t)HALF * K * 2;
    const size_t tstep = 2 * hstep;
    const unsigned ldsw = (unsigned)wid * 1024u;
    const int aoff = lds_byte(wr * 64 + fr, fq * 8), boff = lds_byte(wc * 32 + fr, fq * 8);
#define PG8_SA(b, h) (((b) * 2 + (h)) * HTB)
#define PG8_SB(b, h) ((4 + (b) * 2 + (h)) * HTB)
#define PG8_STAGE(bufoff, gbase, voff) do { _Pragma("unroll") for (int _i = 0; _i < 2; ++_i) \
        __builtin_amdgcn_global_load_lds((const unsigned*)((const char*)(gbase) + (voff)[_i]), (PG8_LAS unsigned*)(lds + (bufoff) + ldsw + _i * 8192), 16, 0, 0); } while (0)
#define PG8_STAGEA(bufoff, koff, vo) do { _Pragma("unroll") for (int _i = 0; _i < 2; ++_i) \
        __builtin_amdgcn_global_load_lds((const unsigned*)((const char*)g.A + (koff) + (vo)[_i]), (PG8_LAS unsigned*)(lds + (bufoff) + ldsw + _i * 8192), 16, 0, 0); } while (0)
#define PG8_LDA(dst, b, h) do { _Pragma("unroll") for (int m = 0; m < 4; ++m) _Pragma("unroll") for (int k = 0; k < 2; ++k) dst[m][k] = *(const PG8_LAS bf16x8*)(lds + PG8_SA(b, h) + aoff + m * 2048 + k * 1024); } while (0)
#define PG8_LDB(dst, b, h) do { _Pragma("unroll") for (int n = 0; n < 2; ++n) _Pragma("unroll") for (int k = 0; k < 2; ++k) dst[n][k] = *(const PG8_LAS bf16x8*)(lds + PG8_SB(b, h) + boff + n * 2048 + k * 1024); } while (0)
#define PG8_MMA(ai, bj, At, Bt) do { __builtin_amdgcn_s_setprio(1); _Pragma("unroll") for (int m = 0; m < 4; ++m) _Pragma("unroll") for (int n = 0; n < 2; ++n) _Pragma("unroll") for (int k = 0; k < 2; ++k) \
        acc[ai][bj][m][n] = __builtin_amdgcn_mfma_f32_16x16x32_bf16(Bt[n][k], At[m][k], acc[ai][bj][m][n], 0, 0, 0); __builtin_amdgcn_s_setprio(0); } while (0)
#define PG8_WAIT_V(n) asm volatile("s_waitcnt vmcnt(" #n ")" ::: "memory")
#define PG8_WAIT_L(n) asm volatile("s_waitcnt lgkmcnt(" #n ")" ::: "memory")
#define PG8_BAR __builtin_amdgcn_s_barrier()
#define PG8_SCHED __builtin_amdgcn_sched_barrier(0)
    Unit cur, nxt, nn; int ui = 0;
    if (!S.next(0, cur)) return;
    f32x4 acc[2][2][4][2];
#pragma unroll
    for (int a = 0; a < 2; ++a)
#pragma unroll
        for (int b = 0; b < 2; ++b)
#pragma unroll
            for (int m = 0; m < 4; ++m)
#pragma unroll
                for (int n = 0; n < 2; ++n) acc[a][b][m][n] = (f32x4){0.f, 0.f, 0.f, 0.f};
    bf16x8 At[4][2], B0[2][2], B1[2][2];
    const char* cB = (const char*)g.Bt + (size_t)cur.pn * tstep;
    S.a_ready(cur);
    PG8_AOFF(vAc, cur);
    bool has_next = S.next(1, nxt);
    if (has_next) PG8_AROW(rN, nxt);
    if constexpr (SP2) {
        PG8_STAGE(PG8_SB(0, 0), cB, voffB); PG8_STAGE(PG8_SB(0, 1), cB + hstep, voffB); PG8_STAGEA(PG8_SA(0, 0), 0, vAc[0]); PG8_STAGEA(PG8_SA(0, 1), 0, vAc[1]);
        if (wr == 1) PG8_BAR;
        PG8_WAIT_V(2); PG8_BAR;
        PG8_STAGE(PG8_SB(1, 0), cB + kstep, voffB); PG8_STAGEA(PG8_SA(1, 0), kstep, vAc[0]); PG8_STAGE(PG8_SB(1, 1), cB + hstep + kstep, voffB);
        PG8_WAIT_V(6); PG8_BAR;
    } else {
        PG8_STAGE(PG8_SB(0, 0), cB, voffB); PG8_STAGEA(PG8_SA(0, 0), 0, vAc[0]); PG8_STAGE(PG8_SB(0, 1), cB + hstep, voffB); PG8_STAGEA(PG8_SA(0, 1), 0, vAc[1]);
        if (wr == 1) PG8_BAR;
        PG8_WAIT_V(4); PG8_BAR;
        PG8_STAGE(PG8_SB(1, 0), cB + kstep, voffB); PG8_STAGEA(PG8_SA(1, 0), kstep, vAc[0]); PG8_STAGE(PG8_SB(1, 1), cB + hstep + kstep, voffB);
        PG8_WAIT_V(6); PG8_BAR;
    }
    for (;;) {
        const bool has_nn = has_next && S.next(ui + 2, nn);
        if (has_nn) PG8_AROW(rNN, nn);
        const char* nB = has_next ? (const char*)g.Bt + (size_t)nxt.pn * tstep : cB;
        if (has_next) { PG8_AOFFR(vAn, rN); } else { _Pragma("unroll") for (int _h = 0; _h < 2; ++_h) _Pragma("unroll") for (int _i = 0; _i < 2; ++_i) vAn[_h][_i] = vAc[_h][_i]; }
        for (int t = 0; t < nt; t += 2) {
            const bool last = (t == nt - 2);
            const size_t a1 = (size_t)(t + 1) * kstep;
            const size_t a2 = last ? (size_t)0 : (size_t)(t + 2) * kstep; const char* b2 = last ? nB : cB + (size_t)(t + 2) * kstep;
            const size_t a3 = a2 + kstep; const char* b3 = b2 + kstep;
#define PG8_SWAPA() do { if (last) { _Pragma("unroll") for (int _h = 0; _h < 2; ++_h) _Pragma("unroll") for (int _i = 0; _i < 2; ++_i) vAc[_h][_i] = vAn[_h][_i]; } } while (0)
            if (last && has_next) S.a_ready(nxt);
            if constexpr (SP2) {
            PG8_LDB(B0, 0, 0); PG8_LDB(B1, 0, 1); PG8_SCHED; PG8_LDA(At, 0, 0); PG8_STAGEA(PG8_SA(1, 1), a1, vAc[1]); PG8_SWAPA();
            PG8_WAIT_V(8); PG8_WAIT_L(0); PG8_BAR; PG8_MMA(0, 0, At, B0); PG8_MMA(0, 1, At, B1); PG8_BAR; PG8_SCHED;
            PG8_LDA(At, 0, 1); PG8_STAGE(PG8_SB(0, 0), b2, voffB); PG8_STAGE(PG8_SB(0, 1), b2 + hstep, voffB); PG8_STAGEA(PG8_SA(0, 0), a2, vAc[0]);
            PG8_WAIT_V(8); PG8_WAIT_L(0); PG8_BAR; PG8_MMA(1, 0, At, B0); PG8_MMA(1, 1, At, B1); PG8_BAR; PG8_SCHED;
            PG8_LDB(B0, 1, 0); PG8_LDB(B1, 1, 1); PG8_SCHED; PG8_LDA(At, 1, 0); PG8_STAGEA(PG8_SA(0, 1), a2, vAc[1]);
            PG8_WAIT_V(8); PG8_WAIT_L(0); PG8_BAR; PG8_MMA(0, 0, At, B0); PG8_MMA(0, 1, At, B1); PG8_BAR; PG8_SCHED;
            PG8_LDA(At, 1, 1); PG8_STAGE(PG8_SB(1, 0), b3, voffB); PG8_STAGE(PG8_SB(1, 1), b3 + hstep, voffB); PG8_STAGEA(PG8_SA(1, 0), a3, vAc[0]);
            PG8_WAIT_V(8); PG8_WAIT_L(0); PG8_BAR; PG8_MMA(1, 0, At, B0); PG8_MMA(1, 1, At, B1); PG8_BAR; PG8_SCHED;
            } else {
            PG8_LDB(B0, 0, 0); PG8_SCHED; PG8_LDA(At, 0, 0); PG8_STAGEA(PG8_SA(1, 1), a1, vAc[1]); PG8_SWAPA();
            PG8_WAIT_L(8); PG8_BAR; PG8_WAIT_L(0); PG8_MMA(0, 0, At, B0); PG8_BAR; PG8_SCHED;
            PG8_LDB(B1, 0, 1); PG8_STAGE(PG8_SB(0, 0), b2, voffB);
            PG8_BAR; PG8_WAIT_L(0); PG8_MMA(0, 1, At, B1); PG8_BAR;
            PG8_LDA(At, 0, 1); PG8_STAGEA(PG8_SA(0, 0), a2, vAc[0]);
            PG8_BAR; PG8_WAIT_L(0); PG8_MMA(1, 0, At, B0); PG8_BAR; PG8_SCHED;
            PG8_STAGE(PG8_SB(0, 1), b2 + hstep, voffB);
            PG8_WAIT_V(6); PG8_BAR; PG8_MMA(1, 1, At, B1); PG8_BAR;
            PG8_LDB(B0, 1, 0); PG8_SCHED; PG8_LDA(At, 1, 0); PG8_STAGEA(PG8_SA(0, 1), a2, vAc[1]);
            PG8_WAIT_L(8); PG8_BAR; PG8_WAIT_L(0); PG8_MMA(0, 0, At, B0); PG8_BAR; PG8_SCHED;
            PG8_LDB(B1, 1, 1); PG8_STAGE(PG8_SB(1, 0), b3, voffB);
            PG8_BAR; PG8_WAIT_L(0); PG8_MMA(0, 1, At, B1); PG8_BAR;
            PG8_LDA(At, 1, 1); PG8_STAGEA(PG8_SA(1, 0), a3, vAc[0]);
            PG8_BAR; PG8_WAIT_L(0); PG8_MMA(1, 0, At, B0); PG8_BAR; PG8_SCHED;
            PG8_STAGE(PG8_SB(1, 1), b3 + hstep, voffB);
            PG8_WAIT_V(6); PG8_BAR; PG8_MMA(1, 1, At, B1); PG8_BAR;
            }
        }
        if constexpr (ALIGN_EPI) { if (wr == 0) PG8_BAR; }
        if constexpr (!Epi::AFTER_DRAIN) { E(acc, cur, wr, wc, fr, fq); S.done(cur); }
        if (!has_next) break;
#pragma unroll
        for (int a = 0; a < 2; ++a)
#pragma unroll
            for (int b = 0; b < 2; ++b)
#pragma unroll
                for (int m = 0; m < 4; ++m)
#pragma unroll
                    for (int n = 0; n < 2; ++n) acc[a][b][m][n] = (f32x4){0.f, 0.f, 0.f, 0.f};
        cur = nxt; nxt = nn; has_next = has_nn; cB = nB; ++ui;
        _Pragma("unroll") for (int _h = 0; _h < 2; ++_h) _Pragma("unroll") for (int _i = 0; _i < 2; ++_i) rN[_h][_i] = rNN[_h][_i];
        if constexpr (ALIGN_EPI) { if (wr == 1) PG8_BAR; }
    }
    PG8_WAIT_V(0);
    if constexpr (!ALIGN_EPI) { if (wr == 0) PG8_BAR; }
    PG8_BAR;
    if constexpr (Epi::AFTER_DRAIN) { E.fused(acc, cur, wr, wc, fr, fq, lds, wid, lane); S.done(cur); }
#undef PG8_SA
#undef PG8_SB
#undef PG8_STAGE
#undef PG8_STAGEA
#undef PG8_AOFF
#undef PG8_AROW
#undef PG8_AOFFR
#undef PG8_SWAPA
#undef PG8_LDA
#undef PG8_LDB
#undef PG8_MMA
#undef PG8_WAIT_V
#undef PG8_WAIT_L
#undef PG8_BAR
#undef PG8_SCHED
}
}
namespace attn_body {
using bf16=unsigned short;
using bf16x8=__attribute__((ext_vector_type(8)))short;
using s16x4=__attribute__((ext_vector_type(4)))short;
using f32x16=__attribute__((ext_vector_type(16)))float;
using u32x4=__attribute__((ext_vector_type(4)))unsigned;
constexpr int D=64,QP=512,KVP=64,OP=1024,NKEYS=16640;
constexpr int NW=8,QBLK=32,QB=QBLK*NW,KVBLK=64;
constexpr int ATTN_UNIT_ROWS=QB;
__device__ __forceinline__ int crow(int r,int hi){return (r&3)+8*(r>>2)+4*hi;}
#define SBAR() __builtin_amdgcn_sched_barrier(0)
constexpr int NSLOT=3, SLOTB=8192;
constexpr int LDS_K=0, LDS_V=NSLOT*SLOTB, LDS_WS=2*NSLOT*SLOTB, LDS_OST=LDS_WS+NW*64*4, LDS_BYTES=LDS_OST+NW*4096;
constexpr float C2=0.125f*1.4426950408889634f;
__device__ __forceinline__ void glds16(const void*gsrc,unsigned lds_dst){unsigned keep;
  asm volatile("s_mov_b32 %0, m0\n\ts_mov_b32 m0, %2\n\ts_nop 0\n\tglobal_load_lds_dwordx4 %1, off\n\ts_mov_b32 m0, %0":"=&s"(keep):"v"(gsrc),"s"(lds_dst):"memory");}
__device__ __forceinline__ float max3f(float a,float b,float c){float r;asm("v_max3_f32 %0, %1, %2, %3":"=v"(r):"v"(a),"v"(b),"v"(c));return r;}
__device__ __forceinline__ float max2f(float a,float b){float r;asm("v_max_f32_e32 %0, %1, %2":"=v"(r):"v"(a),"v"(b));return r;}
__device__ __forceinline__ float fadd_s(float a,float b){float r;asm("v_add_f32_e32 %0, %1, %2":"=v"(r):"v"(a),"v"(b));return r;}
__device__ __forceinline__ float fsub_s(float a,float b){float r;asm("v_sub_f32_e32 %0, %1, %2":"=v"(r):"v"(a),"v"(b));return r;}
typedef float f32x2_t __attribute__((ext_vector_type(2))); typedef __bf16 bf16x2_t __attribute__((ext_vector_type(2)));
__device__ __forceinline__ unsigned cvtpk_s(float lo,float hi){f32x2_t v={lo,hi};bf16x2_t b=__builtin_convertvector(v,bf16x2_t);return __builtin_bit_cast(unsigned,b);}
#define WAIT_BAR(N) asm volatile("s_waitcnt vmcnt(" #N ") lgkmcnt(0)\n\ts_barrier":::"memory")

__device__ __forceinline__ void qkt(f32x16&p0,f32x16&p1,const char*Kslot,const bf16x8*qr,const f32x16&negm,int r32,int hi){
  const char*kb=Kslot+hi*1024+r32*16;
  #pragma unroll
  for(int d0=0;d0<4;++d0){
    const bf16x8 b0=*reinterpret_cast<const bf16x8*>(kb+d0*2048);
    const bf16x8 b1=*reinterpret_cast<const bf16x8*>(kb+d0*2048+512);
    if(d0==0){p0=__builtin_amdgcn_mfma_f32_32x32x16_bf16(b0,qr[0],negm,0,0,0);p1=__builtin_amdgcn_mfma_f32_32x32x16_bf16(b1,qr[0],negm,0,0,0);}
    else{p0=__builtin_amdgcn_mfma_f32_32x32x16_bf16(b0,qr[d0],p0,0,0,0);p1=__builtin_amdgcn_mfma_f32_32x32x16_bf16(b1,qr[d0],p1,0,0,0);}}
}
typedef __attribute__((address_space(3))) const char* lds_cptr;
typedef short v4i16_t __attribute__((ext_vector_type(4)));
__device__ __forceinline__ void kload8(bf16x8*kf,lds_cptr kp){
  kf[0]=*(const __attribute__((address_space(3))) bf16x8*)(kp);      kf[1]=*(const __attribute__((address_space(3))) bf16x8*)(kp+512);
  kf[2]=*(const __attribute__((address_space(3))) bf16x8*)(kp+2048); kf[3]=*(const __attribute__((address_space(3))) bf16x8*)(kp+2560);
  kf[4]=*(const __attribute__((address_space(3))) bf16x8*)(kp+4096); kf[5]=*(const __attribute__((address_space(3))) bf16x8*)(kp+4608);
  kf[6]=*(const __attribute__((address_space(3))) bf16x8*)(kp+6144); kf[7]=*(const __attribute__((address_space(3))) bf16x8*)(kp+6656);
}
__device__ __forceinline__ void kload2(bf16x8*kf,lds_cptr kp,int j){ kf[2*j]=*(const __attribute__((address_space(3))) bf16x8*)(kp+j*2048); kf[2*j+1]=*(const __attribute__((address_space(3))) bf16x8*)(kp+j*2048+512); }
__device__ __forceinline__ s16x4 vtr(lds_cptr p){ return __builtin_bit_cast(s16x4,__builtin_amdgcn_ds_read_tr16_b64_v4i16((__attribute__((address_space(3))) v4i16_t*)p)); }
__device__ __forceinline__ float rowmax(const f32x16&p0,const f32x16&p1){
  float a=max3f(p0[0],p0[1],p1[0]),b=max3f(p0[2],p0[3],p1[1]);a=max3f(a,p1[2],p1[3]);
  #pragma unroll
  for(int r=4;r<16;r+=4){a=max3f(a,p0[r],p0[r+1]);b=max3f(b,p0[r+2],p0[r+3]);a=max3f(a,p1[r],p1[r+1]);b=max3f(b,p1[r+2],p1[r+3]);}
  const float m=max2f(a,b);
  auto rr=__builtin_amdgcn_permlane32_swap(__float_as_uint(m),__float_as_uint(m),false,false);
  return max2f(__uint_as_float(rr[0]),__uint_as_float(rr[1]));
}
__device__ __forceinline__ void pv(f32x16*o,int vb,bf16x8 pa0,bf16x8 pa1,bf16x8 pa2,bf16x8 pa3){
  #pragma unroll
  for(int d0=0;d0<2;++d0){s16x4 lo[4],hi[4];
    #pragma unroll
    for(int ks=0;ks<4;++ks){
      asm volatile("ds_read_b64_tr_b16 %0,%1 offset:%c2":"=&v"(lo[ks]):"v"(vb),"i"(d0*4096+ks*1024):"memory");
      asm volatile("ds_read_b64_tr_b16 %0,%1 offset:%c2":"=&v"(hi[ks]):"v"(vb),"i"(d0*4096+ks*1024+512):"memory");}
    asm volatile("s_waitcnt lgkmcnt(0)":::"memory");SBAR();
    #define PK(k) (bf16x8){lo[k][0],lo[k][1],lo[k][2],lo[k][3],hi[k][0],hi[k][1],hi[k][2],hi[k][3]}
    o[d0]=__builtin_amdgcn_mfma_f32_32x32x16_bf16(pa0,PK(0),o[d0],0,0,0);
    o[d0]=__builtin_amdgcn_mfma_f32_32x32x16_bf16(pa1,PK(1),o[d0],0,0,0);
    o[d0]=__builtin_amdgcn_mfma_f32_32x32x16_bf16(pa2,PK(2),o[d0],0,0,0);
    o[d0]=__builtin_amdgcn_mfma_f32_32x32x16_bf16(pa3,PK(3),o[d0],0,0,0);
    #undef PK
  }
}

#ifndef ATTN_STORE16
#define ATTN_STORE16(p,v) (*(u32x4*)(p)=(v))
#endif
template<int THRL> __device__ __forceinline__ void attn_unit(int h,int qb,const bf16*Q,const bf16*__restrict__ K,const bf16*__restrict__ V,bf16*O,char*shm,const int tid){
  const int lane=tid&63,r32=lane&31,hi=lane>>5; const int wid=__builtin_amdgcn_readfirstlane(tid>>6);
  const int q0=qb*QB;
  const bf16*Qw=Q+(long)(q0+wid*QBLK)*QP+h*D;
  const bf16*Kh=K+(long)(h>>2)*NKEYS*KVP,*Vh=V+(long)(h>>2)*NKEYS*KVP;
  const unsigned lds0=(unsigned)(uintptr_t)shm;
  float*wsf=(float*)(shm+LDS_WS)+wid*64;
  const bf16*ksrc=Kh+(long)lane*KVP+wid*8;
  const bf16*vsrc=Vh+(long)(16*(wid&3)+(lane>>2))*KVP+(wid>>2)*32+(lane&3)*8;
  const unsigned kdst=lds0+LDS_K+wid*1024, vdst=lds0+LDS_V+wid*1024;
  #define DMA_K(t,slot) glds16(ksrc+(long)(t)*KVBLK*KVP,(unsigned)__builtin_amdgcn_readfirstlane(kdst+(slot)))
  #define DMA_V(t,slot) glds16(vsrc+(long)(t)*KVBLK*KVP,(unsigned)__builtin_amdgcn_readfirstlane(vdst+(slot)))
  const int vb0=(int)(lds0+LDS_V)+((lane>>4)&1)*32+(lane&3)*8+(4*hi+((lane&15)>>2))*64;
  const char*Kbase=shm+LDS_K; bf16x8 kf[8];
  const lds_cptr shm3=(lds_cptr)shm; const lds_cptr kp0=shm3+LDS_K+hi*1024+r32*16; const lds_cptr vp0=shm3+LDS_V+((lane>>4)&1)*32+(lane&3)*8+(4*hi+((lane&15)>>2))*64;
  constexpr int NT=NKEYS/KVBLK;
  DMA_K(0,0);DMA_V(0,0);DMA_K(1,SLOTB);
  bf16x8 qr[4];
  #pragma unroll
  for(int d0=0;d0<4;++d0)qr[d0]=*reinterpret_cast<const bf16x8*>(&Qw[(long)r32*QP+d0*16+hi*8]);
  float l_reg=0.f;f32x16 o[2];o[0]=f32x16{};o[1]=f32x16{};const f32x16 negm=f32x16{};
  #define CMASK(P0,P1,t) do{}while(0)
  #define START(P0,P1) do{ _Pragma("unroll") for(int r=0;r<16;++r)P0[r]=__builtin_amdgcn_exp2f(P0[r]); }while(0)
  #define RESC() do{}while(0)
  f32x16 pA0,pA1,pB0,pB1;
  int sl_prev=0,sl_cur=0,sl_next=SLOTB;
  #define ROT() do{sl_prev=sl_cur;sl_cur=sl_next;sl_next=(sl_next==(NSLOT-1)*SLOTB)?0:sl_next+SLOTB;}while(0)
  DMA_K(2,2*SLOTB);
  WAIT_BAR(3);
  qkt(pA0,pA1,Kbase,qr,negm,r32,hi);asm volatile("s_nop 15\n\ts_nop 7":"+v"(pA0),"+v"(pA1));CMASK(pA0,pA1,0);
  START(pA0,pA1);
  _Pragma("unroll") for(int r=0;r<16;++r)pA1[r]=__builtin_amdgcn_exp2f(pA1[r]);
  WAIT_BAR(0);
  DMA_K(3,0);DMA_V(1,SLOTB);
  ROT();
  kload8(kf,kp0+sl_cur);
  WAIT_BAR(2);
  s16x4 vlo[8],vhi[8]; u32x4 pw0,pw1,pw2,pw3;
  #define PKW(P,B) cvtpk_s(P[B],P[B+1])
  #define PAF(k) __builtin_bit_cast(bf16x8,pw##k)
  #define VFR(i) (bf16x8){vlo[i][0],vlo[i][1],vlo[i][2],vlo[i][3],vhi[i][0],vhi[i][1],vhi[i][2],vhi[i][3]}
  #define PIN(x) asm volatile("":"+v"(x))
  #define MX3(a,b,c) __builtin_fmaxf(__builtin_fmaxf((a),(b)),(c))
  #define GAPA(MF,A0,A1,A2,A3,W0,W1,PW) do{ MF; sacc+=A0; sacc+=A1; sacc+=A2; sacc+=A3; PIN(sacc); W0; W1; PIN(PW); SBAR(); }while(0)
  #define EX(v) __builtin_amdgcn_exp2f(v)
  #define GAPB(MF,X,B) do{ MF; X[B]=EX(X[B]); X[B+1]=EX(X[B+1]); X[B+2]=EX(X[B+2]); X[B+3]=EX(X[B+3]); PIN(X); SBAR(); }while(0)
  #define VRD(i) do{ vlo[i]=vtr(vp_+(((i)>>2)*4096+((i)&3)*1024)); vhi[i]=vtr(vp_+(((i)>>2)*4096+((i)&3)*1024+512)); }while(0)
  #define KRD(G,j) do{ if(G){ kload2(kf,kp0+sl_next,j); SBAR(); } }while(0)
  #define STEP(C0,C1,P0,P1,t,GK,GV,GL) do{ SBAR(); \
    const lds_cptr vp_=vp0+sl_prev; \
    VRD(0); SBAR(); float sacc=(P0[0]+P0[1]); \
    GAPA(C0=__builtin_amdgcn_mfma_f32_32x32x16_bf16(kf[0],qr[0],negm,0,0,0), P0[2],P0[3],P0[4],P0[5],     pw0[0]=PKW(P0,0), pw0[1]=PKW(P0,2), pw0); \
    VRD(4); SBAR(); GAPA(C1=__builtin_amdgcn_mfma_f32_32x32x16_bf16(kf[1],qr[0],negm,0,0,0), P0[6],P0[7],P0[8],P0[9],     pw0[2]=PKW(P0,4), pw0[3]=PKW(P0,6), pw0); \
    VRD(1); SBAR(); GAPA(C0=__builtin_amdgcn_mfma_f32_32x32x16_bf16(kf[2],qr[1],C0,0,0,0),   P0[10],P0[11],P0[12],P0[13], pw1[0]=PKW(P0,8), pw1[1]=PKW(P0,10), pw1); \
    VRD(5); SBAR(); GAPA(C1=__builtin_amdgcn_mfma_f32_32x32x16_bf16(kf[3],qr[1],C1,0,0,0),   P0[14],P0[15],P1[0],P1[1],   pw1[2]=PKW(P0,12),pw1[3]=PKW(P0,14), pw1); \
    VRD(2); SBAR(); GAPA(C0=__builtin_amdgcn_mfma_f32_32x32x16_bf16(kf[4],qr[2],C0,0,0,0),   P1[2],P1[3],P1[4],P1[5],     pw2[0]=PKW(P1,0), pw2[1]=PKW(P1,2), pw2); \
    VRD(6); SBAR(); GAPA(C1=__builtin_amdgcn_mfma_f32_32x32x16_bf16(kf[5],qr[2],C1,0,0,0),   P1[6],P1[7],P1[8],P1[9],     pw2[2]=PKW(P1,4), pw2[3]=PKW(P1,6), pw2); \
    VRD(3); SBAR(); GAPA(C0=__builtin_amdgcn_mfma_f32_32x32x16_bf16(kf[6],qr[3],C0,0,0,0),   P1[10],P1[11],P1[12],P1[13], pw3[0]=PKW(P1,8), pw3[1]=PKW(P1,10), pw3); \
    VRD(7); SBAR(); GAPA(C1=__builtin_amdgcn_mfma_f32_32x32x16_bf16(kf[7],qr[3],C1,0,0,0),   P1[14],P1[15],0.f,0.f,       pw3[2]=PKW(P1,12),pw3[3]=PKW(P1,14), pw3); \
    l_reg+=sacc; \
    if(GK){DMA_K((t)+3,sl_cur);} if(GV){DMA_V((t)+1,sl_next);} \
    CMASK(C0,C1,t); \
    SBAR(); \
    GAPB(o[0]=__builtin_amdgcn_mfma_f32_32x32x16_bf16(PAF(0),VFR(0),o[0],0,0,0), C0,0); \
    GAPB(o[1]=__builtin_amdgcn_mfma_f32_32x32x16_bf16(PAF(0),VFR(4),o[1],0,0,0), C0,4); \
    KRD(GL,0); GAPB(o[0]=__builtin_amdgcn_mfma_f32_32x32x16_bf16(PAF(1),VFR(1),o[0],0,0,0), C0,8); \
    KRD(GL,1); GAPB(o[1]=__builtin_amdgcn_mfma_f32_32x32x16_bf16(PAF(1),VFR(5),o[1],0,0,0), C0,12); \
    KRD(GL,2); GAPB(o[0]=__builtin_amdgcn_mfma_f32_32x32x16_bf16(PAF(2),VFR(2),o[0],0,0,0), C1,0); \
    KRD(GL,3); GAPB(o[1]=__builtin_amdgcn_mfma_f32_32x32x16_bf16(PAF(2),VFR(6),o[1],0,0,0), C1,4); \
    GAPB(o[0]=__builtin_amdgcn_mfma_f32_32x32x16_bf16(PAF(3),VFR(3),o[0],0,0,0), C1,8); \
    GAPB(o[1]=__builtin_amdgcn_mfma_f32_32x32x16_bf16(PAF(3),VFR(7),o[1],0,0,0), C1,12); \
    }while(0)
  int t=1;
  for(;t+5<NT;t+=2){
    STEP(pB0,pB1,pA0,pA1,t,true,true,true);     WAIT_BAR(2); RESC(); ROT();
    STEP(pA0,pA1,pB0,pB1,t+1,true,true,true);   WAIT_BAR(2); RESC(); ROT();
  }
  #define ENDW(tt) do{ if((tt)+3<NT){WAIT_BAR(2);} else if((tt)+2<NT){WAIT_BAR(1);} else {WAIT_BAR(0);} }while(0)
  for(;t+1<NT;t+=2){
    STEP(pB0,pB1,pA0,pA1,t,(t+3<NT),(t+1<NT),(t+1<NT));       ENDW(t);   RESC(); ROT();
    STEP(pA0,pA1,pB0,pB1,t+1,(t+4<NT),(t+2<NT),(t+2<NT));     ENDW(t+1); RESC(); ROT();
  }
  STEP(pB0,pB1,pA0,pA1,NT-1,false,false,false); RESC();
  { float sacc=pB0[0]+pB0[1]; _Pragma("unroll") for(int r=2;r<16;++r)sacc+=pB0[r]; _Pragma("unroll") for(int r=0;r<16;++r)sacc+=pB1[r]; l_reg+=sacc;
    pw0=(u32x4){PKW(pB0,0),PKW(pB0,2),PKW(pB0,4),PKW(pB0,6)};pw1=(u32x4){PKW(pB0,8),PKW(pB0,10),PKW(pB0,12),PKW(pB0,14)};pw2=(u32x4){PKW(pB1,0),PKW(pB1,2),PKW(pB1,4),PKW(pB1,6)};pw3=(u32x4){PKW(pB1,8),PKW(pB1,10),PKW(pB1,12),PKW(pB1,14)};
    SBAR(); pv(o,vb0+sl_cur,PAF(0),PAF(1),PAF(2),PAF(3)); }
  #undef PKW
  #undef PAF
  #undef VFR
  #undef PIN
  #undef MX3
  #undef GAPA
  #undef GAPB
  #undef EX
  #undef VRD
  #undef KRD
  #undef STEP
  #undef ENDW
  {auto rr=__builtin_amdgcn_permlane32_swap(__float_as_uint(l_reg),__float_as_uint(l_reg),false,false);l_reg=__uint_as_float(rr[0])+__uint_as_float(rr[1]);}
  if(hi==0)wsf[32+r32]=l_reg;asm volatile("s_waitcnt lgkmcnt(0)":::"memory");
  float rli[16];
  #pragma unroll
  for(int r=0;r<16;++r)rli[r]=__builtin_amdgcn_rcpf(wsf[32+crow(r,hi)]);
  bf16*Ow=O+(long)(q0+wid*QBLK)*OP+h*D;
  { bf16*stg=(bf16*)(shm+LDS_OST)+wid*2048;
    #pragma unroll
    for(int r=0;r<16;++r){const int orow=crow(r,hi);
      #pragma unroll
      for(int d0=0;d0<2;++d0)stg[orow*64+d0*32+r32]=f2bf(o[d0][r]*rli[r]);}
    asm volatile("s_waitcnt lgkmcnt(0)":::"memory");
    #pragma unroll
    for(int i=0;i<4;++i){const int row=i*8+(lane>>3),ch=lane&7; const u32x4 v=*(const u32x4*)(stg+row*64+ch*8); ATTN_STORE16(Ow+(long)row*OP+ch*8,v);} }
  asm volatile("s_waitcnt lgkmcnt(0)\n\ts_barrier":::"memory");
  #undef DMA_K
  #undef DMA_V
  #undef CMASK
  #undef START
  #undef RESC
  #undef ROT
}
constexpr int ATTN_LDS_BYTES=LDS_BYTES;
struct AttnTensors { const bf16* Q; const bf16* K; const bf16* V; bf16* O; };
#undef SBAR
#undef WAIT_BAR
}
constexpr int NWAVES = 8, NTHREADS = 512;
constexpr int RING_OFF = 0, RING_BYTES = 131072;
constexpr int LDSCTL_OFF = RING_BYTES, MISC_OFF = LDSCTL_OFF + 320;
constexpr int TT_OFF = LDSCTL_OFF + 1024;
constexpr int RT_OFF = LDSCTL_OFF + 4096;
constexpr int LDS_BYTES = RT_OFF + 16384 + 1024;
constexpr int MAXT = 192;

struct Frame {
    LAS unsigned char* lds; volatile LAS unsigned* MISC; unsigned* ctl;
    int tid, lane, wave, vcu, G;
};
__device__ __forceinline__ float silu_f(float v) { return v * __builtin_amdgcn_rcpf(1.f + __expf(-v)); }
__device__ __forceinline__ float lsig(float x) { return -log1pf(expf(-x)); }

__device__ __forceinline__ void publish_add(unsigned* cnt, bool leader) {
    asm volatile("s_waitcnt vmcnt(0)" ::: "memory"); __syncthreads();
    if (leader) { __builtin_amdgcn_fence(__ATOMIC_RELEASE, "agent"); asm volatile("s_waitcnt vmcnt(0)" ::: "memory");
        (void)__hip_atomic_fetch_add(cnt, 1u, __ATOMIC_RELAXED, __HIP_MEMORY_SCOPE_AGENT); }
}
__device__ __forceinline__ void store16_wt(void* p, f32x4 v) { asm volatile("global_store_dwordx4 %0, %1, off sc1\n\ts_nop 1" :: "v"(p), "v"(v) : "memory"); }
__device__ __forceinline__ void publish_add_wt(unsigned* cnt, bool leader) {
    asm volatile("s_waitcnt vmcnt(0)" ::: "memory"); __syncthreads();
    if (leader) (void)__hip_atomic_fetch_add(cnt, 1u, __ATOMIC_RELAXED, __HIP_MEMORY_SCOPE_AGENT);
}
__device__ __forceinline__ void wait_ge(unsigned* cnt, unsigned want, bool leader, unsigned* tmo, bool acq = true) {
    if (leader) { unsigned sp = 0;
        while (__hip_atomic_load(cnt, __ATOMIC_RELAXED, __HIP_MEMORY_SCOPE_AGENT) < want) { __builtin_amdgcn_s_sleep(2);
            if ((++sp & 1023u) == 0u) { if (sp > (1u << 22) || __hip_atomic_load(tmo, __ATOMIC_RELAXED, __HIP_MEMORY_SCOPE_AGENT) != 0u) { __hip_atomic_store(tmo, 1u, __ATOMIC_RELAXED, __HIP_MEMORY_SCOPE_AGENT); break; } } }
        if (acq) __builtin_amdgcn_fence(__ATOMIC_ACQUIRE, "agent"); asm volatile("s_waitcnt vmcnt(0)" ::: "memory"); }
    __syncthreads();
}

__device__ __forceinline__ void p0_transpose_item(const float* W, int N, bf16* WT, int Kd, int k0, int n0, int drow0, LAS float* scr, int lane) {
    float wv[32];
#pragma unroll
    for (int i = 0; i < 32; ++i) wv[i] = NT_LD(&W[(size_t)(k0 + 2 * i + (lane >> 5)) * N + n0 + (lane & 31)]);
#pragma unroll
    for (int i = 0; i < 32; ++i) scr[(2 * i + (lane >> 5)) * 33 + (lane & 31)] = wv[i];
    LDS_WAIT(); asm volatile("" ::: "memory");
    const int c = lane & 7;
#pragma unroll
    for (int j = 0; j < 4; ++j) { const int n = (lane >> 3) + 8 * j; const LAS float* s = scr + (8 * c) * 33 + n;
        u32x4 o; o.x = pk2(s[0 * 33], s[1 * 33]); o.y = pk2(s[2 * 33], s[3 * 33]); o.z = pk2(s[4 * 33], s[5 * 33]); o.w = pk2(s[6 * 33], s[7 * 33]);
        if (WT_MASK & 64) st16_sel(WT + (size_t)(drow0 + n) * Kd + k0 + 8 * c, o, true); else NT_ST(o, (u32x4*)(WT + (size_t)(drow0 + n) * Kd + k0 + 8 * c)); }
    LDS_WAIT(); asm volatile("" ::: "memory");
}
struct P0Args { unsigned* modcnt; const float *c, *cctx, *w_ada, *b_ada, *w_in, *w_out, *wg, *wu, *wd, *wgrp, *wexp; float *MOD, *ROPE, *RTW; bf16 *Wi, *Wo, *Wgu, *Wd; };
constexpr int CV_IN = 16 * 72, CV_OUT = 16 * 32, CV_G = 32 * 256, CV_D = 32 * 256, CV_ITEMS = CV_IN + CV_OUT + 2 * CV_G + CV_D;
#ifndef FILL_ITEMS
#define FILL_ITEMS 10240
#endif
constexpr int P0_ITEMS = CV_ITEMS - FILL_ITEMS;
__device__ __forceinline__ void convert_items(Frame& F, const P0Args& a, int first, int last, int w, int nw) {
    LAS float* scr = (LAS float*)(F.lds + RING_OFF + F.wave * 16384);
    for (int it = first + w; it < last; it += nw) {
        int r = it;
        if (r < CV_IN) { const int kb = r / 72, nb = r % 72, n0 = 32 * nb, pn = n0 >> 8, off = n0 & 255, wc = off >> 6, bj = (off >> 5) & 1;
            p0_transpose_item(a.w_in, NPROJ, a.Wi, 1024, 64 * kb, n0, pn * 256 + 128 * bj + 32 * wc, scr, F.lane); continue; } r -= CV_IN;
        if (r < CV_OUT) { const int kb = r >> 5, nb = r & 31; p0_transpose_item(a.w_out, 1024, a.Wo, 1024, 64 * kb, 32 * nb, 32 * nb, scr, F.lane); continue; } r -= CV_OUT;
        if (r < 2 * CV_G) { const int up = r >= CV_G; if (up) r -= CV_G; const int e = r >> 8, q = r & 255, kb = q >> 4, nb = q & 15, n0 = 32 * nb, pn = n0 >> 7, p = n0 & 127;
            p0_transpose_item((up ? a.wu : a.wg) + (size_t)e * 1024 * 512, 512, a.Wgu, 1024, 64 * kb, n0, e * 1024 + pn * 256 + (up ? 128 : 0) + p, scr, F.lane); continue; } r -= 2 * CV_G;
        { const int e = r >> 8, q = r & 255, kb = q >> 5, nb = q & 31; p0_transpose_item(a.wd + (size_t)e * 512 * 1024, 1024, a.Wd, 512, 64 * kb, 32 * nb, e * 1024 + 32 * nb, scr, F.lane); }
    }
}
__device__ __forceinline__ void p0_prologue(Frame& F, const P0Args& a) {
    for (int cb = F.vcu; cb < 192; cb += F.G) {
        LAS float* sv = (LAS float*)(F.lds);
        LAS float* red = (LAS float*)(F.lds + 8192);
        for (int i = F.tid; i < 2048; i += NTHREADS) sv[i] = silu_f(i < 1024 ? a.c[i] : a.cctx[i - 1024]);
        __syncthreads();
        const int col = F.tid & 31, kg = F.tid >> 5, j0 = cb * 32;
        float a0 = 0.f, a1 = 0.f;
#pragma unroll 8
        for (int i = 0; i < 64; ++i) { const int k = kg + 16 * i; const float w = NT_LD(&a.w_ada[(size_t)k * 6144 + j0 + col]); a0 += sv[k] * w; a1 += sv[1024 + k] * w; }
        red[(kg * 32 + col) * 2] = a0; red[(kg * 32 + col) * 2 + 1] = a1;
        __syncthreads();
        if (F.tid < 64) { const int cc = F.tid & 31, s = F.tid >> 5; float t = 0.f;
#pragma unroll
            for (int g = 0; g < 16; ++g) t += red[(g * 32 + cc) * 2 + s];
            if (WT_MASK & 128) __hip_atomic_store(a.MOD + s * 6144 + j0 + cc, t + a.b_ada[j0 + cc], __ATOMIC_RELAXED, __HIP_MEMORY_SCOPE_AGENT); else a.MOD[s * 6144 + j0 + cc] = t + a.b_ada[j0 + cc]; }
        if (WT_MASK & 128) publish_add_wt(a.modcnt, F.tid == 0); else publish_add(a.modcnt, F.tid == 0);
        __syncthreads();
    }
    if (F.vcu == F.G - 1) {
        for (int i = F.tid; i < 4096; i += NTHREADS) { const int pos = i >> 4, f = i & 15; const float freq = powf(10000.f, -(float)(2 * f) / 32.f), ang = (float)pos * freq;
            a.ROPE[2 * i] = cosf(ang); a.ROPE[2 * i + 1] = sinf(ang); }
        __syncthreads();
    }
    if (F.vcu == (F.G >= 2 ? F.G - 2 : 0)) {
        for (int i = F.tid; i < 36 * 1024; i += NTHREADS) { const int cc = i >> 10, n = i & 1023; a.RTW[i] = cc < 32 ? a.wexp[(size_t)n * 32 + cc] : a.wgrp[(size_t)n * 4 + cc - 32]; }
    }
    convert_items(F, a, 0, P0_ITEMS, F.vcu * NWAVES + F.wave, F.G * NWAVES);
}
template <int NB> __device__ __forceinline__ void norm1_rows(const int (&rows)[NB], int lane, const float* x, const float* ctx, const float* g1, const float* MOD, bf16* HX) {
    f32x4 v[NB][4];
#pragma unroll
    for (int b = 0; b < NB; ++b) { const int r = rows[b]; const float* src = r < CL ? ctx + (size_t)r * DM : x + (size_t)(r - CL) * DM;
#pragma unroll
        for (int j = 0; j < 4; ++j) v[b][j] = NT_LD((const f32x4*)src + lane + 64 * j); }
#pragma unroll
    for (int b = 0; b < NB; ++b) { const int r = rows[b]; const float* mod = MOD + (r < CL ? 6144 : 0); float ss = 0.f;
#pragma unroll
        for (int j = 0; j < 4; ++j) ss += (v[b][j].x * v[b][j].x + v[b][j].y * v[b][j].y) + (v[b][j].z * v[b][j].z + v[b][j].w * v[b][j].w);
        const float rstd = rsqrtf(wave_sum(ss) * (1.f / DM) + EPS);
#pragma unroll
        for (int j = 0; j < 4; ++j) { const int n = 4 * lane + 256 * j; const f32x4 g = *(const f32x4*)(g1 + n), sh = *(const f32x4*)(mod + n), sc = *(const f32x4*)(mod + 1024 + n);
            float h[4];
#pragma unroll
            for (int i = 0; i < 4; ++i) h[i] = (v[b][j][i] * rstd) * g[i] * (1.f + sc[i]) + sh[i];
            u32x2 o; o.x = pk2(h[0], h[1]); o.y = pk2(h[2], h[3]); st8_sel(HX + (size_t)r * DM + n, o, (WT_MASK & 1) != 0); } }
}

__device__ __forceinline__ void route_stage_weights(Frame& F, const float* RTW) {
    LAS u32x4* wxT = (LAS u32x4*)(F.lds + RING_OFF); LAS u32x4* wgT = (LAS u32x4*)(F.lds + RT_OFF); const u32x4* src = (const u32x4*)RTW;
#pragma unroll 8
    for (int i = 0; i < 16; ++i) wxT[F.tid + NTHREADS * i] = src[F.tid + NTHREADS * i];
#pragma unroll
    for (int i = 0; i < 2; ++i) wgT[F.tid + NTHREADS * i] = src[8192 + F.tid + NTHREADS * i];
    __syncthreads();
}
struct RouteOut { int ea, eb; float w1, w2; };
__device__ __forceinline__ void route_load_row(int t, int lane, const bf16* XN, f32x4 (&v)[4]) {
    const u32x2* xr = (const u32x2*)(XN + (size_t)t * DM) + lane;
#pragma unroll
    for (int j = 0; j < 4; ++j) { const u32x2 w = xr[64 * j]; v[j] = (f32x4){__uint_as_float(w.x << 16), __uint_as_float(w.x & 0xffff0000u), __uint_as_float(w.y << 16), __uint_as_float(w.y & 0xffff0000u)}; }
}
template <int COMMIT> __device__ __forceinline__ void route_row_pre(Frame& F, int t, const f32x4 (&v)[4], const float* g2, const float* MOD, const float* bgrp, const float* bexp,
                                              bf16* H2, int* EID, float* RW, int* CNT, int* LIST, RouteOut* ro = nullptr, const f32x4 (*wgr)[4] = nullptr, const f32x4 (*gms)[4] = nullptr);
template <int COMMIT> __device__ __forceinline__ void route_row_lds(Frame& F, int t, const bf16* XN, const float* g2, const float* MOD, const float* bgrp, const float* bexp,
                                              bf16* H2, int* EID, float* RW, int* CNT, int* LIST) {
    f32x4 v[4]; route_load_row(t, F.lane, XN, v); route_row_pre<COMMIT>(F, t, v, g2, MOD, bgrp, bexp, H2, EID, RW, CNT, LIST);
}
template <int COMMIT> __device__ __forceinline__ void route_row_pre(Frame& F, int t, const f32x4 (&v)[4], const float* g2, const float* MOD, const float* bgrp, const float* bexp,
                                              bf16* H2, int* EID, float* RW, int* CNT, int* LIST, RouteOut* ro, const f32x4 (*wgr)[4], const f32x4 (*gms)[4]) {
    const int lane = F.lane;
    const LAS float* wxT = (const LAS float*)(F.lds + RING_OFF); const LAS float* wgT = (const LAS float*)(F.lds + RT_OFF);
    float ss = 0.f;
#pragma unroll
    for (int j = 0; j < 4; ++j) ss += (v[j].x * v[j].x + v[j].y * v[j].y) + (v[j].z * v[j].z + v[j].w * v[j].w);
#if defined(DIAG_CK) && DIAG_CK == 1
    { unsigned cx = 0;
#pragma unroll
      for (int j = 0; j < 4; ++j) cx ^= (__float_as_uint(v[j].x) * 3u) ^ (__float_as_uint(v[j].y) * 5u) ^ (__float_as_uint(v[j].z) * 7u) ^ (__float_as_uint(v[j].w) * 11u);
      cx *= (unsigned)(t * 2 + 1);
#pragma unroll
      for (int o = 1; o < 64; o <<= 1) cx ^= (unsigned)__shfl_xor((int)cx, o);
      if (COMMIT && lane == 0) atomicXor((unsigned*)(CNT) + 64, cx); }
#endif
    const float rstd = rsqrtf(wave_sum(ss) * (1.f / DM) + EPS);
    float gl[4]; pg8::f32x2 gl2[4] = {{0.f, 0.f}, {0.f, 0.f}, {0.f, 0.f}, {0.f, 0.f}};
    f32x4 h[4];
#pragma unroll
    for (int j = 0; j < 4; ++j) {
        const int n = 4 * lane + 256 * j;
        if (gms) h[j] = (v[j] * rstd) * gms[0][j] + gms[1][j];
        else { const f32x4 g = *(const f32x4*)(g2 + n), sh = *(const f32x4*)(MOD + 3072 + n), sc = *(const f32x4*)(MOD + 4096 + n);
#pragma unroll
            for (int i = 0; i < 4; ++i) h[j][i] = (v[j][i] * rstd) * g[i] * (1.f + sc[i]) + sh[i]; }
#pragma unroll
        for (int c = 0; c < 4; ++c) { const f32x4 w = wgr ? wgr[c][j] : *(const LAS f32x4*)(wgT + c * 1024 + n); gl2[c] += (pg8::f32x2){h[j].x, h[j].y} * (pg8::f32x2){w.x, w.y}; gl2[c] += (pg8::f32x2){h[j].z, h[j].w} * (pg8::f32x2){w.z, w.w}; }
        u32x2 o; o.x = pk2(h[j].x, h[j].y); o.y = pk2(h[j].z, h[j].w);
        st8_sel(H2 + (size_t)t * DM + n, o, (WT_MASK & 16) != 0);
    }
#pragma unroll
    for (int c = 0; c < 4; ++c) gl[c] = wave_sum(gl2[c].x + gl2[c].y) + bgrp[c];
    int g = 0; float gm = gl[0];
#pragma unroll
    for (int c = 1; c < 4; ++c) if (gl[c] > gm) { gm = gl[c]; g = c; }
    g = __builtin_amdgcn_readfirstlane(g);
    float gs = 0.f;
#pragma unroll
    for (int c = 0; c < 4; ++c) gs += __expf(gl[c] - gm);
    const float pg = __builtin_amdgcn_rcpf(gs);
    float el[8]; pg8::f32x2 el2[8] = {{0.f, 0.f}, {0.f, 0.f}, {0.f, 0.f}, {0.f, 0.f}, {0.f, 0.f}, {0.f, 0.f}, {0.f, 0.f}, {0.f, 0.f}};
#pragma unroll
    for (int j = 0; j < 4; ++j)
#pragma unroll
        for (int c = 0; c < 8; ++c) { const f32x4 w = *(const LAS f32x4*)(wxT + (g * 8 + c) * 1024 + 4 * lane + 256 * j); el2[c] += (pg8::f32x2){h[j].x, h[j].y} * (pg8::f32x2){w.x, w.y}; el2[c] += (pg8::f32x2){h[j].z, h[j].w} * (pg8::f32x2){w.z, w.w}; }
#pragma unroll
    for (int c = 0; c < 8; ++c) el[c] = wave_sum(el2[c].x + el2[c].y) + bexp[g * 8 + c];
    int j1 = 0; float m1 = el[0];
#pragma unroll
    for (int c = 1; c < 8; ++c) if (el[c] > m1) { m1 = el[c]; j1 = c; }
    int j2 = -1; float m2 = -INFINITY;
#pragma unroll
    for (int c = 0; c < 8; ++c) if (c != j1 && el[c] > m2) { m2 = el[c]; j2 = c; }
    const float e2 = __expf(m2 - m1), r12 = __builtin_amdgcn_rcpf(1.f + e2), w1 = pg * r12, w2 = pg * e2 * r12;
    if (COMMIT == 2) { ro->ea = __builtin_amdgcn_readfirstlane(g * 8 + j1); ro->eb = __builtin_amdgcn_readfirstlane(g * 8 + j2); ro->w1 = __uint_as_float(__builtin_amdgcn_readfirstlane(__float_as_uint(w1))); ro->w2 = __uint_as_float(__builtin_amdgcn_readfirstlane(__float_as_uint(w2))); return; }
    if (lane == 0) {
        const int ea = g * 8 + j1, eb = g * 8 + j2;
        EID[2 * t] = ea; EID[2 * t + 1] = eb; RW[2 * t] = w1; RW[2 * t + 1] = w2;
        if (COMMIT == 1) {
            const int sa = atomicAdd(CNT + ea, 1); __hip_atomic_store(LIST + ea * SEQ + sa, 2 * t, __ATOMIC_RELAXED, __HIP_MEMORY_SCOPE_AGENT);
            const int sb = atomicAdd(CNT + eb, 1); __hip_atomic_store(LIST + eb * SEQ + sb, 2 * t + 1, __ATOMIC_RELAXED, __HIP_MEMORY_SCOPE_AGENT); }
    }
}

namespace pg8 {
struct AMapDirect { __device__ __forceinline__ int row(const Unit& u, int r) const { return u.pm * BM + r; }
    __device__ __forceinline__ int raw(const Unit& u, int r) const { return row(u, r); } __device__ __forceinline__ int fix(int x) const { return x; } };
struct MoeTable { const LAS int* tt; const int* LIST;
    __device__ __forceinline__ int e(int T) const { return tt[T]; }
    __device__ __forceinline__ int s0(int T) const { return tt[MAXT + T]; }
    __device__ __forceinline__ int cnt(int e_) const { return tt[2 * MAXT + e_]; }
    __device__ __forceinline__ int ntiles() const { return tt[2 * MAXT + 32]; }
};
struct AMapGather { MoeTable mt;
    __device__ __forceinline__ int row(const Unit& u, int r) const { const int T = u.pm, e = mt.e(T), c = mt.cnt(e); int s = mt.s0(T) + r; s = s < c ? s : c - 1; return mt.LIST[e * SEQ + s] >> 1; }
    __device__ __forceinline__ int raw(const Unit& u, int r) const { const int T = u.pm, e = mt.e(T), c = mt.cnt(e); int s = mt.s0(T) + r; s = s < c ? s : c - 1; return mt.LIST[e * SEQ + s]; }
    __device__ __forceinline__ int fix(int x) const { return x >> 1; } };
struct MoeOrder { MoeTable mt; int G, c;
    __device__ __forceinline__ bool next(int i, Unit& u) const { const int L = i * G + c; if (L >= 4 * mt.ntiles()) return false; const int T = L >> 2; u.pm = T; u.pn = mt.e(T) * 4 + (L & 3); return true; }
    __device__ __forceinline__ void a_ready(const Unit&) const {}
    __device__ __forceinline__ void done(const Unit&) const {}
};
struct MoeOrder1 { MoeTable mt; int G, c; unsigned* tcnt;
    __device__ __forceinline__ bool next(int i, Unit& u) const { const int L = i * G + c; if (L >= 4 * mt.ntiles()) return false; const int T = L >> 2; u.pm = T; u.pn = mt.e(T) * 4 + (L & 3); return true; }
    __device__ __forceinline__ void a_ready(const Unit&) const {}
    __device__ __forceinline__ void done(const Unit& u) const { asm volatile("s_waitcnt vmcnt(0)" ::: "memory");
        if (fresh_lane() == 0) (void)__hip_atomic_fetch_add(tcnt + 64 * u.pm, 1u, __ATOMIC_RELAXED, __HIP_MEMORY_SCOPE_AGENT); }
};
#ifndef NOACQ_MASK
#define NOACQ_MASK 0
#endif
#ifndef MOE_NOACQ
#define MOE_NOACQ 0
#endif
#ifndef MOE_PEEK
#define MOE_PEEK 0
#endif
struct MoeOrder2 { MoeTable mt; int G, c, wave; unsigned* tcnt; unsigned* tmo; mutable bool acq_all = false;
    __device__ __forceinline__ bool next(int i, Unit& u) const {
        const int n1 = 4 * mt.ntiles(), k3 = n1 - 512; int L;
        if (G != 256 || k3 < 0 || k3 > 255) L = i * G + c;
        else if (c < k3) { if (i > 0) return false; L = 512 + c; }
        else { const int nb = 256 - k3; L = (c - k3) + i * nb; if (L >= 512) return false; }
        if (L >= n1) return false; const int T = L >> 2; u.pm = T; u.pn = mt.e(T) * 4 + (L & 3); return true; }
    __device__ __forceinline__ void a_ready(const Unit& u) const {
        if (wave == 0 && !acq_all) { unsigned sp = 0;
            while ((unsigned)__builtin_amdgcn_readfirstlane(__hip_atomic_load(tcnt + 64 * u.pm, __ATOMIC_RELAXED, __HIP_MEMORY_SCOPE_AGENT)) < 32u) { __builtin_amdgcn_s_sleep(2);
                if ((++sp & 1023u) == 0u && (sp > (1u << 22) || __builtin_amdgcn_readfirstlane(__hip_atomic_load(tmo, __ATOMIC_RELAXED, __HIP_MEMORY_SCOPE_AGENT)) != 0u)) { if (fresh_lane() == 0) __hip_atomic_store(tmo, 1u, __ATOMIC_RELAXED, __HIP_MEMORY_SCOPE_AGENT); break; } }
            if (MOE_PEEK) { bool all = true;
#pragma unroll
                for (int j = 0; j < 3; ++j) { Unit o; if (next(j, o)) all = all && ((unsigned)__builtin_amdgcn_readfirstlane(__hip_atomic_load(tcnt + 64 * o.pm, __ATOMIC_RELAXED, __HIP_MEMORY_SCOPE_AGENT)) >= 32u); }
                acq_all = all; }
            if (!MOE_NOACQ) __builtin_amdgcn_fence(__ATOMIC_ACQUIRE, "agent"); asm volatile("s_waitcnt vmcnt(0)" ::: "memory"); }
        asm volatile("" ::: "memory"); __builtin_amdgcn_s_barrier(); asm volatile("" ::: "memory");
    }
    __device__ __forceinline__ void done(const Unit&) const {}
};
__device__ __forceinline__ u32x4 pack8(const f32x4& a, const f32x4& b) { u32x4 w; w.x = cvt_pk_bf16(a[0], a[1]); w.y = cvt_pk_bf16(a[2], a[3]); w.z = cvt_pk_bf16(b[0], b[1]); w.w = cvt_pk_bf16(b[2], b[3]); return w; }

struct EpiInProj {
    static constexpr bool PERM = true, AFTER_DRAIN = false;
    bf16 *Q, *K, *V, *QR, *KR, *VR, *GR; const float *gq, *gk, *ROPE;
    __device__ __forceinline__ void operator()(const f32x4 (&acc)[2][2][4][2], const Unit& u, int wr, int wc, int fr, int fq) const {
        const int pn = u.pn; int kind, h;
        if (pn < 2) { kind = 0; h = pn * 4 + wc; } else if (pn == 2) { if (wc < 2) { kind = 1; h = wc; } else { kind = 2; h = wc - 2; } }
        else if (pn == 3) { kind = 3; h = wc; } else if (pn == 4) { kind = 4; h = wc; } else if (pn < 7) { kind = 5; h = (pn - 5) * 4 + wc; } else { kind = 6; h = (pn - 7) * 4 + wc; }
        const bool isctx = (u.pm == 0);
        if (isctx && (kind == 0 || kind == 3 || kind == 6)) return;
        const bool norm = kind <= 1, rope = !isctx && (kind == 0 || kind == 1 || kind == 3 || kind == 4);
        f32x4 gg[2][2];
#pragma unroll
        for (int bj = 0; bj < 2; ++bj)
#pragma unroll
            for (int n = 0; n < 2; ++n) gg[bj][n] = norm ? *(const f32x4*)((kind == 0 ? gq : gk) + 32 * bj + 8 * fq + 4 * n) : (f32x4){1.f, 1.f, 1.f, 1.f};
        const float osc = kind == 0 ? QSCALE : (kind == 4 ? 0.125f : 1.f);
        bf16* obase; int ostride; bool use_t;
        switch (kind) {
            case 0: obase = Q + h * 64; ostride = 512; use_t = true; break;
            case 1: obase = K + (size_t)h * NKV * 64; ostride = 64; use_t = false; break;
            case 2: obase = V + (size_t)h * NKV * 64; ostride = 64; use_t = false; break;
            case 3: obase = QR + (size_t)h * SEQ * 64; ostride = 64; use_t = true; break;
            case 4: obase = KR + (size_t)h * NKV * 64; ostride = 64; use_t = false; break;
            case 5: obase = VR + (size_t)(h >> 1) * NKV * 128 + (h & 1) * 64; ostride = 128; use_t = false; break;
            default: obase = GR + h * 64; ostride = 512; use_t = true; break;
        }
        f32x4 csr[2][2], csc[4][2];
        if (rope) { const int tb = u.pm * BM - CL + wr * 64;
#pragma unroll
            for (int ai = 0; ai < 2; ++ai)
#pragma unroll
                for (int n = 0; n < 2; ++n) csr[ai][n] = *(const f32x4*)(ROPE + ((((tb + ai * HALF) >> 6) * 16 + 4 * fq) * 2) + 4 * n);
#pragma unroll
            for (int m = 0; m < 4; ++m)
#pragma unroll
                for (int n = 0; n < 2; ++n) csc[m][n] = *(const f32x4*)(ROPE + (((m * 16 + fr) * 16 + 4 * fq) * 2) + 4 * n); }
#pragma unroll
        for (int ai = 0; ai < 2; ++ai)
#pragma unroll
            for (int m = 0; m < 4; ++m) {
                const int r = u.pm * BM + ai * HALF + wr * 64 + m * 16 + fr, t = r - CL;
                f32x4 v[2][2];
#pragma unroll
                for (int bj = 0; bj < 2; ++bj)
#pragma unroll
                    for (int n = 0; n < 2; ++n) v[bj][n] = acc[ai][bj][m][n];
                if (norm) { float ss = 0.f;
#pragma unroll
                    for (int bj = 0; bj < 2; ++bj)
#pragma unroll
                        for (int n = 0; n < 2; ++n) ss += (v[bj][n][0] * v[bj][n][0] + v[bj][n][1] * v[bj][n][1]) + (v[bj][n][2] * v[bj][n][2] + v[bj][n][3] * v[bj][n][3]);
                    ss += __shfl_xor(ss, 16); ss += __shfl_xor(ss, 32);
                    const float rn = rsqrtf(ss * (1.f / 64.f) + EPS);
#pragma unroll
                    for (int bj = 0; bj < 2; ++bj)
#pragma unroll
                        for (int n = 0; n < 2; ++n) v[bj][n] = v[bj][n] * rn * gg[bj][n]; }
                if (rope) {
#pragma unroll
                    for (int bj = 0; bj < 2; ++bj) {
#pragma unroll
                        for (int n = 0; n < 2; ++n) { const f32x4 cs = bj ? csc[m][n] : csr[ai][n]; const f32x4 x = v[bj][n];
                            v[bj][n] = (f32x4){x[0] * cs[0] - x[1] * cs[1], x[0] * cs[1] + x[1] * cs[0], x[2] * cs[2] - x[3] * cs[3], x[2] * cs[3] + x[3] * cs[2]}; } } }
#pragma unroll
                for (int bj = 0; bj < 2; ++bj) {
                    st16_sel(obase + (size_t)(use_t ? t : r) * ostride + 32 * bj + 8 * fq, pack8(v[bj][0] * osc, v[bj][1] * osc), (WT_MASK & 2) != 0); }
            }
    }
};
template <bool WT> struct EpiOutProj {
    static constexpr bool PERM = true, AFTER_DRAIN = false;
    const float* x; const float* gt1; bf16* XN;
    __device__ __forceinline__ void operator()(const f32x4 (&acc)[2][2][4][2], const Unit& u, int wr, int wc, int fr, int fq) const {
        const int c0 = u.pn * BM + wc * 32 + 8 * fq;
        f32x4 g[2][2];
#pragma unroll
        for (int bj = 0; bj < 2; ++bj)
#pragma unroll
            for (int n = 0; n < 2; ++n) g[bj][n] = *(const f32x4*)(gt1 + c0 + bj * HALF + 4 * n);
#pragma unroll
        for (int ai = 0; ai < 2; ++ai) { f32x4 xv[4][2][2];
#pragma unroll
            for (int m = 0; m < 4; ++m) { const size_t off = (size_t)(u.pm * BM + ai * HALF + wr * 64 + m * 16 + fr) * DM + c0;
#pragma unroll
                for (int bj = 0; bj < 2; ++bj)
#pragma unroll
                    for (int n = 0; n < 2; ++n) xv[m][bj][n] = NT_LD((const f32x4*)(x + off + bj * HALF + 4 * n)); }
#pragma unroll
            for (int m = 0; m < 4; ++m) { const size_t off = (size_t)(u.pm * BM + ai * HALF + wr * 64 + m * 16 + fr) * DM + c0;
#pragma unroll
                for (int bj = 0; bj < 2; ++bj) { const u32x4 w = pack8(xv[m][bj][0] + g[bj][0] * acc[ai][bj][m][0], xv[m][bj][1] + g[bj][1] * acc[ai][bj][m][1]);
                    if (WT) store16_wt(XN + off + bj * HALF, __builtin_bit_cast(f32x4, w)); else *(u32x4*)(XN + off + bj * HALF) = w; } } }
    }
};
#ifndef ACT_ST16
#define ACT_ST16 0
#endif
template <bool WT> struct EpiSwiGLU {
    static constexpr bool PERM = true, AFTER_DRAIN = false;
    bf16* ACT;
    __device__ __forceinline__ void operator()(const f32x4 (&acc)[2][2][4][2], const Unit& u, int wr, int wc, int fr, int fq) const {
        const int c0 = (u.pn & 3) * 128 + wc * 32 + 8 * fq;
#pragma unroll
        for (int ai = 0; ai < 2; ++ai)
#pragma unroll
            for (int m = 0; m < 4; ++m) { f32x4 o[2];
#pragma unroll
                for (int n = 0; n < 2; ++n)
#pragma unroll
                    for (int i = 0; i < 4; ++i) { const float gv = acc[ai][0][m][n][i]; o[n][i] = gv * __builtin_amdgcn_rcpf(1.f + __expf(-gv)) * acc[ai][1][m][n][i]; }
                const u32x4 w = pack8(o[0], o[1]); bf16* dst = ACT + (size_t)(u.pm * BM + ai * HALF + wr * 64 + m * 16 + fr) * DEXP + c0;
                if (WT && !ACT_ST16) { __hip_atomic_store((unsigned long long*)dst, (unsigned long long)w.x | ((unsigned long long)w.y << 32), __ATOMIC_RELAXED, __HIP_MEMORY_SCOPE_AGENT);
                          __hip_atomic_store((unsigned long long*)dst + 1, (unsigned long long)w.z | ((unsigned long long)w.w << 32), __ATOMIC_RELAXED, __HIP_MEMORY_SCOPE_AGENT); }
                else st16_sel(dst, w, WT); }
    }
};
struct EpiScatter {
    static constexpr bool PERM = true, AFTER_DRAIN = false;
    MoeTable mt; bf16* Y; int* FLAG;
    __device__ __forceinline__ void operator()(const f32x4 (&acc)[2][2][4][2], const Unit& u, int wr, int wc, int fr, int fq) const {
        const int T = u.pm, e = mt.e(T), cnt = mt.cnt(e), s0 = mt.s0(T); const int c0 = (u.pn & 3) * BM + wc * 32 + 8 * fq;
        int al[2][4];
#pragma unroll
        for (int ai = 0; ai < 2; ++ai)
#pragma unroll
            for (int m = 0; m < 4; ++m) { const int s = s0 + ai * HALF + wr * 64 + m * 16 + fr; al[ai][m] = s < cnt ? mt.LIST[e * SEQ + s] : -1; }
#pragma unroll
        for (int ai = 0; ai < 2; ++ai)
#pragma unroll
            for (int m = 0; m < 4; ++m) { const int a = al[ai][m];
                if (a >= 0) { bf16* dst = Y + ((size_t)(a & 1) * SEQ + (a >> 1)) * DM + c0;
#ifdef DIAG_FLAG
                    if ((u.pn & 3) == 0 && wc == 0 && fq == 0) atomicAdd(FLAG + a, 1);
#endif
#pragma unroll
                    for (int bj = 0; bj < 2; ++bj) st16_sel(dst + bj * HALF, pack8(acc[ai][bj][m][0], acc[ai][bj][m][1]), (WT_MASK & 32) != 0); } }
    }
};
}
__device__ __forceinline__ void moe_build_table(Frame& F, const int* CNT) {
    LAS int* tt = (LAS int*)(F.lds + TT_OFF);
    if (F.wave == 0) { const int lane = fresh_lane(); const int c = lane < NEXP ? CNT[lane] : 0; const int nt = (c + 255) >> 8; int incl = nt;
#pragma unroll
        for (int o = 1; o < 32; o <<= 1) { const int v = __shfl_up(incl, o); if (lane >= o) incl += v; }
        const int first = incl - nt;
        if (lane < NEXP) { tt[2 * MAXT + lane] = c; for (int k = 0; k < nt; ++k) if (first + k < MAXT) { tt[first + k] = lane; tt[MAXT + first + k] = 256 * k; } }
        const int total = __shfl(incl, NEXP - 1); if (lane == 0) tt[2 * MAXT + 32] = total < MAXT ? total : MAXT; }
    __syncthreads();
}

namespace ret {
typedef short bf16x8 __attribute__((ext_vector_type(8)));
typedef short s16x4 __attribute__((ext_vector_type(4)));
constexpr int KS = 144, VS = 272, PS = 272;
constexpr int NCH = 130;
#define RET_MFMA(a, b, c) __builtin_amdgcn_mfma_f32_16x16x32_bf16(a, b, c, 0, 0, 0)
__device__ __forceinline__ bf16x8 tr_frag(LAS unsigned char* base, int S, int tok0, int feat0, int lane) {
    const int g = lane >> 4, i = lane & 15;
#ifndef RET_NO_TR
    const int q = i >> 2, p = i & 3;
    LAS unsigned char* a0 = base + (tok0 + 8 * g + q) * S + (feat0 + 4 * p) * 2;
    const s16x4 lo = __builtin_bit_cast(s16x4, __builtin_amdgcn_ds_read_tr16_b64_v4i16((LAS s16x4*)a0));
    const s16x4 hi = __builtin_bit_cast(s16x4, __builtin_amdgcn_ds_read_tr16_b64_v4i16((LAS s16x4*)(a0 + 4 * S)));
    return (bf16x8){lo[0], lo[1], lo[2], lo[3], hi[0], hi[1], hi[2], hi[3]};
#else
    bf16x8 r;
#pragma unroll
    for (int j = 0; j < 8; ++j) r[j] = *(LAS short*)(base + (tok0 + 8 * g + j) * S + (feat0 + i) * 2);
    return r;
#endif
}
__device__ __forceinline__ u32x4 scale8(u32x4 w, float s) {
    u32x4 o;
#pragma unroll
    for (int i = 0; i < 4; ++i) { const float lo = __uint_as_float(w[i] << 16) * s, hi = __uint_as_float(w[i] & 0xffff0000u) * s; o[i] = pk2(lo, hi); }
    return o;
}
#ifndef RET_WT
#define RET_WT 0
#endif
__device__ __forceinline__ void r1_unit(Frame& F, int h, int j, const bf16* KR, const bf16* VR, float lgf, float lgb, float* U) {
    LAS unsigned char* Kf = F.lds, *Kb = F.lds + 128 * KS, *Vs = F.lds + 2 * 128 * KS;
    const int lane = fresh_lane(), tid = F.wave * 64 + lane;
    const bf16* kc = KR + ((size_t)h * NKV + 128 * j) * 64; const bf16* vc = VR + ((size_t)h * NKV + 128 * j) * 128;
#pragma unroll
    for (int i = 0; i < 2; ++i) { const int id = tid + 512 * i, row = id >> 3, ch = id & 7; const u32x4 w = *(const u32x4*)(kc + row * 64 + ch * 8);
        *(LAS u32x4*)(Kf + row * KS + ch * 16) = scale8(w, __expf(lgf * (float)(127 - row))); *(LAS u32x4*)(Kb + row * KS + ch * 16) = scale8(w, __expf(lgb * (float)row)); }
#pragma unroll
    for (int i = 0; i < 4; ++i) { const int id = tid + 512 * i, row = id >> 4, ch = id & 15; *(LAS u32x4*)(Vs + row * VS + ch * 16) = *(const u32x4*)(vc + row * 128 + ch * 8); }
    __syncthreads();
    const int w = F.wave, g = lane >> 4, li = lane & 15;
    bf16x8 a[4];
#pragma unroll
    for (int ks = 0; ks < 4; ++ks) a[ks] = tr_frag(Vs, VS, 32 * ks, 16 * w, lane);
#pragma unroll
    for (int dir = 0; dir < 2; ++dir)
#pragma unroll
        for (int c = 0; c < 4; ++c) { f32x4 acc = {0.f, 0.f, 0.f, 0.f}; bf16x8 bfr[4];
#pragma unroll
            for (int ks = 0; ks < 4; ++ks) bfr[ks] = tr_frag(dir ? Kb : Kf, KS, 32 * ks, 16 * c, lane);
#pragma unroll
            for (int ks = 0; ks < 4; ++ks) acc = RET_MFMA(a[ks], bfr[ks], acc);
            float* up = U + ((size_t)((h * NCH + j) * 2 + dir)) * 8192 + (16 * w + 4 * g) * 64 + 16 * c + li;
#pragma unroll
            for (int r = 0; r < 4; ++r) { if (RET_WT) __hip_atomic_store(up + r * 64, acc[r], __ATOMIC_RELAXED, __HIP_MEMORY_SCOPE_AGENT); else up[r * 64] = acc[r]; } }
    __syncthreads();
}
__device__ __forceinline__ void r2_scan(int gid, const float* U, float lgf, float lgb, int h, int dir, bf16* SP) {
    const int e = gid & 8191; const float gC = __expf((dir ? lgb : lgf) * 128.f); float S = 0.f;
    const float* up = U + (size_t)(h * NCH * 2 + dir) * 8192 + e; bf16* sp = SP + (size_t)(h * 128 * 2 + dir) * 8192 + e;
    if (dir == 0) {
#pragma unroll 44
        for (int j = 0; j < NCH; ++j) { if (j >= 2) sp[(size_t)(j - 2) * 16384] = f2bf(S); S = gC * S + up[(size_t)j * 16384]; }
    } else {
        S = up[(size_t)1 * 16384]; S = gC * S + up[0];
#pragma unroll 43
        for (int j = NCH - 1; j >= 2; --j) { sp[(size_t)(j - 2) * 16384] = f2bf(S); S = gC * S + up[(size_t)j * 16384]; }
    }
}
__device__ __forceinline__ void r2_scan_block(Frame& F, int blk, const float* U, const float* dec_f, const float* dec_b, bf16* SP) {
    const int cid0 = blk * 256, combo = cid0 >> 13, h = combo >> 1, dir = combo & 1, s = F.wave, lane = fresh_lane(), vz = lane >> 6;
    const float lg = lsig(dir ? dec_b[h] : dec_f[h]), gC = __expf(lg * 128.f), D16 = __expf(lg * 128.f * 16.f);
    LAS float* Tl = (LAS float*)(F.lds + RING_OFF);
    float pre[4][16], c0[4];
#pragma unroll
    for (int q = 0; q < 4; ++q) { const int e = (cid0 + q * 64 + lane) & 8191; const float* up = U + (size_t)(h * NCH * 2 + dir) * 8192 + e;
        const float ua = up[(size_t)(dir + vz) * 16384], ub = up[(size_t)(1 - dir + vz) * 16384];
        float u[16];
#pragma unroll
        for (int k = 0; k < 16; ++k) { const int n = (dir == 0 ? 16 * s + k : 127 - 16 * s - k) + vz; u[k] = up[(size_t)(2 + n) * 16384]; }
        c0[q] = gC * ua + ub;
        float P = 0.f;
#pragma unroll
        for (int k = 0; k < 16; ++k) { pre[q][k] = P; P = gC * P + u[k]; }
        Tl[s * 256 + q * 64 + lane] = P; }
    __syncthreads();
#pragma unroll
    for (int q = 0; q < 4; ++q) { float C = c0[q];
        for (int s2 = 0; s2 < s; ++s2) C = C * D16 + Tl[s2 * 256 + q * 64 + lane];
        const int e = (cid0 + q * 64 + lane) & 8191; bf16* sp = SP + (size_t)(h * 128 * 2 + dir) * 8192 + e; float cur = C;
#pragma unroll
        for (int k = 0; k < 16; ++k) { const int n = (dir == 0 ? 16 * s + k : 127 - 16 * s - k) + vz; const bf16 sv = f2bf(cur + pre[q][k]); if (RET_WT) __hip_atomic_store(sp + (size_t)n * 16384, sv, __ATOMIC_RELAXED, __HIP_MEMORY_SCOPE_AGENT); else sp[(size_t)n * 16384] = sv; cur *= gC; } }
    __syncthreads();
}
struct R3Regs { u32x4 kreg[2], vreg[4], sreg[4]; bf16x8 qa[2]; };
__device__ __forceinline__ void r3_load(R3Regs& R, int wv, int lane, int h, int n, const bf16* QR, const bf16* KR, const bf16* VR, const bf16* SP) {
    const int t0 = 128 * n, tid = wv * 64 + lane, g = lane >> 4, li = lane & 15; const bf16* kc = KR + ((size_t)h * NKV + CL + t0) * 64; const bf16* vc = VR + ((size_t)h * NKV + CL + t0) * 128;
    const bf16* spc = SP + (size_t)((h * 128 + n) * 2) * 8192;
#pragma unroll
    for (int q = 0; q < 2; ++q) { const int id = tid + 512 * q; R.kreg[q] = *(const u32x4*)(kc + (id >> 3) * 64 + (id & 7) * 8); }
#pragma unroll
    for (int q = 0; q < 4; ++q) { const int id = tid + 512 * q; R.vreg[q] = *(const u32x4*)(vc + (id >> 4) * 128 + (id & 15) * 8); R.sreg[q] = *(const u32x4*)(spc + (size_t)id * 8); }
#pragma unroll
    for (int ks = 0; ks < 2; ++ks) R.qa[ks] = *(const bf16x8*)(QR + ((size_t)h * SEQ + t0 + 16 * wv + li) * 64 + 32 * ks + 8 * g);
}
__device__ __forceinline__ void r3_unit(Frame& F, R3Regs& R, int h, int n, int hn, int nn, const bf16* QR, const bf16* KR, const bf16* VR, const bf16* GR, const bf16* SP,
                                        float lgf, float lgb, const float* gn_g, const float* gn_b, bf16* MIX) {
    LAS unsigned char* Ks = F.lds, *Vs = F.lds + 128 * KS, *Ps = F.lds + 128 * KS + 128 * VS, *Ss = F.lds + 128 * KS + 2 * 128 * VS;
    const int t0 = 128 * n;
    const int w = F.wave, lane = fresh_lane(), g = lane >> 4, li = lane & 15, tid = w * 64 + lane;
    const int i = 16 * w + li, t = t0 + i;
    bf16x8 qa[2]; qa[0] = R.qa[0]; qa[1] = R.qa[1];
#pragma unroll
    for (int q = 0; q < 2; ++q) { const int id = tid + 512 * q; *(LAS u32x4*)(Ks + (id >> 3) * KS + (id & 7) * 16) = R.kreg[q]; }
#pragma unroll
    for (int q = 0; q < 4; ++q) { const int id = tid + 512 * q; *(LAS u32x4*)(Vs + (id >> 4) * VS + (id & 15) * 16) = R.vreg[q]; *(LAS u32x4*)(Ss + (id >> 3) * KS + (id & 7) * 16) = R.sreg[q]; }
    if (hn >= 0) r3_load(R, w, lane, hn, nn, QR, KR, VR, SP);
    __syncthreads();
    u32x2 greg[8];
#pragma unroll
    for (int d = 0; d < 8; ++d) greg[d] = *(const u32x2*)(GR + (size_t)t * 512 + h * 128 + 16 * d + 4 * g);
    float cf[4], cb[4];
#pragma unroll
    for (int r = 0; r < 4; ++r) { cf[r] = __expf(-lgf * (float)r); cb[r] = __expf(lgb * (float)r); }
    bf16x8 kfr[8][2];
#pragma unroll
    for (int jt = 0; jt < 8; ++jt)
#pragma unroll
        for (int ks = 0; ks < 2; ++ks) kfr[jt][ks] = *(LAS bf16x8*)(Ks + (16 * jt + li) * KS + (32 * ks + 8 * g) * 2);
#pragma unroll
    for (int jt = 0; jt < 8; ++jt) { f32x4 s = {0.f, 0.f, 0.f, 0.f};
#pragma unroll
        for (int ks = 0; ks < 2; ++ks) s = RET_MFMA(kfr[jt][ks], qa[ks], s);
        const int df0 = i - (16 * jt + 4 * g); const float ef0 = __expf(lgf * (float)df0), eb0 = __expf(-lgb * (float)df0);
        float p[4];
#pragma unroll
        for (int r = 0; r < 4; ++r) p[r] = s[r] * ((df0 - r >= 0) ? ef0 * cf[r] : eb0 * cb[r]);
        u32x2 pw; pw.x = pk2(p[0], p[1]); pw.y = pk2(p[2], p[3]);
        *(LAS u32x2*)(Ps + i * PS + (16 * jt + 4 * g) * 2) = pw; }
    LDS_WAIT();
    f32x4 acc[8], af[8], ab[8];
#pragma unroll
    for (int d = 0; d < 8; ++d) { acc[d] = (f32x4){0.f, 0.f, 0.f, 0.f}; af[d] = acc[d]; ab[d] = acc[d]; }
#pragma unroll
    for (int ks = 0; ks < 4; ++ks) { const bf16x8 pf = *(LAS bf16x8*)(Ps + i * PS + (32 * ks + 8 * g) * 2); bf16x8 vf[8];
#pragma unroll
        for (int d = 0; d < 8; ++d) vf[d] = tr_frag(Vs, VS, 32 * ks, 16 * d, lane);
#pragma unroll
        for (int d = 0; d < 8; ++d) acc[d] = RET_MFMA(vf[d], pf, acc[d]); }
#pragma unroll
    for (int ks = 0; ks < 2; ++ks) { bf16x8 sf[8], sb[8];
#pragma unroll
        for (int d = 0; d < 8; ++d) { const int off = (16 * d + li) * KS + (32 * ks + 8 * g) * 2; sf[d] = *(LAS bf16x8*)(Ss + off); sb[d] = *(LAS bf16x8*)(Ss + 128 * KS + off); }
#pragma unroll
        for (int d = 0; d < 8; ++d) { af[d] = RET_MFMA(sf[d], qa[ks], af[d]); ab[d] = RET_MFMA(sb[d], qa[ks], ab[d]); } }
    const float xf = __expf(lgf * (float)(i + 1)), xb = __expf(lgb * (float)(128 - i));
    float s1 = 0.f;
#pragma unroll
    for (int d = 0; d < 8; ++d) { acc[d] = acc[d] + xf * af[d] + xb * ab[d]; s1 += (acc[d][0] + acc[d][1]) + (acc[d][2] + acc[d][3]); }
    s1 += __shfl_xor(s1, 16); s1 += __shfl_xor(s1, 32);
    const float mu = s1 * (1.f / 128.f); float s2 = 0.f;
#pragma unroll
    for (int d = 0; d < 8; ++d) { acc[d] = acc[d] - mu; s2 += (acc[d][0] * acc[d][0] + acc[d][1] * acc[d][1]) + (acc[d][2] * acc[d][2] + acc[d][3] * acc[d][3]); }
    s2 += __shfl_xor(s2, 16); s2 += __shfl_xor(s2, 32);
    const float rs = rsqrtf(s2 * (1.f / 128.f) + EPS);
#pragma unroll
    for (int d = 0; d < 8; ++d) { const int c0 = h * 128 + 16 * d + 4 * g; const f32x4 gg = *(const f32x4*)(gn_g + c0), bb = *(const f32x4*)(gn_b + c0); const u32x2 gr = greg[d];
        const float r0 = __uint_as_float(gr.x << 16), r1 = __uint_as_float(gr.x & 0xffff0000u), r2 = __uint_as_float(gr.y << 16), r3 = __uint_as_float(gr.y & 0xffff0000u);
        u32x2 o; o.x = pk2((acc[d][0] * rs * gg[0] + bb[0]) * silu_f(r0), (acc[d][1] * rs * gg[1] + bb[1]) * silu_f(r1));
        o.y = pk2((acc[d][2] * rs * gg[2] + bb[2]) * silu_f(r2), (acc[d][3] * rs * gg[3] + bb[3]) * silu_f(r3));
        st8_sel(MIX + (size_t)t * 1024 + 512 + c0, o, (WT_MASK & 8) != 0); }
    __syncthreads();
}
#undef RET_MFMA
}
#ifndef FUSE67_WT
#define FUSE67_WT false
#endif
constexpr int N_PHASES = 11;
struct Args { const float* in[24]; float* out; unsigned char* ws; int ph_lo, ph_hi, flags, pad; };
__global__ void __launch_bounds__(NTHREADS, 2) mega_fwd(Args args) {
    extern __shared__ __attribute__((aligned(16))) unsigned char lds[];
    Frame F;
    F.lds = (LAS unsigned char*)lds; F.MISC = (volatile LAS unsigned*)(F.lds + MISC_OFF);
    F.tid = threadIdx.x; F.lane = F.tid & 63; F.wave = __builtin_amdgcn_readfirstlane(F.tid >> 6);
    F.G = gridDim.x; { const int bx = blockIdx.x; F.vcu = (F.G % 8 == 0) ? (bx % 8) * (F.G / 8) + bx / 8 : bx; }
    unsigned char* ws = args.ws; const float* const* in = args.in;
    F.ctl = (unsigned*)(ws + WS_CTL);
    float* MOD = (float*)(ws + WS_MOD); float* ROPE = (float*)(ws + WS_ROPE);
    int* EID = (int*)(ws + WS_EID); float* RW = (float*)(ws + WS_RW); int* LIST = (int*)(ws + WS_LIST); int* CNT = (int*)(ws + WS_CTL) + CW_CNT;
    bf16 *Wi = (bf16*)(ws + WS_WI), *Wo = (bf16*)(ws + WS_WO), *Wgu = (bf16*)(ws + WS_WGU), *Wd = (bf16*)(ws + WS_WD);
    bf16 *HX = (bf16*)(ws + WS_HX), *MIX = (bf16*)(ws + WS_MIX), *H2 = (bf16*)(ws + WS_H2), *Q = (bf16*)(ws + WS_Q), *K = (bf16*)(ws + WS_K), *V = (bf16*)(ws + WS_V);
    bf16 *QR = (bf16*)(ws + WS_QR), *KR = (bf16*)(ws + WS_KR), *VR = (bf16*)(ws + WS_VR), *GR = (bf16*)(ws + WS_GR), *SP = (bf16*)(ws + WS_SP), *ACT = (bf16*)(ws + WS_ACT), *Y = (bf16*)(ws + WS_Y);
    float* U = (float*)(ws + WS_U); bf16* XN = (bf16*)(ws + WS_XNB);
    for (int u = F.tid; u < (LDS_BYTES - LDSCTL_OFF) / 4; u += NTHREADS) ((LAS unsigned*)(F.lds + LDSCTL_OFF))[u] = 0u;
    __syncthreads();
#ifdef DIAG_STOP
    const int lo = args.ph_lo, hi = (args.ph_hi < DIAG_STOP ? args.ph_hi : DIAG_STOP);
#else
    const int lo = args.ph_lo, hi = args.ph_hi;
#endif
    XcdBarrier bar; bar.bar = (unsigned*)F.ctl + CW_BAR; bar.x = 0; bar.st = nullptr;
    if (hi - lo > 1) bar = xcd_barrier_post((unsigned*)F.ctl + CW_BAR, F.MISC + 8);
#define IN(k) (lo <= (k) && (k) < hi)
#ifndef PROBE_PHASE
#define PROBE_PHASE -1
#endif
#define PH(k, ...) do { if (IN(k)) { { __VA_ARGS__ } if (PROBE_PHASE == (k) || PROBE_PHASE == -2) { __syncthreads(); { __VA_ARGS__ } } } } while (0)
#define REFRESH() do { F.lane = fresh_lane(); F.tid = F.wave * 64 + F.lane; } while (0)
#define SEAM(k) do { if (IN(k) && IN((k) + 1)) { xcd_barrier(bar, F.wave == 0 && fresh_lane() == 0); } REFRESH(); } while (0)
    const int gw = F.vcu * NWAVES + F.wave, NGW = F.G * NWAVES;
    REFRESH();

#ifdef DIAG_FLAG
    if (IN(0)) { int* FLAG = (int*)(ws + WS_EID + 512 * 1024); for (int i = F.vcu * NTHREADS + F.tid; i < 2 * SEQ; i += F.G * NTHREADS) FLAG[i] = 0; }
#endif
#ifdef DIAG_CK
#define CKBUF(ptr, n16) do { const u32x4* cp_ = (const u32x4*)(ptr); unsigned cx_ = 0; \
        for (size_t q_ = (size_t)F.vcu * NTHREADS + F.tid; q_ < (size_t)(n16); q_ += (size_t)F.G * NTHREADS) { const u32x4 w_ = cp_[q_]; const unsigned k_ = (unsigned)(q_ * 2654435761ull) | 1u; \
            cx_ ^= (w_.x * k_) ^ (w_.y * (k_ + 2u)) ^ (w_.z * (k_ + 4u)) ^ (w_.w * (k_ + 6u)); } \
        _Pragma("unroll") for (int o_ = 1; o_ < 64; o_ <<= 1) cx_ ^= (unsigned)__shfl_xor((int)cx_, o_); \
        if (F.lane == 0) atomicXor((unsigned*)(CNT) + 64, cx_); } while (0)
#else
#define CKBUF(ptr, n16) do {} while (0)
#endif
    PH(0,  const P0Args a{(unsigned*)F.ctl + CW_MODCNT, in[1], in[3], in[4], in[5], in[7], in[14], in[20], in[21], in[22], in[16], in[18], MOD, ROPE, (float*)(ws + WS_RTW), Wi, Wo, Wgu, Wd}; p0_prologue(F, a); );
    REFRESH();
#ifdef PROBE_BAR
    if (hi - lo > 1) { for (int q = 0; q < PROBE_BAR; ++q) xcd_barrier(bar, F.wave == 0 && fresh_lane() == 0); }
#endif
    PH(1,  wait_ge((unsigned*)F.ctl + CW_MODCNT, 192u, F.tid == 0, (unsigned*)F.ctl + CW_TMO); { int r = gw; for (; r + 3 * NGW < NKV; r += 4 * NGW) { const int rows[4] = {r, r + NGW, r + 2 * NGW, r + 3 * NGW}; norm1_rows<4>(rows, F.lane, in[0], in[2], in[6], MOD, HX); }
            for (; r < NKV; r += NGW) { const int rows[1] = {r}; norm1_rows<1>(rows, F.lane, in[0], in[2], in[6], MOD, HX); } } );
    SEAM(1);
#if defined(DIAG_CK) && DIAG_CK == 4
    CKBUF(HX, (size_t)NKV * DM / 8);
#endif
#if defined(DIAG_CK) && DIAG_CK == 7
    CKBUF(Wi, (size_t)NPROJ * DM / 8); CKBUF(MOD, 12288 / 4); CKBUF(ROPE, 8192 / 4);
#endif
    PH(2,
        pg8::Gemm g{HX, Wi, NKV, NPROJ, DM}; pg8::StaticOrder S; S.init(NKV, NPROJ, F.G, (int)blockIdx.x);
        pg8::EpiInProj E{Q, K, V, QR, KR, VR, GR, in[8], in[9], ROPE}; pg8::AMapDirect AM;
        pg8::gemm_phase<pg8::EpiInProj, pg8::StaticOrder, pg8::AMapDirect, true, true>(F.lds + RING_OFF, g, S, E, AM, F.tid);
        {
          const int nun = (NKV / 256) * (NPROJ / 256), maxu = (nun + F.G - 1) / F.G, first_idle = nun - (maxu - 1) * F.G, bx = (int)blockIdx.x;
          const P0Args a{(unsigned*)F.ctl + CW_MODCNT, in[1], in[3], in[4], in[5], in[7], in[14], in[20], in[21], in[22], in[16], in[18], MOD, ROPE, (float*)(ws + WS_RTW), Wi, Wo, Wgu, Wd};
          if (maxu >= 2 && first_idle < F.G) { if (bx >= first_idle) { REFRESH(); convert_items(F, a, P0_ITEMS, CV_ITEMS, (bx - first_idle) * NWAVES + F.wave, (F.G - first_idle) * NWAVES); } }
          else { REFRESH(); convert_items(F, a, P0_ITEMS, CV_ITEMS, F.vcu * NWAVES + F.wave, F.G * NWAVES); } }
    );
    SEAM(2);
#if defined(DIAG_CK) && DIAG_CK == 3
    CKBUF(Q, (size_t)SEQ * 512 / 8); CKBUF(K, (size_t)2 * NKV * 64 / 8); CKBUF(V, (size_t)2 * NKV * 64 / 8);
#endif
#if defined(DIAG_CK) && DIAG_CK == 5
    CKBUF(QR, (size_t)4 * SEQ * 64 / 8); CKBUF(KR, (size_t)4 * NKV * 64 / 8); CKBUF(VR, (size_t)4 * NKV * 128 / 8); CKBUF(GR, (size_t)SEQ * 512 / 8);
#endif
    if (IN(5)) {
        unsigned* r1cnt = (unsigned*)F.ctl + CW_R1CNT; unsigned* sccnt = (unsigned*)F.ctl + CW_SCANCNT; unsigned* tmo = (unsigned*)F.ctl + CW_TMO;
        const bool do_att = (args.flags & 1) != 0, do_ret = (args.flags & 2) != 0;
        const int ah = (F.G == 256) ? (((F.vcu >> 5) & 1) * 4 + (F.vcu >> 6)) : 0, ac = F.vcu & 31;
        for (int rep = 0; rep < ((PROBE_PHASE == 5 || PROBE_PHASE == 3 || PROBE_PHASE == -2) ? 2 : 1); ++rep) {
        const bool att = do_att && (rep == 0 || PROBE_PHASE != 3), retp = do_ret && (rep == 0 || PROBE_PHASE != 5);
        if (retp) { for (int q = 0; q < (PROBE_PHASE == 31 ? 2 : 1); ++q) for (int u = F.vcu; u < 4 * ret::NCH; u += F.G) { const int h = u & 3, j = u >> 2; ret::r1_unit(F, h, j, KR, VR, lsig(in[10][h]), lsig(in[11][h]), U); }
            if (rep == 0) { if (RET_WT) publish_add_wt(r1cnt, F.tid == 0); else publish_add(r1cnt, F.tid == 0); } }
        if (att) { if (F.G == 256) { attn_body::attn_unit<8>(ah, ac, Q, K, V, MIX, (char*)lds + RING_OFF, F.tid); }
                   else { for (int u = F.vcu; u < 512; u += 2 * F.G) attn_body::attn_unit<8>(u >> 6, u & 63, Q, K, V, MIX, (char*)lds + RING_OFF, F.tid); } }
        REFRESH();
        if (retp) { wait_ge(r1cnt, (unsigned)F.G, F.tid == 0, tmo, !(RET_WT && (NOACQ_MASK & 1)));
            for (int q = 0; q < (PROBE_PHASE == 32 ? 2 : 1); ++q) for (int b = F.vcu; b < 256; b += F.G) ret::r2_scan_block(F, b, U, in[10], in[11], SP);
            if (rep == 0) { if (RET_WT) publish_add_wt(sccnt, F.tid == 0); else publish_add(sccnt, F.tid == 0); } }
        if (att) { if (F.G == 256) { attn_body::attn_unit<8>(ah, ac + 32, Q, K, V, MIX, (char*)lds + RING_OFF, F.tid); }
                   else { for (int u = F.vcu + F.G; u < 512; u += 2 * F.G) attn_body::attn_unit<8>(u >> 6, u & 63, Q, K, V, MIX, (char*)lds + RING_OFF, F.tid); } }
        REFRESH();
        if (retp) { wait_ge(sccnt, (unsigned)F.G, F.tid == 0, tmo, !(RET_WT && (NOACQ_MASK & 2)));
            for (int q = 0; q < (PROBE_PHASE == 33 ? 2 : 1); ++q) { ret::R3Regs R3; if (F.vcu < 512) ret::r3_load(R3, F.wave, fresh_lane(), F.vcu & 3, F.vcu >> 2, QR, KR, VR, SP);
              for (int u = F.vcu; u < 512; u += F.G) { const int h = u & 3, n = u >> 2, un = u + F.G; ret::r3_unit(F, R3, h, n, un < 512 ? (un & 3) : -1, un >> 2, QR, KR, VR, GR, SP, lsig(in[10][h]), lsig(in[11][h]), in[12], in[13], MIX); } } }
        }
    }
    SEAM(5);
#if defined(DIAG_CK) && DIAG_CK == 2
    CKBUF(MIX, (size_t)SEQ * DM / 8);
#endif
#if defined(DIAG_CK) && (DIAG_CK == 8 || DIAG_CK == 9)
    { const u32x4* cp_ = (const u32x4*)MIX; unsigned cx_ = 0;
      for (size_t q_ = (size_t)F.vcu * NTHREADS + F.tid; q_ < (size_t)SEQ * DM / 8; q_ += (size_t)F.G * NTHREADS) { if ((((q_ & 127) < 64) ? 8 : 9) != DIAG_CK) continue; const u32x4 w_ = cp_[q_]; const unsigned k_ = (unsigned)(q_ * 2654435761ull) | 1u;
          cx_ ^= (w_.x * k_) ^ (w_.y * (k_ + 2u)) ^ (w_.z * (k_ + 4u)) ^ (w_.w * (k_ + 6u)); }
#pragma unroll
      for (int o_ = 1; o_ < 64; o_ <<= 1) cx_ ^= (unsigned)__shfl_xor((int)cx_, o_);
      if (F.lane == 0) atomicXor((unsigned*)(CNT) + 64, cx_); }
#endif
#if defined(DIAG_CK) && DIAG_CK == 6
    CKBUF(SP, (size_t)4 * 128 * 2 * 8192 / 8); CKBUF(U, (size_t)4 * 130 * 2 * 8192 / 4);
#endif
    const bool fuse67 = IN(6) && IN(7) && F.G == 256 && PROBE_PHASE != 6 && PROBE_PHASE != -2;
    if (PROBE_PHASE == 66 && IN(6)) { pg8::Gemm g{MIX, Wo, SEQ, DM, DM}; pg8::StaticOrder S; S.init(SEQ, DM, F.G, (int)blockIdx.x); pg8::EpiOutProj<false> E{in[0], MOD + 2048, XN}; pg8::AMapDirect AM;
        pg8::gemm_phase<pg8::EpiOutProj<false>, pg8::StaticOrder, pg8::AMapDirect, true, true>(F.lds + RING_OFF, g, S, E, AM, F.tid); REFRESH(); }
    if (fuse67) {
        pg8::Gemm g{MIX, Wo, SEQ, DM, DM}; pg8::StaticOrder S; S.init(SEQ, DM, F.G, (int)blockIdx.x);
        pg8::EpiOutProj<FUSE67_WT> E{in[0], MOD + 2048, XN}; pg8::AMapDirect AM;
        pg8::gemm_phase<pg8::EpiOutProj<FUSE67_WT>, pg8::StaticOrder, pg8::AMapDirect, true, true>(F.lds + RING_OFF, g, S, E, AM, F.tid);
    } else {
    PH(6,
        pg8::Gemm g{MIX, Wo, SEQ, DM, DM}; pg8::StaticOrder S; S.init(SEQ, DM, F.G, (int)blockIdx.x);
        pg8::EpiOutProj<false> E{in[0], MOD + 2048, XN}; pg8::AMapDirect AM;
        pg8::gemm_phase<pg8::EpiOutProj<false>, pg8::StaticOrder, pg8::AMapDirect, true, true>(F.lds + RING_OFF, g, S, E, AM, F.tid);
    );
    }
    if (fuse67) {
        pg8::StaticOrder S; S.init(SEQ, DM, F.G, (int)blockIdx.x); pg8::Unit u; (void)S.next(0, u);
        unsigned* pc = (unsigned*)F.ctl + CW_PANEL + 64 * u.pm;
        REFRESH();
        if (FUSE67_WT) publish_add_wt(pc, F.tid == 0); else publish_add(pc, F.tid == 0);
        route_stage_weights(F, (const float*)(ws + WS_RTW));
        wait_ge(pc, 4u, F.tid == 0, (unsigned*)F.ctl + CW_TMO, !(FUSE67_WT && (NOACQ_MASK & 4)));
        { const int tb = u.pm * 256 + u.pn * 64 + F.wave * 8; RouteOut ro[8];
          f32x4 gms[2][4];
#pragma unroll
          for (int j = 0; j < 4; ++j) { const int n = 4 * F.lane + 256 * j; const f32x4 g = *(const f32x4*)(in[15] + n), sc = *(const f32x4*)(MOD + 4096 + n); gms[0][j] = g * (sc + 1.f); gms[1][j] = *(const f32x4*)(MOD + 3072 + n); }
          f32x4 xa[4], xb[4]; route_load_row(tb, F.lane, XN, xa);
#pragma unroll
          for (int k = 0; k < 8; k += 2) { route_load_row(tb + k + 1, F.lane, XN, xb); route_row_pre<2>(F, tb + k, xa, in[15], MOD, in[17], in[19], H2, EID, RW, CNT, LIST, &ro[k], nullptr, gms);
              if (k + 2 < 8) route_load_row(tb + k + 2, F.lane, XN, xa); route_row_pre<2>(F, tb + k + 1, xb, in[15], MOD, in[17], in[19], H2, EID, RW, CNT, LIST, &ro[k + 1], nullptr, gms); }
          int ea = ro[0].ea, eb = ro[0].eb; float w1 = ro[0].w1, w2 = ro[0].w2;
#pragma unroll
          for (int k = 1; k < 8; ++k) if (F.lane == k) { ea = ro[k].ea; eb = ro[k].eb; w1 = ro[k].w1; w2 = ro[k].w2; }
          if (PROBE_PHASE == 77) {
#pragma unroll
              for (int k = 0; k < 8; ++k) { f32x4 xv[4]; route_load_row(tb + k, F.lane, XN, xv); route_row_pre<2>(F, tb + k, xv, in[15], MOD, in[17], in[19], H2, EID, RW, CNT, LIST, &ro[k]); } }
          if (F.lane < 8) { const int t = tb + F.lane; EID[2 * t] = ea; EID[2 * t + 1] = eb; RW[2 * t] = w1; RW[2 * t + 1] = w2;
              const int sa = atomicAdd(CNT + ea, 1), sb = atomicAdd(CNT + eb, 1);
              __hip_atomic_store(LIST + ea * SEQ + sa, 2 * t, __ATOMIC_RELAXED, __HIP_MEMORY_SCOPE_AGENT); __hip_atomic_store(LIST + eb * SEQ + sb, 2 * t + 1, __ATOMIC_RELAXED, __HIP_MEMORY_SCOPE_AGENT); } }
        __syncthreads();
    } else {
    SEAM(6);
    if (IN(7)) { route_stage_weights(F, (const float*)(ws + WS_RTW)); for (int t = gw; t < SEQ; t += NGW) route_row_lds<1>(F, t, XN, in[15], MOD, in[17], in[19], H2, EID, RW, CNT, LIST);
        if (PROBE_PHASE == 7 || PROBE_PHASE == -2) { for (int t = gw; t < SEQ; t += NGW) route_row_lds<0>(F, t, XN, in[15], MOD, in[17], in[19], H2, EID, RW, CNT, LIST); }
        __syncthreads(); }
    }
    SEAM(7);
#ifdef DIAG_THRASH
#define THRASH(src) do { const f32x4* tp = (const f32x4*)(src) + (size_t)F.vcu * 16384; f32x4 ts = {0.f, 0.f, 0.f, 0.f}; \
        for (int q = F.tid; q < 16384; q += NTHREADS) ts += tp[q]; \
        if (ts.x + ts.y + ts.z + ts.w == 12345.678f) ((float*)(ws + WS_CTL))[2000 + (F.tid & 7)] = ts.x; __syncthreads(); } while (0)
#else
#define THRASH(src) do {} while (0)
#endif
    THRASH(in[20]);
    const bool fuse89 = IN(8) && IN(9) && F.G == 256 && PROBE_PHASE != 8 && PROBE_PHASE != 9 && PROBE_PHASE != -2;
    if (fuse89) {
        moe_build_table(F, CNT);
        pg8::MoeTable mt{(const LAS int*)(F.lds + TT_OFF), LIST}; unsigned* tcnt = (unsigned*)F.ctl + CW_TILE;
        { pg8::Gemm g{H2, Wgu, 0, 0, DM}; pg8::MoeOrder1 S{mt, F.G, F.vcu, tcnt}; pg8::EpiSwiGLU<true> E{ACT}; pg8::AMapGather AM{mt};
          pg8::gemm_phase<pg8::EpiSwiGLU<true>, pg8::MoeOrder1, pg8::AMapGather, true, true>(F.lds + RING_OFF, g, S, E, AM, F.tid); }
        REFRESH();
        { pg8::Gemm g{ACT, Wd, 0, 0, DEXP}; pg8::MoeOrder2 S{mt, F.G, F.vcu, F.wave, tcnt, (unsigned*)F.ctl + CW_TMO}; pg8::EpiScatter E{mt, Y, (int*)(ws + WS_EID + 512 * 1024)}; pg8::AMapDirect AM;
          pg8::gemm_phase<pg8::EpiScatter, pg8::MoeOrder2, pg8::AMapDirect, true, true>(F.lds + RING_OFF, g, S, E, AM, F.tid); }
    } else {
    PH(8,
        moe_build_table(F, CNT);
        pg8::MoeTable mt{(const LAS int*)(F.lds + TT_OFF), LIST};
        pg8::Gemm g{H2, Wgu, 0, 0, DM}; pg8::MoeOrder S{mt, F.G, F.vcu}; pg8::EpiSwiGLU<false> E{ACT}; pg8::AMapGather AM{mt};
        pg8::gemm_phase<pg8::EpiSwiGLU<false>, pg8::MoeOrder, pg8::AMapGather, true, true>(F.lds + RING_OFF, g, S, E, AM, F.tid);
    );
    SEAM(8);
    THRASH(in[21]);
    PH(9,
        moe_build_table(F, CNT);
        pg8::MoeTable mt{(const LAS int*)(F.lds + TT_OFF), LIST};
        pg8::Gemm g{ACT, Wd, 0, 0, DEXP}; pg8::MoeOrder S{mt, F.G, F.vcu}; pg8::EpiScatter E{mt, Y, (int*)(ws + WS_EID + 512 * 1024)}; pg8::AMapDirect AM;
        pg8::gemm_phase<pg8::EpiScatter, pg8::MoeOrder, pg8::AMapDirect, true, true>(F.lds + RING_OFF, g, S, E, AM, F.tid);
    );
    }
    SEAM(9);
    THRASH(in[22]);
#ifdef DIAG_CK
    float diag_scale = 1.f;
    if (IN(10)) { const unsigned cur = __hip_atomic_load((unsigned*)(CNT) + 64, __ATOMIC_RELAXED, __HIP_MEMORY_SCOPE_AGENT); unsigned* prev = (unsigned*)(ws + 264 * MiB);
        const unsigned p0 = __hip_atomic_load(prev, __ATOMIC_RELAXED, __HIP_MEMORY_SCOPE_AGENT), p1 = __hip_atomic_load(prev + 1, __ATOMIC_RELAXED, __HIP_MEMORY_SCOPE_AGENT);
        if (p1 == (p0 ^ 0x5a5a1234u) && p0 != cur) diag_scale = 3.f; }
#endif
#ifdef DIAG_FLAG
    if (IN(10)) { const int* FLAG = (const int*)(ws + WS_EID + 512 * 1024); for (int t = gw; t < SEQ; t += NGW) { if (FLAG[2 * t] != 1 || FLAG[2 * t + 1] != 1) { const float qn = __builtin_nanf(""); for (int i = F.lane; i < DM; i += 64) Y[(size_t)t * DM + i] = 0x7fc0; (void)qn; } } }
#endif
    if (IN(10)) { if (PROBE_PHASE == 10 || PROBE_PHASE == -2) { for (int t = gw; t < SEQ; t += NGW) final_row(t, F.lane, XN, Y, RW, MOD, in[23], (float*)(ws + WS_HX)); }
        { int t = gw; for (; t + 3 * NGW < SEQ; t += 4 * NGW) { const int rows[4] = {t, t + NGW, t + 2 * NGW, t + 3 * NGW}; final_rows<4>(rows, F.lane, XN, Y, RW, MOD, in[23], args.out); }
          for (; t < SEQ; t += NGW) final_row(t, F.lane, XN, Y, RW, MOD, in[23], args.out); } }
#ifdef DIAG_CK
    if (IN(10)) { __syncthreads(); if (diag_scale != 1.f) { for (int t = gw; t < SEQ; t += NGW) for (int i = F.lane; i < DM; i += 64) args.out[(size_t)t * DM + i] *= diag_scale; }
        if (blockIdx.x == 0 && F.tid == 0) { const unsigned cur = __hip_atomic_load((unsigned*)(CNT) + 64, __ATOMIC_RELAXED, __HIP_MEMORY_SCOPE_AGENT); unsigned* prev = (unsigned*)(ws + 264 * MiB);
            __hip_atomic_store(prev, cur, __ATOMIC_RELAXED, __HIP_MEMORY_SCOPE_AGENT); __hip_atomic_store(prev + 1, cur ^ 0x5a5a1234u, __ATOMIC_RELAXED, __HIP_MEMORY_SCOPE_AGENT); } }
#endif
    if (PROBE_PHASE == 108 || PROBE_PHASE == 109) { xcd_barrier(bar, F.wave == 0 && fresh_lane() == 0); REFRESH();
        moe_build_table(F, CNT); pg8::MoeTable mt{(const LAS int*)(F.lds + TT_OFF), LIST}; pg8::MoeOrder S{mt, F.G, F.vcu};
        if (PROBE_PHASE == 108) { pg8::Gemm g{H2, Wgu, 0, 0, DM}; pg8::EpiSwiGLU<false> E{ACT}; pg8::AMapGather AM{mt};
            pg8::gemm_phase<pg8::EpiSwiGLU<false>, pg8::MoeOrder, pg8::AMapGather, true, true>(F.lds + RING_OFF, g, S, E, AM, F.tid); }
        else { pg8::Gemm g{ACT, Wd, 0, 0, DEXP}; pg8::EpiScatter E{mt, Y, (int*)(ws + WS_EID + 512 * 1024)}; pg8::AMapDirect AM;
            pg8::gemm_phase<pg8::EpiScatter, pg8::MoeOrder, pg8::AMapDirect, true, true>(F.lds + RING_OFF, g, S, E, AM, F.tid); } }
    if (PROBE_PHASE == 100) { REFRESH(); const P0Args a{(unsigned*)F.ctl + CW_MODCNT, in[1], in[3], in[4], in[5], in[7], in[14], in[20], in[21], in[22], in[16], in[18], MOD, ROPE, (float*)(ws + WS_RTW), Wi, Wo, Wgu, Wd}; p0_prologue(F, a); }
#undef IN
#undef SEAM
}

#ifndef FAST_MASK
#define FAST_MASK 0xff
#endif
#ifndef ONE_LAUNCH
#define ONE_LAUNCH 0
#endif
static int g_grid = 0;
static void launch_fast(Args a, int lo, int hi, int flags, hipStream_t stream) {
    a.ph_lo = lo; a.ph_hi = hi; a.flags = flags; a.pad = 0;
    hipLaunchKernelGGL(mega_fwd, dim3(g_grid), dim3(NTHREADS), LDS_BYTES, stream, a);
}
extern "C" void kernel_launch(void* const* d_in, const int* in_sizes, int n_in, void* d_out, int out_size, void* d_ws, size_t ws_size, hipStream_t stream) {
    if (n_in != 24 || out_size != SEQ * DM || ws_size < WS_END) { fprintf(stderr, "kernel_launch: unexpected shapes / workspace (%d inputs, out %d, ws %zu < %zu)\n", n_in, out_size, ws_size, (size_t)WS_END); return; }
    if (g_grid == 0) {
        int dev = 0, cus = 0;
        if (hipGetDevice(&dev) != hipSuccess || hipDeviceGetAttribute(&cus, hipDeviceAttributeMultiprocessorCount, dev) != hipSuccess) { g_grid = -1; return; }
        if (hipFuncSetAttribute((const void*)mega_fwd, hipFuncAttributeMaxDynamicSharedMemorySize, LDS_BYTES) != hipSuccess) { g_grid = -1; return; }
        int per_cu = 0; (void)hipOccupancyMaxActiveBlocksPerMultiprocessor(&per_cu, (const void*)mega_fwd, NTHREADS, LDS_BYTES); (void)hipGetLastError();
        g_grid = cus;
    }
    if (g_grid < 0) return;
    const float* const* in = (const float* const*)d_in;
    unsigned char* ws = (unsigned char*)d_ws; float* out = (float*)d_out;
    (void)hipMemsetAsync(ws + WS_CTL, 0, CTL_ZERO_BYTES, stream);
    Args a{}; for (int i = 0; i < 24; ++i) a.in[i] = in[i]; a.out = out; a.ws = ws;
#if ONE_LAUNCH
    launch_fast(a, 0, N_PHASES, 3, stream);
#ifdef DIAG_2LAUNCH
    (void)hipMemsetAsync(ws + WS_CTL, 0, CTL_ZERO_BYTES, stream); launch_fast(a, 0, N_PHASES, 3, stream);
#endif
#ifdef DIAG_RERUN_LO
    (void)hipMemsetAsync(ws + WS_CTL + 4 * CW_MODCNT, 0, CTL_ZERO_BYTES - 4 * CW_MODCNT, stream); launch_fast(a, DIAG_RERUN_LO, DIAG_RERUN_HI, DIAG_RERUN_FLAGS, stream);
#endif
#else
    float* MOD = (float*)(ws + WS_MOD); float* ROPE = (float*)(ws + WS_ROPE);
    int* EID = (int*)(ws + WS_EID); float* RW = (float*)(ws + WS_RW); int* LIST = (int*)(ws + WS_LIST); int* CNT = (int*)(ws + WS_CTL) + CW_CNT;
    bf16 *HX = (bf16*)(ws + WS_HX), *MIX = (bf16*)(ws + WS_MIX), *H2 = (bf16*)(ws + WS_H2), *Q = (bf16*)(ws + WS_Q), *K = (bf16*)(ws + WS_K), *V = (bf16*)(ws + WS_V);
    bf16 *QR = (bf16*)(ws + WS_QR), *KR = (bf16*)(ws + WS_KR), *VR = (bf16*)(ws + WS_VR), *GR = (bf16*)(ws + WS_GR), *Y = (bf16*)(ws + WS_Y);
    (void)EID; (void)RW; (void)LIST; (void)CNT; (void)H2; (void)Y;
    const int FM = FAST_MASK;
    if (FM & 1) launch_fast(a, 0, 1, 0, stream);
    if (!(FM & 1)) { nv::k_mod<<<dim3(24, 2), 256, 0, stream>>>(in[1], in[3], in[4], in[5], MOD); nv::k_rope<<<16, 256, 0, stream>>>(ROPE); }
    if (FM & 2) launch_fast(a, 1, 2, 0, stream); else nv::k_norm1<<<NKV, 256, 0, stream>>>(in[0], in[2], in[6], MOD, HX);
#ifdef DUP_P2
    launch_fast(a, 2, 3, 0, stream);
#endif
    if (FM & 4) launch_fast(a, 2, 3, 0, stream); else nv::k_inproj<<<dim3(36, NKV / 64), 256, 0, stream>>>(HX, in[7], in[8], in[9], ROPE, Q, K, V, QR, KR, VR, GR);
    if (FM & 8) { launch_fast(a, 3, 4, 0, stream); launch_fast(a, 4, 5, 0, stream); launch_fast(a, 5, 6, 2, stream);
#ifdef DUP_R3
    launch_fast(a, 5, 6, 2, stream);
#endif
    }
    else nv::k_ret<<<dim3(SEQ / 128, 4), 256, 0, stream>>>(QR, KR, VR, GR, in[10], in[11], in[12], in[13], MIX);
    if (FM & 16) launch_fast(a, 5, 6, 1, stream); else nv::k_attn<<<dim3(SEQ / 256, 8), 256, 0, stream>>>(Q, K, V, MIX);
    if (FM & 32) launch_fast(a, 6, 7, 0, stream); else nv::k_outproj<<<dim3(16, SEQ / 64), 256, 0, stream>>>(MIX, in[14], in[0], MOD, out);
    launch_fast(a, 7, 8, 0, stream);
    if (FM & 64) { launch_fast(a, 8, 9, 0, stream); launch_fast(a, 9, 10, 0, stream); }
    else nv::k_moe<<<dim3(SEQ / 8, NEXP), 256, 0, stream>>>(H2, CNT, LIST, in[20], in[21], in[22], Y);
    launch_fast(a, 10, 11, 0, stream);
#endif
}
```

```cpp
#define ONE_LAUNCH 1
#define FILL_ITEMS 16384
#define NT_POLICY 1
#define FUSE67_WT true
#define RET_WT 1
#define WT_MASK 3
#define MOE_NOACQ 1
#define ACT_ST16 1
#include <hip/hip_runtime.h>
#include <cstdio>
#include <cstdint>
#include <cmath>

constexpr int DM = 1024, SEQ = 16384, CL = 256, NKV = SEQ + CL  , GRIDW = 64, NPROJ = 2304;
constexpr int NEXP = 32, DEXP = 512;
constexpr float EPS = 1e-6f;
constexpr float QSCALE = 0.125f * 1.4426950408889634f;
typedef unsigned short bf16;
typedef float f32x4 __attribute__((ext_vector_type(4)));
typedef unsigned u32x4 __attribute__((ext_vector_type(4)));
typedef unsigned u32x2 __attribute__((ext_vector_type(2)));

__host__ __device__ __forceinline__ float bf2f(bf16 v) { union { unsigned u; float f; } c; c.u = ((unsigned)v) << 16; return c.f; }
__host__ __device__ __forceinline__ bf16 f2bf(float f) { union { unsigned u; float f; } c; c.f = f; return (bf16)((c.u + 0x7fffu + ((c.u >> 16) & 1u)) >> 16); }
__device__ __forceinline__ unsigned pk2(float lo, float hi) { unsigned r; asm("v_cvt_pk_bf16_f32 %0, %1, %2" : "=v"(r) : "v"(lo), "v"(hi)); return r; }
#ifndef WSUM_DPP
#define WSUM_DPP 0
#endif
__device__ __forceinline__ float dpp_add_(float v, const int ctrl_sel) {
    int r; const int iv = __float_as_int(v);
    switch (ctrl_sel) { case 0: r = __builtin_amdgcn_update_dpp(iv, iv, 0xB1, 0xF, 0xF, false); break;
                        case 1: r = __builtin_amdgcn_update_dpp(iv, iv, 0x4E, 0xF, 0xF, false); break;
                        case 2: r = __builtin_amdgcn_update_dpp(iv, iv, 0x141, 0xF, 0xF, false); break;
                        default: r = __builtin_amdgcn_update_dpp(iv, iv, 0x140, 0xF, 0xF, false); break; }
    return v + __int_as_float(r);
}
__device__ __forceinline__ float wave_sum(float v) {
#if WSUM_DPP
    v = dpp_add_(v, 0); v = dpp_add_(v, 1); v = dpp_add_(v, 2); v = dpp_add_(v, 3);
    { auto rr = __builtin_amdgcn_permlane16_swap(__float_as_uint(v), __float_as_uint(v), false, false); v = __uint_as_float(rr[0]) + __uint_as_float(rr[1]); }
    { auto rr = __builtin_amdgcn_permlane32_swap(__float_as_uint(v), __float_as_uint(v), false, false); v = __uint_as_float(rr[0]) + __uint_as_float(rr[1]); }
    return v;
#else
#pragma unroll
    for (int o = 1; o < 64; o <<= 1) v += __shfl_xor(v, o);
    return v;
#endif
}

#ifdef NT_POLICY
#define NT_LD(p) __builtin_nontemporal_load(p)
#define NT_ST(v, p) __builtin_nontemporal_store(v, p)
#else
#define NT_LD(p) (*(p))
#define NT_ST(v, p) (*(p) = (v))
#endif
#ifndef WT_MASK
#define WT_MASK 0
#endif
__device__ __forceinline__ void st16_sel(void* p, u32x4 v, bool wt) { if (wt) asm volatile("global_store_dwordx4 %0, %1, off sc1\n\ts_nop 1" :: "v"(p), "v"(v) : "memory"); else *(u32x4*)p = v; }
#define ATTN_STORE16(p, v) st16_sel((p), (v), (WT_MASK & 4) != 0)
__device__ __forceinline__ void st8_sel(void* p, u32x2 v, bool wt) { if (wt) asm volatile("global_store_dwordx2 %0, %1, off sc1\n\ts_nop 1" :: "v"(p), "v"(v) : "memory"); else *(u32x2*)p = v; }

__device__ __forceinline__ int fresh_lane() { int l; asm volatile("v_mbcnt_lo_u32_b32 %0, -1, 0\n\tv_mbcnt_hi_u32_b32 %0, -1, %0" : "=v"(l)); return l; }

constexpr size_t MiB = 1u << 20;
constexpr size_t WS_CTL = 0, CTL_ZERO_BYTES = 128 * 1024;
constexpr size_t WS_MOD = 1 * MiB;
constexpr size_t WS_ROPE = 1 * MiB + 64 * 1024;
constexpr size_t WS_RTW = 1 * MiB + 128 * 1024;
constexpr size_t WS_EID = 2 * MiB;
constexpr size_t WS_RW = 2 * MiB + 256 * 1024;
constexpr size_t WS_LIST = 3 * MiB;
constexpr size_t WS_WI = 6 * MiB;
constexpr size_t WS_WO = 11 * MiB;
constexpr size_t WS_WGU = 13 * MiB;
constexpr size_t WS_WD = 77 * MiB;
constexpr size_t WS_HX = 109 * MiB;
constexpr size_t WS_MIX = WS_HX, WS_H2 = WS_HX;
constexpr size_t WS_Q = 142 * MiB;
constexpr size_t WS_K = 158 * MiB;
constexpr size_t WS_V = WS_K + 4352 * 1024;
constexpr size_t WS_QR = WS_V + 4352 * 1024;
constexpr size_t WS_KR = WS_QR + 8 * MiB;
constexpr size_t WS_VR = WS_KR + 8448 * 1024;
constexpr size_t WS_GR = WS_VR + 16896 * 1024;
constexpr size_t WS_U = WS_GR + 16 * MiB;
constexpr size_t WS_SP = WS_U + 33280 * 1024;
constexpr size_t WS_C_END = WS_SP + 16 * MiB;
constexpr size_t WS_ACT = 142 * MiB;
constexpr size_t WS_Y = 182 * MiB;
constexpr size_t WS_XNB = 246 * MiB;
constexpr size_t WS_END = WS_XNB + 32 * MiB;
constexpr int CW_TMO = 0, CW_CODE = 1, CW_CNT = 1024  , CW_MODCNT = 2048, CW_R1CNT = 2112, CW_SCANCNT = 2176, CW_BAR = 4096, CW_PANEL = 8192  , CW_TILE = 16384  ;

__device__ __forceinline__ void route_row(int t, int lane, const float* XN, const float* g2, const float* MOD, const float* wgrp, const float* bgrp,
                                          const float* wexp, const float* bexp, bf16* H2, int* EID, float* RW, int* CNT, int* LIST) {
    const f32x4* xr = (const f32x4*)(XN + (size_t)t * DM) + lane;
    f32x4 v[4]; float ss = 0.f;
#pragma unroll
    for (int j = 0; j < 4; ++j) { v[j] = xr[64 * j]; ss += (v[j].x * v[j].x + v[j].y * v[j].y) + (v[j].z * v[j].z + v[j].w * v[j].w); }
    const float rstd = rsqrtf(wave_sum(ss) * (1.f / DM) + EPS);
    float gl[4] = {0.f, 0.f, 0.f, 0.f};
    float h[16];
#pragma unroll
    for (int j = 0; j < 4; ++j) {
        const int n = 4 * lane + 256 * j;
        const f32x4 g = *(const f32x4*)(g2 + n), sh = *(const f32x4*)(MOD + 3072 + n), sc = *(const f32x4*)(MOD + 4096 + n);
#pragma unroll
        for (int i = 0; i < 4; ++i) { const float hv = (v[j][i] * rstd) * g[i] * (1.f + sc[i]) + sh[i]; h[4 * j + i] = hv;
            const f32x4 w = *(const f32x4*)(wgrp + (size_t)(n + i) * 4); gl[0] += hv * w.x; gl[1] += hv * w.y; gl[2] += hv * w.z; gl[3] += hv * w.w; }
        u32x2 o; o.x = pk2(h[4 * j], h[4 * j + 1]); o.y = pk2(h[4 * j + 2], h[4 * j + 3]);
        *(u32x2*)(H2 + (size_t)t * DM + n) = o;
    }
#pragma unroll
    for (int c = 0; c < 4; ++c) gl[c] = wave_sum(gl[c]) + bgrp[c];
    int g = 0; float gm = gl[0];
#pragma unroll
    for (int c = 1; c < 4; ++c) if (gl[c] > gm) { gm = gl[c]; g = c; }
    float gs = 0.f;
#pragma unroll
    for (int c = 0; c < 4; ++c) gs += expf(gl[c] - gm);
    const float pg = 1.f / gs;
    float el[8] = {0.f, 0.f, 0.f, 0.f, 0.f, 0.f, 0.f, 0.f};
#pragma unroll
    for (int j = 0; j < 4; ++j)
#pragma unroll
        for (int i = 0; i < 4; ++i) { const int n = 4 * lane + 256 * j + i; const f32x4 w0 = *(const f32x4*)(wexp + (size_t)n * 32 + g * 8), w1 = *(const f32x4*)(wexp + (size_t)n * 32 + g * 8 + 4);
            const float hv = h[4 * j + i]; el[0] += hv * w0.x; el[1] += hv * w0.y; el[2] += hv * w0.z; el[3] += hv * w0.w; el[4] += hv * w1.x; el[5] += hv * w1.y; el[6] += hv * w1.z; el[7] += hv * w1.w; }
#pragma unroll
    for (int c = 0; c < 8; ++c) el[c] = wave_sum(el[c]) + bexp[g * 8 + c];
    int j1 = 0; float m1 = el[0];
#pragma unroll
    for (int c = 1; c < 8; ++c) if (el[c] > m1) { m1 = el[c]; j1 = c; }
    int j2 = -1; float m2 = -INFINITY;
#pragma unroll
    for (int c = 0; c < 8; ++c) if (c != j1 && el[c] > m2) { m2 = el[c]; j2 = c; }
    const float e2 = expf(m2 - m1), w1 = pg / (1.f + e2), w2 = pg * e2 / (1.f + e2);
    if (lane == 0) {
        const int ea = g * 8 + j1, eb = g * 8 + j2;
        EID[2 * t] = ea; EID[2 * t + 1] = eb; RW[2 * t] = w1; RW[2 * t + 1] = w2;
        const int sa = atomicAdd(CNT + ea, 1); LIST[ea * SEQ + sa] = 2 * t;
        const int sb = atomicAdd(CNT + eb, 1); LIST[eb * SEQ + sb] = 2 * t + 1;
    }
}
template <int NB> __device__ __forceinline__ void final_rows(const int (&rows)[NB], int lane, const bf16* XN, const bf16* Y, const float* RW, const float* MOD, const float* gfin, float* out) {
    f32x4 xv[NB][4]; u32x2 ya[NB][4], yb[NB][4]; float w0[NB], w1[NB];
#pragma unroll
    for (int b = 0; b < NB; ++b) { const int t = rows[b]; w0[b] = RW[2 * t]; w1[b] = RW[2 * t + 1];
#pragma unroll
        for (int j = 0; j < 4; ++j) { const int n = 4 * lane + 256 * j; { const u32x2 xw = NT_LD((const u32x2*)(XN + (size_t)t * DM + n)); xv[b][j] = (f32x4){__uint_as_float(xw.x << 16), __uint_as_float(xw.x & 0xffff0000u), __uint_as_float(xw.y << 16), __uint_as_float(xw.y & 0xffff0000u)}; }
            ya[b][j] = NT_LD((const u32x2*)(Y + (size_t)t * DM + n)); yb[b][j] = NT_LD((const u32x2*)(Y + ((size_t)SEQ + t) * DM + n)); } }
#pragma unroll
    for (int b = 0; b < NB; ++b) { const int t = rows[b]; f32x4 v[4]; float ss = 0.f;
#pragma unroll
        for (int j = 0; j < 4; ++j) { const int n = 4 * lane + 256 * j; const f32x4 gt = *(const f32x4*)(MOD + 5120 + n); const u32x2 a = ya[b][j], c = yb[b][j];
            const float fa[4] = {__uint_as_float(a.x << 16), __uint_as_float(a.x & 0xffff0000u), __uint_as_float(a.y << 16), __uint_as_float(a.y & 0xffff0000u)};
            const float fb[4] = {__uint_as_float(c.x << 16), __uint_as_float(c.x & 0xffff0000u), __uint_as_float(c.y << 16), __uint_as_float(c.y & 0xffff0000u)};
#pragma unroll
            for (int i = 0; i < 4; ++i) { v[j][i] = xv[b][j][i] + gt[i] * (fa[i] * w0[b] + fb[i] * w1[b]); ss += v[j][i] * v[j][i]; } }
        const float rstd = rsqrtf(wave_sum(ss) * (1.f / DM) + EPS);
#pragma unroll
        for (int j = 0; j < 4; ++j) { const int n = 4 * lane + 256 * j; const f32x4 g = *(const f32x4*)(gfin + n);
            f32x4 o; o.x = v[j].x * rstd * g.x; o.y = v[j].y * rstd * g.y; o.z = v[j].z * rstd * g.z; o.w = v[j].w * rstd * g.w;
            NT_ST(o, (f32x4*)(out + (size_t)t * DM + n)); } }
}
__device__ __forceinline__ void final_row(int t, int lane, const bf16* XN, const bf16* Y, const float* RW, const float* MOD, const float* gfin, float* out) {
    const int rows[1] = {t}; final_rows<1>(rows, lane, XN, Y, RW, MOD, gfin, out);
}
#ifdef WITH_NAIVE
__global__ void k_route(const float* XN, const float* g2, const float* MOD, const float* wgrp, const float* bgrp, const float* wexp, const float* bexp,
                        bf16* H2, int* EID, float* RW, int* CNT, int* LIST) {
    const int t = blockIdx.x * 4 + (threadIdx.x >> 6);
    route_row(t, threadIdx.x & 63, XN, g2, MOD, wgrp, bgrp, wexp, bexp, H2, EID, RW, CNT, LIST);
}
__global__ void k_final(const float* XN, const bf16* Y, const float* RW, const float* MOD, const float* gfin, float* out) {
    const int t = blockIdx.x * 4 + (threadIdx.x >> 6);
    final_row(t, threadIdx.x & 63, XN, Y, RW, MOD, gfin, out);
}

#endif
#define GAS __attribute__((address_space(1)))
#define LAS __attribute__((address_space(3)))
typedef unsigned v4u __attribute__((ext_vector_type(4)));
typedef short bf16x8 __attribute__((ext_vector_type(8)));
typedef GAS unsigned gu32;
typedef GAS unsigned long long gu64;
#define RLX_AGENT __ATOMIC_RELAXED, __HIP_MEMORY_SCOPE_AGENT
#define LDS_WAIT() asm volatile("s_waitcnt lgkmcnt(0)" ::: "memory")
#define VM_WAIT() asm volatile("s_waitcnt vmcnt(0)" ::: "memory")
__device__ __forceinline__ unsigned long long rt() { return __builtin_amdgcn_s_memrealtime(); }

#define XB_TMO      128
#define XB_XCNT(j)  (256  + 64 * (j))
#define XB_XSUB(j)  (1280 + 64 * (j))
#define XB_XGEN(j)  (2304 + 64 * (j))
#define XB_TOP      3328
#define XB_TOPGEN   3392
#define XCD_BAR_WORDS 3456
#define XB_SPIN_CAP (1u << 18)

__device__ __forceinline__ unsigned xb_ld(unsigned* p)              { return __hip_atomic_load(p, __ATOMIC_RELAXED, __HIP_MEMORY_SCOPE_AGENT); }
__device__ __forceinline__ unsigned xb_add(unsigned* p, unsigned v) { return __hip_atomic_fetch_add(p, v, __ATOMIC_RELAXED, __HIP_MEMORY_SCOPE_AGENT); }
__device__ __forceinline__ unsigned xb_xcc_id() { return (unsigned)__builtin_amdgcn_s_getreg((3 << 11) | 20) & 0xFu; }
#define XB_SPIN(cond, bar) do { unsigned _sp = 0; while (cond) { __builtin_amdgcn_s_sleep(1); \
    if ((++_sp & 255u) == 0u) { if (xb_ld(&(bar)[XB_TMO])) break; if (_sp > XB_SPIN_CAP) { atomicAdd(&(bar)[XB_TMO], 1u); break; } } } } while (0)

struct XcdBarrier {
    unsigned* bar; unsigned x;
    volatile LAS unsigned* st;
};

__device__ __forceinline__ XcdBarrier xcd_barrier_post(unsigned* bar, volatile LAS unsigned* st) {
    XcdBarrier b; b.bar = bar; b.x = xb_xcc_id(); b.st = st;
    if (threadIdx.x == 0) (void)xb_add(&bar[XB_XCNT(b.x)], 1u);
    return b;
}
__device__ __forceinline__ void xcd_barrier_complete(unsigned* bar, unsigned x, unsigned& nloc, unsigned& nx) {
    const unsigned G = gridDim.x * gridDim.y * gridDim.z;
    unsigned sum, cnt, mine, sp = 0u;
    for (;;) {
        sum = 0u; cnt = 0u; mine = 0u;
#pragma unroll
        for (unsigned j = 0; j < 16; ++j) { const unsigned c = xb_ld(&bar[XB_XCNT(j)]); sum += c; cnt += (c > 0u) ? 1u : 0u; mine = (j == x) ? c : mine; }
        if (sum == G) break;
        __builtin_amdgcn_s_sleep(1);
        if ((++sp & 255u) == 0u) { if (xb_ld(&bar[XB_TMO])) break; if (sp > XB_SPIN_CAP) { atomicAdd(&bar[XB_TMO], 1u); break; } }
    }
    nloc = mine > 0u ? mine : 1u; nx = cnt > 0u ? cnt : 1u;
}

__device__ __forceinline__ void xcd_barrier(const XcdBarrier& b, const bool leader_thread) {
    asm volatile("s_waitcnt vmcnt(0)" ::: "memory");
    __syncthreads();
    if (leader_thread) {
        unsigned* bar = b.bar;
        __builtin_amdgcn_s_waitcnt(0);
        unsigned nloc = b.st[0], nx = b.st[1];
        if (nloc == 0u) { xcd_barrier_complete(bar, b.x, nloc, nx); b.st[0] = nloc; b.st[1] = nx; }
        const unsigned old = xb_add(&bar[XB_XSUB(b.x)], 1u);
        const unsigned gen = old / nloc;
        if (old + 1u == (gen + 1u) * nloc) {
            __builtin_amdgcn_fence(__ATOMIC_RELEASE, "agent");
            asm volatile("s_waitcnt vmcnt(0)" ::: "memory");
            const unsigned og = xb_add(&bar[XB_TOP], 1u);
            const unsigned tg = og / nx;
            if (og + 1u == (tg + 1u) * nx) xb_add(&bar[XB_TOPGEN], 1u);
            else XB_SPIN(xb_ld(&bar[XB_TOPGEN]) == tg, bar);
            __builtin_amdgcn_fence(__ATOMIC_ACQUIRE, "agent");
            xb_add(&bar[XB_XGEN(b.x)], 1u);
            asm volatile("s_waitcnt vmcnt(0)" ::: "memory");
        } else {
            XB_SPIN(xb_ld(&bar[XB_XGEN(b.x)]) == gen, bar);
            __builtin_amdgcn_fence(__ATOMIC_ACQUIRE, "agent");
            asm volatile("s_waitcnt vmcnt(0)" ::: "memory");
        }
    }
    __syncthreads();
}
namespace pg8 {
#define PG8_LAS __attribute__((address_space(3)))
typedef unsigned short bf16_t;
typedef short bf16x8 __attribute__((ext_vector_type(8)));
typedef float f32x4 __attribute__((ext_vector_type(4)));
typedef unsigned u32x4 __attribute__((ext_vector_type(4)));
constexpr int BM = 256, BK = 64, HALF = 128, HTB = HALF * BK * 2  , STAGE_BYTES = 8 * HTB, NXCD = 8, WGM = 8;

__host__ __device__ __forceinline__ int lds_byte(int r, int c) { const int st = (r >> 4) * 2 + (c >> 5), rr = r & 15, cc = c & 31, ob = rr * 64 + cc * 2; return st * 1024 + (ob ^ (((ob >> 9) & 1) << 5)); }
__host__ __device__ __forceinline__ void stage_rc(int b, int& R, int& C) { const int st = b / 1024, sb = b % 1024, swz = sb ^ (((sb >> 9) & 1) << 5); R = (st >> 1) * 16 + swz / 64; C = (st & 1) * 32 + (swz % 64) / 2; }
__host__ __device__ __forceinline__ int perm32(int rho) { const int n = rho >> 4, i = rho & 15; return 8 * (i >> 2) + 4 * n + (i & 3); }

struct Unit { int pm, pn; };
struct Gemm { const bf16_t* A; const bf16_t* Bt; int M, N, K; };

struct StaticOrder {
    int nM, nN, nwg, G, c;
    __host__ __device__ void init(int M, int N, int G_, int c_) { nM = M / BM; nN = N / BM; nwg = nM * nN; G = G_; c = c_; }
    __host__ __device__ bool next(int i, Unit& u) const {
        const long L = (long)i * G + c; if (L >= nwg) return false;
        int wgid = (int)L; { const int q = nwg / NXCD, r = nwg % NXCD, xcd = wgid % NXCD, off = wgid / NXCD; wgid = (xcd < r ? xcd * (q + 1) : r * (q + 1) + (xcd - r) * q) + off; }
        const int nig = WGM * nN, gid = wgid / nig, fm = gid * WGM, gsz = (nM - fm) < WGM ? (nM - fm) : WGM;
        u.pm = fm + ((wgid % nig) % gsz); u.pn = (wgid % nig) / gsz; return true;
    }
    __device__ __forceinline__ void a_ready(const Unit&) const {}
    __device__ __forceinline__ void done(const Unit&) const {}
};

__device__ __forceinline__ unsigned cvt_pk_bf16(float lo, float hi) { unsigned r; asm volatile("v_cvt_pk_bf16_f32 %0, %1, %2" : "=v"(r) : "v"(lo), "v"(hi)); return r; }
typedef float f32x2 __attribute__((ext_vector_type(2)));
template <class Epi, class Sched, class AMap, bool ALIGN_EPI = false, bool SP2 = false>
__device__ __forceinline__ void gemm_phase(PG8_LAS unsigned char* lds, const Gemm g, const Sched& S, const Epi& E, const AMap& AM, const int tid) {
    const int wid = __builtin_amdgcn_readfirstlane(tid >> 6), lane = tid & 63, wr = wid >> 2, wc = wid & 3, fr = lane & 15, fq = lane >> 4;
    const int K = g.K, nt = K / BK;
    unsigned voffB[2]; int stR[2], stC[2];
#pragma unroll
    for (int i = 0; i < 2; ++i) { int R, C; stage_rc(tid * 16 + i * 8192, R, C); const int Rb = Epi::PERM ? ((R & ~31) + perm32(R & 31)) : R;
        stR[i] = R; stC[i] = C; voffB[i] = (unsigned)(Rb * K + C) * 2u; }
    unsigned vAc[2][2], vAn[2][2]; int rN[2][2], rNN[2][2];
#define PG8_AOFF(dst, un) do { _Pragma("unroll") for (int _h = 0; _h < 2; ++_h) _Pragma("unroll") for (int _i = 0; _i < 2; ++_i) \
        dst[_h][_i] = (unsigned)AM.row(un, _h * HALF + stR[_i]) * (unsigned)(K * 2) + (unsigned)(stC[_i] * 2); } while (0)
#define PG8_AROW(dst, un) do { _Pragma("unroll") for (int _h = 0; _h < 2; ++_h) _Pragma("unroll") for (int _i = 0; _i < 2; ++_i) dst[_h][_i] = AM.raw(un, _h * HALF + stR[_i]); } while (0)
#define PG8_AOFFR(dst, raw) do { _Pragma("unroll") for (int _h = 0; _h < 2; ++_h) _Pragma("unroll") for (int _i = 0; _i < 2; ++_i) \
        dst[_h][_i] = (unsigned)AM.fix(raw[_h][_i]) * (unsigned)(K * 2) + (unsigned)(stC[_i] * 2); } while (0)
    const size_t kstep = (size_t)(BK * 2);
    const size_t hstep = (size_t)HALF * K * 2;
    const size_t tstep = 2 * hstep;
    const unsigned ldsw = (unsigned)wid * 1024u;
    const int aoff = lds_byte(wr * 64 + fr, fq * 8), boff = lds_byte(wc * 32 + fr, fq * 8);
#define PG8_SA(b, h) (((b) * 2 + (h)) * HTB)
#define PG8_SB(b, h) ((4 + (b) * 2 + (h)) * HTB)
#define PG8_STAGE(bufoff, gbase, voff) do { _Pragma("unroll") for (int _i = 0; _i < 2; ++_i) \
        __builtin_amdgcn_global_load_lds((const unsigned*)((const char*)(gbase) + (voff)[_i]), (PG8_LAS unsigned*)(lds + (bufoff) + ldsw + _i * 8192), 16, 0, 0); } while (0)
#define PG8_STAGEA(bufoff, koff, vo) do { _Pragma("unroll") for (int _i = 0; _i < 2; ++_i) \
        __builtin_amdgcn_global_load_lds((const unsigned*)((const char*)g.A + (koff) + (vo)[_i]), (PG8_LAS unsigned*)(lds + (bufoff) + ldsw + _i * 8192), 16, 0, 0); } while (0)
#define PG8_LDA(dst, b, h) do { _Pragma("unroll") for (int m = 0; m < 4; ++m) _Pragma("unroll") for (int k = 0; k < 2; ++k) dst[m][k] = *(const PG8_LAS bf16x8*)(lds + PG8_SA(b, h) + aoff + m * 2048 + k * 1024); } while (0)
#define PG8_LDB(dst, b, h) do { _Pragma("unroll") for (int n = 0; n < 2; ++n) _Pragma("unroll") for (int k = 0; k < 2; ++k) dst[n][k] = *(const PG8_LAS bf16x8*)(lds + PG8_SB(b, h) + boff + n * 2048 + k * 1024); } while (0)
#define PG8_MMA(ai, bj, At, Bt) do { __builtin_amdgcn_s_setprio(1); _Pragma("unroll") for (int m = 0; m < 4; ++m) _Pragma("unroll") for (int n = 0; n < 2; ++n) _Pragma("unroll") for (int k = 0; k < 2; ++k) \
        acc[ai][bj][m][n] = __builtin_amdgcn_mfma_f32_16x16x32_bf16(Bt[n][k], At[m][k], acc[ai][bj][m][n], 0, 0, 0); __builtin_amdgcn_s_setprio(0); } while (0)
#define PG8_WAIT_V(n) asm volatile("s_waitcnt vmcnt(" #n ")" ::: "memory")
#define PG8_WAIT_L(n) asm volatile("s_waitcnt lgkmcnt(" #n ")" ::: "memory")
#define PG8_BAR __builtin_amdgcn_s_barrier()
#define PG8_SCHED __builtin_amdgcn_sched_barrier(0)
    Unit cur, nxt, nn; int ui = 0;
    if (!S.next(0, cur)) return;
    f32x4 acc[2][2][4][2];
#pragma unroll
    for (int a = 0; a < 2; ++a)
#pragma unroll
        for (int b = 0; b < 2; ++b)
#pragma unroll
            for (int m = 0; m < 4; ++m)
#pragma unroll
                for (int n = 0; n < 2; ++n) acc[a][b][m][n] = (f32x4){0.f, 0.f, 0.f, 0.f};
    bf16x8 At[4][2], B0[2][2], B1[2][2];
    const char* cB = (const char*)g.Bt + (size_t)cur.pn * tstep;
    S.a_ready(cur);
    PG8_AOFF(vAc, cur);
    bool has_next = S.next(1, nxt);
    if (has_next) PG8_AROW(rN, nxt);
    if constexpr (SP2) {
        PG8_STAGE(PG8_SB(0, 0), cB, voffB); PG8_STAGE(PG8_SB(0, 1), cB + hstep, voffB); PG8_STAGEA(PG8_SA(0, 0), 0, vAc[0]); PG8_STAGEA(PG8_SA(0, 1), 0, vAc[1]);
        if (wr == 1) PG8_BAR;
        PG8_WAIT_V(2); PG8_BAR;
        PG8_STAGE(PG8_SB(1, 0), cB + kstep, voffB); PG8_STAGEA(PG8_SA(1, 0), kstep, vAc[0]); PG8_STAGE(PG8_SB(1, 1), cB + hstep + kstep, voffB);
        PG8_WAIT_V(6); PG8_BAR;
    } else {
        PG8_STAGE(PG8_SB(0, 0), cB, voffB); PG8_STAGEA(PG8_SA(0, 0), 0, vAc[0]); PG8_STAGE(PG8_SB(0, 1), cB + hstep, voffB); PG8_STAGEA(PG8_SA(0, 1), 0, vAc[1]);
        if (wr == 1) PG8_BAR;
        PG8_WAIT_V(4); PG8_BAR;
        PG8_STAGE(PG8_SB(1, 0), cB + kstep, voffB); PG8_STAGEA(PG8_SA(1, 0), kstep, vAc[0]); PG8_STAGE(PG8_SB(1, 1), cB + hstep + kstep, voffB);
        PG8_WAIT_V(6); PG8_BAR;
    }
    for (;;) {
        const bool has_nn = has_next && S.next(ui + 2, nn);
        if (has_nn) PG8_AROW(rNN, nn);
        const char* nB = has_next ? (const char*)g.Bt + (size_t)nxt.pn * tstep : cB;
        if (has_next) { PG8_AOFFR(vAn, rN); } else { _Pragma("unroll") for (int _h = 0; _h < 2; ++_h) _Pragma("unroll") for (int _i = 0; _i < 2; ++_i) vAn[_h][_i] = vAc[_h][_i]; }
        for (int t = 0; t < nt; t += 2) {
            const bool last = (t == nt - 2);
            const size_t a1 = (size_t)(t + 1) * kstep;
            const size_t a2 = last ? (size_t)0 : (size_t)(t + 2) * kstep; const char* b2 = last ? nB : cB + (size_t)(t + 2) * kstep;
            const size_t a3 = a2 + kstep; const char* b3 = b2 + kstep;
#define PG8_SWAPA() do { if (last) { _Pragma("unroll") for (int _h = 0; _h < 2; ++_h) _Pragma("unroll") for (int _i = 0; _i < 2; ++_i) vAc[_h][_i] = vAn[_h][_i]; } } while (0)
            if (last && has_next) S.a_ready(nxt);
            if constexpr (SP2) {
            PG8_LDB(B0, 0, 0); PG8_LDB(B1, 0, 1); PG8_SCHED; PG8_LDA(At, 0, 0); PG8_STAGEA(PG8_SA(1, 1), a1, vAc[1]); PG8_SWAPA();
            PG8_WAIT_V(8); PG8_WAIT_L(0); PG8_BAR; PG8_MMA(0, 0, At, B0); PG8_MMA(0, 1, At, B1); PG8_BAR; PG8_SCHED;
            PG8_LDA(At, 0, 1); PG8_STAGE(PG8_SB(0, 0), b2, voffB); PG8_STAGE(PG8_SB(0, 1), b2 + hstep, voffB); PG8_STAGEA(PG8_SA(0, 0), a2, vAc[0]);
            PG8_WAIT_V(8); PG8_WAIT_L(0); PG8_BAR; PG8_MMA(1, 0, At, B0); PG8_MMA(1, 1, At, B1); PG8_BAR; PG8_SCHED;
            PG8_LDB(B0, 1, 0); PG8_LDB(B1, 1, 1); PG8_SCHED; PG8_LDA(At, 1, 0); PG8_STAGEA(PG8_SA(0, 1), a2, vAc[1]);
            PG8_WAIT_V(8); PG8_WAIT_L(0); PG8_BAR; PG8_MMA(0, 0, At, B0); PG8_MMA(0, 1, At, B1); PG8_BAR; PG8_SCHED;
            PG8_LDA(At, 1, 1); PG8_STAGE(PG8_SB(1, 0), b3, voffB); PG8_STAGE(PG8_SB(1, 1), b3 + hstep, voffB); PG8_STAGEA(PG8_SA(1, 0), a3, vAc[0]);
            PG8_WAIT_V(8); PG8_WAIT_L(0); PG8_BAR; PG8_MMA(1, 0, At, B0); PG8_MMA(1, 1, At, B1); PG8_BAR; PG8_SCHED;
            } else {
            PG8_LDB(B0, 0, 0); PG8_SCHED; PG8_LDA(At, 0, 0); PG8_STAGEA(PG8_SA(1, 1), a1, vAc[1]); PG8_SWAPA();
            PG8_WAIT_L(8); PG8_BAR; PG8_WAIT_L(0); PG8_MMA(0, 0, At, B0); PG8_BAR; PG8_SCHED;
            PG8_LDB(B1, 0, 1); PG8_STAGE(PG8_SB(0, 0), b2, voffB);
            PG8_BAR; PG8_WAIT_L(0); PG8_MMA(0, 1, At, B1); PG8_BAR;
            PG8_LDA(At, 0, 1); PG8_STAGEA(PG8_SA(0, 0), a2, vAc[0]);
            PG8_BAR; PG8_WAIT_L(0); PG8_MMA(1, 0, At, B0); PG8_BAR; PG8_SCHED;
            PG8_STAGE(PG8_SB(0, 1), b2 + hstep, voffB);
            PG8_WAIT_V(6); PG8_BAR; PG8_MMA(1, 1, At, B1); PG8_BAR;
            PG8_LDB(B0, 1, 0); PG8_SCHED; PG8_LDA(At, 1, 0); PG8_STAGEA(PG8_SA(0, 1), a2, vAc[1]);
            PG8_WAIT_L(8); PG8_BAR; PG8_WAIT_L(0); PG8_MMA(0, 0, At, B0); PG8_BAR; PG8_SCHED;
            PG8_LDB(B1, 1, 1); PG8_STAGE(PG8_SB(1, 0), b3, voffB);
            PG8_BAR; PG8_WAIT_L(0); PG8_MMA(0, 1, At, B1); PG8_BAR;
            PG8_LDA(At, 1, 1); PG8_STAGEA(PG8_SA(1, 0), a3, vAc[0]);
            PG8_BAR; PG8_WAIT_L(0); PG8_MMA(1, 0, At, B0); PG8_BAR; PG8_SCHED;
            PG8_STAGE(PG8_SB(1, 1), b3 + hstep, voffB);
            PG8_WAIT_V(6); PG8_BAR; PG8_MMA(1, 1, At, B1); PG8_BAR;
            }
        }
        if constexpr (ALIGN_EPI) { if (wr == 0) PG8_BAR; }
        if constexpr (!Epi::AFTER_DRAIN) { E(acc, cur, wr, wc, fr, fq); S.done(cur); }
        if (!has_next) break;
#pragma unroll
        for (int a = 0; a < 2; ++a)
#pragma unroll
            for (int b = 0; b < 2; ++b)
#pragma unroll
                for (int m = 0; m < 4; ++m)
#pragma unroll
                    for (int n = 0; n < 2; ++n) acc[a][b][m][n] = (f32x4){0.f, 0.f, 0.f, 0.f};
        cur = nxt; nxt = nn; has_next = has_nn; cB = nB; ++ui;
        _Pragma("unroll") for (int _h = 0; _h < 2; ++_h) _Pragma("unroll") for (int _i = 0; _i < 2; ++_i) rN[_h][_i] = rNN[_h][_i];
        if constexpr (ALIGN_EPI) { if (wr == 1) PG8_BAR; }
    }
    PG8_WAIT_V(0);
    if constexpr (!ALIGN_EPI) { if (wr == 0) PG8_BAR; }
    PG8_BAR;
    if constexpr (Epi::AFTER_DRAIN) { E.fused(acc, cur, wr, wc, fr, fq, lds, wid, lane); S.done(cur); }
#undef PG8_SA
#undef PG8_SB
#undef PG8_STAGE
#undef PG8_STAGEA
#undef PG8_AOFF
#undef PG8_AROW
#undef PG8_AOFFR
#undef PG8_SWAPA
#undef PG8_LDA
#undef PG8_LDB
#undef PG8_MMA
#undef PG8_WAIT_V
#undef PG8_WAIT_L
#undef PG8_BAR
#undef PG8_SCHED
}
}
namespace attn_body {
using bf16=unsigned short;
using bf16x8=__attribute__((ext_vector_type(8)))short;
using s16x4=__attribute__((ext_vector_type(4)))short;
using f32x16=__attribute__((ext_vector_type(16)))float;
using u32x4=__attribute__((ext_vector_type(4)))unsigned;
constexpr int D=64,QP=512,KVP=64,OP=1024,NKEYS=16640;
constexpr int NW=8,QBLK=32,QB=QBLK*NW,KVBLK=64;
constexpr int ATTN_UNIT_ROWS=QB;
__device__ __forceinline__ int crow(int r,int hi){return (r&3)+8*(r>>2)+4*hi;}
#define SBAR() __builtin_amdgcn_sched_barrier(0)
constexpr int NSLOT=3, SLOTB=8192;
constexpr int LDS_K=0, LDS_V=NSLOT*SLOTB, LDS_WS=2*NSLOT*SLOTB, LDS_OST=LDS_WS+NW*64*4, LDS_BYTES=LDS_OST+NW*4096;
constexpr float C2=0.125f*1.4426950408889634f;
__device__ __forceinline__ void glds16(const void*gsrc,unsigned lds_dst){unsigned keep;
  asm volatile("s_mov_b32 %0, m0\n\ts_mov_b32 m0, %2\n\ts_nop 0\n\tglobal_load_lds_dwordx4 %1, off\n\ts_mov_b32 m0, %0":"=&s"(keep):"v"(gsrc),"s"(lds_dst):"memory");}
__device__ __forceinline__ float max3f(float a,float b,float c){float r;asm("v_max3_f32 %0, %1, %2, %3":"=v"(r):"v"(a),"v"(b),"v"(c));return r;}
__device__ __forceinline__ float max2f(float a,float b){float r;asm("v_max_f32_e32 %0, %1, %2":"=v"(r):"v"(a),"v"(b));return r;}
__device__ __forceinline__ float fadd_s(float a,float b){float r;asm("v_add_f32_e32 %0, %1, %2":"=v"(r):"v"(a),"v"(b));return r;}
__device__ __forceinline__ float fsub_s(float a,float b){float r;asm("v_sub_f32_e32 %0, %1, %2":"=v"(r):"v"(a),"v"(b));return r;}
typedef float f32x2_t __attribute__((ext_vector_type(2))); typedef __bf16 bf16x2_t __attribute__((ext_vector_type(2)));
__device__ __forceinline__ unsigned cvtpk_s(float lo,float hi){f32x2_t v={lo,hi};bf16x2_t b=__builtin_convertvector(v,bf16x2_t);return __builtin_bit_cast(unsigned,b);}
#define WAIT_BAR(N) asm volatile("s_waitcnt vmcnt(" #N ") lgkmcnt(0)\n\ts_barrier":::"memory")

__device__ __forceinline__ void qkt(f32x16&p0,f32x16&p1,const char*Kslot,const bf16x8*qr,const f32x16&negm,int r32,int hi){
  const char*kb=Kslot+hi*1024+r32*16;
  #pragma unroll
  for(int d0=0;d0<4;++d0){
    const bf16x8 b0=*reinterpret_cast<const bf16x8*>(kb+d0*2048);
    const bf16x8 b1=*reinterpret_cast<const bf16x8*>(kb+d0*2048+512);
    if(d0==0){p0=__builtin_amdgcn_mfma_f32_32x32x16_bf16(b0,qr[0],negm,0,0,0);p1=__builtin_amdgcn_mfma_f32_32x32x16_bf16(b1,qr[0],negm,0,0,0);}
    else{p0=__builtin_amdgcn_mfma_f32_32x32x16_bf16(b0,qr[d0],p0,0,0,0);p1=__builtin_amdgcn_mfma_f32_32x32x16_bf16(b1,qr[d0],p1,0,0,0);}}
}
typedef __attribute__((address_space(3))) const char* lds_cptr;
typedef short v4i16_t __attribute__((ext_vector_type(4)));
__device__ __forceinline__ void kload8(bf16x8*kf,lds_cptr kp){
  kf[0]=*(const __attribute__((address_space(3))) bf16x8*)(kp);      kf[1]=*(const __attribute__((address_space(3))) bf16x8*)(kp+512);
  kf[2]=*(const __attribute__((address_space(3))) bf16x8*)(kp+2048); kf[3]=*(const __attribute__((address_space(3))) bf16x8*)(kp+2560);
  kf[4]=*(const __attribute__((address_space(3))) bf16x8*)(kp+4096); kf[5]=*(const __attribute__((address_space(3))) bf16x8*)(kp+4608);
  kf[6]=*(const __attribute__((address_space(3))) bf16x8*)(kp+6144); kf[7]=*(const __attribute__((address_space(3))) bf16x8*)(kp+6656);
}
__device__ __forceinline__ void kload2(bf16x8*kf,lds_cptr kp,int j){ kf[2*j]=*(const __attribute__((address_space(3))) bf16x8*)(kp+j*2048); kf[2*j+1]=*(const __attribute__((address_space(3))) bf16x8*)(kp+j*2048+512); }
__device__ __forceinline__ s16x4 vtr(lds_cptr p){ return __builtin_bit_cast(s16x4,__builtin_amdgcn_ds_read_tr16_b64_v4i16((__attribute__((address_space(3))) v4i16_t*)p)); }
__device__ __forceinline__ float rowmax(const f32x16&p0,const f32x16&p1){
  float a=max3f(p0[0],p0[1],p1[0]),b=max3f(p0[2],p0[3],p1[1]);a=max3f(a,p1[2],p1[3]);
  #pragma unroll
  for(int r=4;r<16;r+=4){a=max3f(a,p0[r],p0[r+1]);b=max3f(b,p0[r+2],p0[r+3]);a=max3f(a,p1[r],p1[r+1]);b=max3f(b,p1[r+2],p1[r+3]);}
  const float m=max2f(a,b);
  auto rr=__builtin_amdgcn_permlane32_swap(__float_as_uint(m),__float_as_uint(m),false,false);
  return max2f(__uint_as_float(rr[0]),__uint_as_float(rr[1]));
}
__device__ __forceinline__ void pv(f32x16*o,int vb,bf16x8 pa0,bf16x8 pa1,bf16x8 pa2,bf16x8 pa3){
  #pragma unroll
  for(int d0=0;d0<2;++d0){s16x4 lo[4],hi[4];
    #pragma unroll
    for(int ks=0;ks<4;++ks){
      asm volatile("ds_read_b64_tr_b16 %0,%1 offset:%c2":"=&v"(lo[ks]):"v"(vb),"i"(d0*4096+ks*1024):"memory");
      asm volatile("ds_read_b64_tr_b16 %0,%1 offset:%c2":"=&v"(hi[ks]):"v"(vb),"i"(d0*4096+ks*1024+512):"memory");}
    asm volatile("s_waitcnt lgkmcnt(0)":::"memory");SBAR();
    #define PK(k) (bf16x8){lo[k][0],lo[k][1],lo[k][2],lo[k][3],hi[k][0],hi[k][1],hi[k][2],hi[k][3]}
    o[d0]=__builtin_amdgcn_mfma_f32_32x32x16_bf16(pa0,PK(0),o[d0],0,0,0);
    o[d0]=__builtin_amdgcn_mfma_f32_32x32x16_bf16(pa1,PK(1),o[d0],0,0,0);
    o[d0]=__builtin_amdgcn_mfma_f32_32x32x16_bf16(pa2,PK(2),o[d0],0,0,0);
    o[d0]=__builtin_amdgcn_mfma_f32_32x32x16_bf16(pa3,PK(3),o[d0],0,0,0);
    #undef PK
  }
}

#ifndef ATTN_STORE16
#define ATTN_STORE16(p,v) (*(u32x4*)(p)=(v))
#endif
template<int THRL> __device__ __forceinline__ void attn_unit(int h,int qb,const bf16*Q,const bf16*__restrict__ K,const bf16*__restrict__ V,bf16*O,char*shm,const int tid){
  const int lane=tid&63,r32=lane&31,hi=lane>>5; const int wid=__builtin_amdgcn_readfirstlane(tid>>6);
  const int q0=qb*QB;
  const bf16*Qw=Q+(long)(q0+wid*QBLK)*QP+h*D;
  const bf16*Kh=K+(long)(h>>2)*NKEYS*KVP,*Vh=V+(long)(h>>2)*NKEYS*KVP;
  const unsigned lds0=(unsigned)(uintptr_t)shm;
  float*wsf=(float*)(shm+LDS_WS)+wid*64;
  const bf16*ksrc=Kh+(long)lane*KVP+wid*8;
  const bf16*vsrc=Vh+(long)(16*(wid&3)+(lane>>2))*KVP+(wid>>2)*32+(lane&3)*8;
  const unsigned kdst=lds0+LDS_K+wid*1024, vdst=lds0+LDS_V+wid*1024;
  #define DMA_K(t,slot) glds16(ksrc+(long)(t)*KVBLK*KVP,(unsigned)__builtin_amdgcn_readfirstlane(kdst+(slot)))
  #define DMA_V(t,slot) glds16(vsrc+(long)(t)*KVBLK*KVP,(unsigned)__builtin_amdgcn_readfirstlane(vdst+(slot)))
  const int vb0=(int)(lds0+LDS_V)+((lane>>4)&1)*32+(lane&3)*8+(4*hi+((lane&15)>>2))*64;
  const char*Kbase=shm+LDS_K; bf16x8 kf[8];
  const lds_cptr shm3=(lds_cptr)shm; const lds_cptr kp0=shm3+LDS_K+hi*1024+r32*16; const lds_cptr vp0=shm3+LDS_V+((lane>>4)&1)*32+(lane&3)*8+(4*hi+((lane&15)>>2))*64;
  constexpr int NT=NKEYS/KVBLK;
  DMA_K(0,0);DMA_V(0,0);DMA_K(1,SLOTB);
  bf16x8 qr[4];
  #pragma unroll
  for(int d0=0;d0<4;++d0)qr[d0]=*reinterpret_cast<const bf16x8*>(&Qw[(long)r32*QP+d0*16+hi*8]);
  float l_reg=0.f;f32x16 o[2];o[0]=f32x16{};o[1]=f32x16{};const f32x16 negm=f32x16{};
  #define CMASK(P0,P1,t) do{}while(0)
  #define START(P0,P1) do{ _Pragma("unroll") for(int r=0;r<16;++r)P0[r]=__builtin_amdgcn_exp2f(P0[r]); }while(0)
  #define RESC() do{}while(0)
  f32x16 pA0,pA1,pB0,pB1;
  int sl_prev=0,sl_cur=0,sl_next=SLOTB;
  #define ROT() do{sl_prev=sl_cur;sl_cur=sl_next;sl_next=(sl_next==(NSLOT-1)*SLOTB)?0:sl_next+SLOTB;}while(0)
  DMA_K(2,2*SLOTB);
  WAIT_BAR(3);
  qkt(pA0,pA1,Kbase,qr,negm,r32,hi);asm volatile("s_nop 15\n\ts_nop 7":"+v"(pA0),"+v"(pA1));CMASK(pA0,pA1,0);
  START(pA0,pA1);
  _Pragma("unroll") for(int r=0;r<16;++r)pA1[r]=__builtin_amdgcn_exp2f(pA1[r]);
  WAIT_BAR(0);
  DMA_K(3,0);DMA_V(1,SLOTB);
  ROT();
  kload8(kf,kp0+sl_cur);
  WAIT_BAR(2);
  s16x4 vlo[8],vhi[8]; u32x4 pw0,pw1,pw2,pw3;
  #define PKW(P,B) cvtpk_s(P[B],P[B+1])
  #define PAF(k) __builtin_bit_cast(bf16x8,pw##k)
  #define VFR(i) (bf16x8){vlo[i][0],vlo[i][1],vlo[i][2],vlo[i][3],vhi[i][0],vhi[i][1],vhi[i][2],vhi[i][3]}
  #define PIN(x) asm volatile("":"+v"(x))
  #define MX3(a,b,c) __builtin_fmaxf(__builtin_fmaxf((a),(b)),(c))
  #define GAPA(MF,A0,A1,A2,A3,W0,W1,PW) do{ MF; sacc+=A0; sacc+=A1; sacc+=A2; sacc+=A3; PIN(sacc); W0; W1; PIN(PW); SBAR(); }while(0)
  #define EX(v) __builtin_amdgcn_exp2f(v)
  #define GAPB(MF,X,B) do{ MF; X[B]=EX(X[B]); X[B+1]=EX(X[B+1]); X[B+2]=EX(X[B+2]); X[B+3]=EX(X[B+3]); PIN(X); SBAR(); }while(0)
  #define VRD(i) do{ vlo[i]=vtr(vp_+(((i)>>2)*4096+((i)&3)*1024)); vhi[i]=vtr(vp_+(((i)>>2)*4096+((i)&3)*1024+512)); }while(0)
  #define KRD(G,j) do{ if(G){ kload2(kf,kp0+sl_next,j); SBAR(); } }while(0)
  #define STEP(C0,C1,P0,P1,t,GK,GV,GL) do{ SBAR(); \
    const lds_cptr vp_=vp0+sl_prev; \
    VRD(0); SBAR(); float sacc=(P0[0]+P0[1]); \
    GAPA(C0=__builtin_amdgcn_mfma_f32_32x32x16_bf16(kf[0],qr[0],negm,0,0,0), P0[2],P0[3],P0[4],P0[5],     pw0[0]=PKW(P0,0), pw0[1]=PKW(P0,2), pw0); \
    VRD(4); SBAR(); GAPA(C1=__builtin_amdgcn_mfma_f32_32x32x16_bf16(kf[1],qr[0],negm,0,0,0), P0[6],P0[7],P0[8],P0[9],     pw0[2]=PKW(P0,4), pw0[3]=PKW(P0,6), pw0); \
    VRD(1); SBAR(); GAPA(C0=__builtin_amdgcn_mfma_f32_32x32x16_bf16(kf[2],qr[1],C0,0,0,0),   P0[10],P0[11],P0[12],P0[13], pw1[0]=PKW(P0,8), pw1[1]=PKW(P0,10), pw1); \
    VRD(5); SBAR(); GAPA(C1=__builtin_amdgcn_mfma_f32_32x32x16_bf16(kf[3],qr[1],C1,0,0,0),   P0[14],P0[15],P1[0],P1[1],   pw1[2]=PKW(P0,12),pw1[3]=PKW(P0,14), pw1); \
    VRD(2); SBAR(); GAPA(C0=__builtin_amdgcn_mfma_f32_32x32x16_bf16(kf[4],qr[2],C0,0,0,0),   P1[2],P1[3],P1[4],P1[5],     pw2[0]=PKW(P1,0), pw2[1]=PKW(P1,2), pw2); \
    VRD(6); SBAR(); GAPA(C1=__builtin_amdgcn_mfma_f32_32x32x16_bf16(kf[5],qr[2],C1,0,0,0),   P1[6],P1[7],P1[8],P1[9],     pw2[2]=PKW(P1,4), pw2[3]=PKW(P1,6), pw2); \
    VRD(3); SBAR(); GAPA(C0=__builtin_amdgcn_mfma_f32_32x32x16_bf16(kf[6],qr[3],C0,0,0,0),   P1[10],P1[11],P1[12],P1[13], pw3[0]=PKW(P1,8), pw3[1]=PKW(P1,10), pw3); \
    VRD(7); SBAR(); GAPA(C1=__builtin_amdgcn_mfma_f32_32x32x16_bf16(kf[7],qr[3],C1,0,0,0),   P1[14],P1[15],0.f,0.f,       pw3[2]=PKW(P1,12),pw3[3]=PKW(P1,14), pw3); \
    l_reg+=sacc; \
    if(GK){DMA_K((t)+3,sl_cur);} if(GV){DMA_V((t)+1,sl_next);} \
    CMASK(C0,C1,t); \
    SBAR(); \
    GAPB(o[0]=__builtin_amdgcn_mfma_f32_32x32x16_bf16(PAF(0),VFR(0),o[0],0,0,0), C0,0); \
    GAPB(o[1]=__builtin_amdgcn_mfma_f32_32x32x16_bf16(PAF(0),VFR(4),o[1],0,0,0), C0,4); \
    KRD(GL,0); GAPB(o[0]=__builtin_amdgcn_mfma_f32_32x32x16_bf16(PAF(1),VFR(1),o[0],0,0,0), C0,8); \
    KRD(GL,1); GAPB(o[1]=__builtin_amdgcn_mfma_f32_32x32x16_bf16(PAF(1),VFR(5),o[1],0,0,0), C0,12); \
    KRD(GL,2); GAPB(o[0]=__builtin_amdgcn_mfma_f32_32x32x16_bf16(PAF(2),VFR(2),o[0],0,0,0), C1,0); \
    KRD(GL,3); GAPB(o[1]=__builtin_amdgcn_mfma_f32_32x32x16_bf16(PAF(2),VFR(6),o[1],0,0,0), C1,4); \
    GAPB(o[0]=__builtin_amdgcn_mfma_f32_32x32x16_bf16(PAF(3),VFR(3),o[0],0,0,0), C1,8); \
    GAPB(o[1]=__builtin_amdgcn_mfma_f32_32x32x16_bf16(PAF(3),VFR(7),o[1],0,0,0), C1,12); \
    }while(0)
  int t=1;
  for(;t+5<NT;t+=2){
    STEP(pB0,pB1,pA0,pA1,t,true,true,true);     WAIT_BAR(2); RESC(); ROT();
    STEP(pA0,pA1,pB0,pB1,t+1,true,true,true);   WAIT_BAR(2); RESC(); ROT();
  }
  #define ENDW(tt) do{ if((tt)+3<NT){WAIT_BAR(2);} else if((tt)+2<NT){WAIT_BAR(1);} else {WAIT_BAR(0);} }while(0)
  for(;t+1<NT;t+=2){
    STEP(pB0,pB1,pA0,pA1,t,(t+3<NT),(t+1<NT),(t+1<NT));       ENDW(t);   RESC(); ROT();
    STEP(pA0,pA1,pB0,pB1,t+1,(t+4<NT),(t+2<NT),(t+2<NT));     ENDW(t+1); RESC(); ROT();
  }
  STEP(pB0,pB1,pA0,pA1,NT-1,false,false,false); RESC();
  { float sacc=pB0[0]+pB0[1]; _Pragma("unroll") for(int r=2;r<16;++r)sacc+=pB0[r]; _Pragma("unroll") for(int r=0;r<16;++r)sacc+=pB1[r]; l_reg+=sacc;
    pw0=(u32x4){PKW(pB0,0),PKW(pB0,2),PKW(pB0,4),PKW(pB0,6)};pw1=(u32x4){PKW(pB0,8),PKW(pB0,10),PKW(pB0,12),PKW(pB0,14)};pw2=(u32x4){PKW(pB1,0),PKW(pB1,2),PKW(pB1,4),PKW(pB1,6)};pw3=(u32x4){PKW(pB1,8),PKW(pB1,10),PKW(pB1,12),PKW(pB1,14)};
    SBAR(); pv(o,vb0+sl_cur,PAF(0),PAF(1),PAF(2),PAF(3)); }
  #undef PKW
  #undef PAF
  #undef VFR
  #undef PIN
  #undef MX3
  #undef GAPA
  #undef GAPB
  #undef EX
  #undef VRD
  #undef KRD
  #undef STEP
  #undef ENDW
  {auto rr=__builtin_amdgcn_permlane32_swap(__float_as_uint(l_reg),__float_as_uint(l_reg),false,false);l_reg=__uint_as_float(rr[0])+__uint_as_float(rr[1]);}
  if(hi==0)wsf[32+r32]=l_reg;asm volatile("s_waitcnt lgkmcnt(0)":::"memory");
  float rli[16];
  #pragma unroll
  for(int r=0;r<16;++r)rli[r]=__builtin_amdgcn_rcpf(wsf[32+crow(r,hi)]);
  bf16*Ow=O+(long)(q0+wid*QBLK)*OP+h*D;
  { bf16*stg=(bf16*)(shm+LDS_OST)+wid*2048;
    #pragma unroll
    for(int r=0;r<16;++r){const int orow=crow(r,hi);
      #pragma unroll
      for(int d0=0;d0<2;++d0)stg[orow*64+d0*32+r32]=f2bf(o[d0][r]*rli[r]);}
    asm volatile("s_waitcnt lgkmcnt(0)":::"memory");
    #pragma unroll
    for(int i=0;i<4;++i){const int row=i*8+(lane>>3),ch=lane&7; const u32x4 v=*(const u32x4*)(stg+row*64+ch*8); ATTN_STORE16(Ow+(long)row*OP+ch*8,v);} }
  asm volatile("s_waitcnt lgkmcnt(0)\n\ts_barrier":::"memory");
  #undef DMA_K
  #undef DMA_V
  #undef CMASK
  #undef START
  #undef RESC
  #undef ROT
}
constexpr int ATTN_LDS_BYTES=LDS_BYTES;
struct AttnTensors { const bf16* Q; const bf16* K; const bf16* V; bf16* O; };
#undef SBAR
#undef WAIT_BAR
}
constexpr int NWAVES = 8, NTHREADS = 512;
constexpr int RING_OFF = 0, RING_BYTES = 131072;
constexpr int LDSCTL_OFF = RING_BYTES, MISC_OFF = LDSCTL_OFF + 320;
constexpr int TT_OFF = LDSCTL_OFF + 1024;
constexpr int RT_OFF = LDSCTL_OFF + 4096;
constexpr int LDS_BYTES = RT_OFF + 16384 + 1024;
constexpr int MAXT = 192;

struct Frame {
    LAS unsigned char* lds; volatile LAS unsigned* MISC; unsigned* ctl;
    int tid, lane, wave, vcu, G;
};
__device__ __forceinline__ float silu_f(float v) { return v * __builtin_amdgcn_rcpf(1.f + __expf(-v)); }
__device__ __forceinline__ float lsig(float x) { return -log1pf(expf(-x)); }

__device__ __forceinline__ void publish_add(unsigned* cnt, bool leader) {
    asm volatile("s_waitcnt vmcnt(0)" ::: "memory"); __syncthreads();
    if (leader) { __builtin_amdgcn_fence(__ATOMIC_RELEASE, "agent"); asm volatile("s_waitcnt vmcnt(0)" ::: "memory");
        (void)__hip_atomic_fetch_add(cnt, 1u, __ATOMIC_RELAXED, __HIP_MEMORY_SCOPE_AGENT); }
}
__device__ __forceinline__ void store16_wt(void* p, f32x4 v) { asm volatile("global_store_dwordx4 %0, %1, off sc1\n\ts_nop 1" :: "v"(p), "v"(v) : "memory"); }
__device__ __forceinline__ void publish_add_wt(unsigned* cnt, bool leader) {
    asm volatile("s_waitcnt vmcnt(0)" ::: "memory"); __syncthreads();
    if (leader) (void)__hip_atomic_fetch_add(cnt, 1u, __ATOMIC_RELAXED, __HIP_MEMORY_SCOPE_AGENT);
}
__device__ __forceinline__ void wait_ge(unsigned* cnt, unsigned want, bool leader, unsigned* tmo, bool acq = true) {
    if (leader) { unsigned sp = 0;
        while (__hip_atomic_load(cnt, __ATOMIC_RELAXED, __HIP_MEMORY_SCOPE_AGENT) < want) { __builtin_amdgcn_s_sleep(2);
            if ((++sp & 1023u) == 0u) { if (sp > (1u << 22) || __hip_atomic_load(tmo, __ATOMIC_RELAXED, __HIP_MEMORY_SCOPE_AGENT) != 0u) { __hip_atomic_store(tmo, 1u, __ATOMIC_RELAXED, __HIP_MEMORY_SCOPE_AGENT); break; } } }
        if (acq) __builtin_amdgcn_fence(__ATOMIC_ACQUIRE, "agent"); asm volatile("s_waitcnt vmcnt(0)" ::: "memory"); }
    __syncthreads();
}

__device__ __forceinline__ void p0_transpose_item(const float* W, int N, bf16* WT, int Kd, int k0, int n0, int drow0, LAS float* scr, int lane) {
    float wv[32];
#pragma unroll
    for (int i = 0; i < 32; ++i) wv[i] = NT_LD(&W[(size_t)(k0 + 2 * i + (lane >> 5)) * N + n0 + (lane & 31)]);
#pragma unroll
    for (int i = 0; i < 32; ++i) scr[(2 * i + (lane >> 5)) * 33 + (lane & 31)] = wv[i];
    LDS_WAIT(); asm volatile("" ::: "memory");
    const int c = lane & 7;
#pragma unroll
    for (int j = 0; j < 4; ++j) { const int n = (lane >> 3) + 8 * j; const LAS float* s = scr + (8 * c) * 33 + n;
        u32x4 o; o.x = pk2(s[0 * 33], s[1 * 33]); o.y = pk2(s[2 * 33], s[3 * 33]); o.z = pk2(s[4 * 33], s[5 * 33]); o.w = pk2(s[6 * 33], s[7 * 33]);
        if (WT_MASK & 64) st16_sel(WT + (size_t)(drow0 + n) * Kd + k0 + 8 * c, o, true); else NT_ST(o, (u32x4*)(WT + (size_t)(drow0 + n) * Kd + k0 + 8 * c)); }
    LDS_WAIT(); asm volatile("" ::: "memory");
}
struct P0Args { unsigned* modcnt; const float *c, *cctx, *w_ada, *b_ada, *w_in, *w_out, *wg, *wu, *wd, *wgrp, *wexp; float *MOD, *ROPE, *RTW; bf16 *Wi, *Wo, *Wgu, *Wd; };
constexpr int CV_IN = 16 * 72, CV_OUT = 16 * 32, CV_G = 32 * 256, CV_D = 32 * 256, CV_ITEMS = CV_IN + CV_OUT + 2 * CV_G + CV_D;
#ifndef FILL_ITEMS
#define FILL_ITEMS 10240
#endif
constexpr int P0_ITEMS = CV_ITEMS - FILL_ITEMS;
__device__ __forceinline__ void convert_items(Frame& F, const P0Args& a, int first, int last, int w, int nw) {
    LAS float* scr = (LAS float*)(F.lds + RING_OFF + F.wave * 16384);
    for (int it = first + w; it < last; it += nw) {
        int r = it;
        if (r < CV_IN) { const int kb = r / 72, nb = r % 72, n0 = 32 * nb, pn = n0 >> 8, off = n0 & 255, wc = off >> 6, bj = (off >> 5) & 1;
            p0_transpose_item(a.w_in, NPROJ, a.Wi, 1024, 64 * kb, n0, pn * 256 + 128 * bj + 32 * wc, scr, F.lane); continue; } r -= CV_IN;
        if (r < CV_OUT) { const int kb = r >> 5, nb = r & 31; p0_transpose_item(a.w_out, 1024, a.Wo, 1024, 64 * kb, 32 * nb, 32 * nb, scr, F.lane); continue; } r -= CV_OUT;
        if (r < 2 * CV_G) { const int up = r >= CV_G; if (up) r -= CV_G; const int e = r >> 8, q = r & 255, kb = q >> 4, nb = q & 15, n0 = 32 * nb, pn = n0 >> 7, p = n0 & 127;
            p0_transpose_item((up ? a.wu : a.wg) + (size_t)e * 1024 * 512, 512, a.Wgu, 1024, 64 * kb, n0, e * 1024 + pn * 256 + (up ? 128 : 0) + p, scr, F.lane); continue; } r -= 2 * CV_G;
        { const int e = r >> 8, q = r & 255, kb = q >> 5, nb = q & 31; p0_transpose_item(a.wd + (size_t)e * 512 * 1024, 1024, a.Wd, 512, 64 * kb, 32 * nb, e * 1024 + 32 * nb, scr, F.lane); }
    }
}
__device__ __forceinline__ void p0_prologue(Frame& F, const P0Args& a) {
    for (int cb = F.vcu; cb < 192; cb += F.G) {
        LAS float* sv = (LAS float*)(F.lds);
        LAS float* red = (LAS float*)(F.lds + 8192);
        for (int i = F.tid; i < 2048; i += NTHREADS) sv[i] = silu_f(i < 1024 ? a.c[i] : a.cctx[i - 1024]);
        __syncthreads();
        const int col = F.tid & 31, kg = F.tid >> 5, j0 = cb * 32;
        float a0 = 0.f, a1 = 0.f;
#pragma unroll 8
        for (int i = 0; i < 64; ++i) { const int k = kg + 16 * i; const float w = NT_LD(&a.w_ada[(size_t)k * 6144 + j0 + col]); a0 += sv[k] * w; a1 += sv[1024 + k] * w; }
        red[(kg * 32 + col) * 2] = a0; red[(kg * 32 + col) * 2 + 1] = a1;
        __syncthreads();
        if (F.tid < 64) { const int cc = F.tid & 31, s = F.tid >> 5; float t = 0.f;
#pragma unroll
            for (int g = 0; g < 16; ++g) t += red[(g * 32 + cc) * 2 + s];
            if (WT_MASK & 128) __hip_atomic_store(a.MOD + s * 6144 + j0 + cc, t + a.b_ada[j0 + cc], __ATOMIC_RELAXED, __HIP_MEMORY_SCOPE_AGENT); else a.MOD[s * 6144 + j0 + cc] = t + a.b_ada[j0 + cc]; }
        if (WT_MASK & 128) publish_add_wt(a.modcnt, F.tid == 0); else publish_add(a.modcnt, F.tid == 0);
        __syncthreads();
    }
    if (F.vcu == F.G - 1) {
        for (int i = F.tid; i < 4096; i += NTHREADS) { const int pos = i >> 4, f = i & 15; const float freq = powf(10000.f, -(float)(2 * f) / 32.f), ang = (float)pos * freq;
            a.ROPE[2 * i] = cosf(ang); a.ROPE[2 * i + 1] = sinf(ang); }
        __syncthreads();
    }
    if (F.vcu == (F.G >= 2 ? F.G - 2 : 0)) {
        for (int i = F.tid; i < 36 * 1024; i += NTHREADS) { const int cc = i >> 10, n = i & 1023; a.RTW[i] = cc < 32 ? a.wexp[(size_t)n * 32 + cc] : a.wgrp[(size_t)n * 4 + cc - 32]; }
    }
    convert_items(F, a, 0, P0_ITEMS, F.vcu * NWAVES + F.wave, F.G * NWAVES);
}
template <int NB> __device__ __forceinline__ void norm1_rows(const int (&rows)[NB], int lane, const float* x, const float* ctx, const float* g1, const float* MOD, bf16* HX) {
    f32x4 v[NB][4];
#pragma unroll
    for (int b = 0; b < NB; ++b) { const int r = rows[b]; const float* src = r < CL ? ctx + (size_t)r * DM : x + (size_t)(r - CL) * DM;
#pragma unroll
        for (int j = 0; j < 4; ++j) v[b][j] = NT_LD((const f32x4*)src + 2 * lane + (j & 1) + 128 * (j >> 1)); }
#pragma unroll
    for (int b = 0; b < NB; ++b) { const int r = rows[b]; const float* mod = MOD + (r < CL ? 6144 : 0); float ss = 0.f;
#pragma unroll
        for (int j = 0; j < 4; ++j) ss += (v[b][j].x * v[b][j].x + v[b][j].y * v[b][j].y) + (v[b][j].z * v[b][j].z + v[b][j].w * v[b][j].w);
        const float rstd = rsqrtf(wave_sum(ss) * (1.f / DM) + EPS);
#pragma unroll
        for (int jp = 0; jp < 2; ++jp) { u32x4 o;
#pragma unroll
            for (int q = 0; q < 2; ++q) { const int j = 2 * jp + q, n = 8 * lane + 4 * q + 512 * jp; const f32x4 g = *(const f32x4*)(g1 + n), sh = *(const f32x4*)(mod + n), sc = *(const f32x4*)(mod + 1024 + n);
                float h[4];
#pragma unroll
                for (int i = 0; i < 4; ++i) h[i] = (v[b][j][i] * rstd) * g[i] * (1.f + sc[i]) + sh[i];
                if (q == 0) { o.x = pk2(h[0], h[1]); o.y = pk2(h[2], h[3]); } else { o.z = pk2(h[0], h[1]); o.w = pk2(h[2], h[3]); } }
            st16_sel(HX + (size_t)r * DM + 8 * lane + 512 * jp, o, (WT_MASK & 1) != 0); } }
}

__device__ __forceinline__ void route_stage_weights(Frame& F, const float* RTW) {
    LAS u32x4* wxT = (LAS u32x4*)(F.lds + RING_OFF); LAS u32x4* wgT = (LAS u32x4*)(F.lds + RT_OFF); const u32x4* src = (const u32x4*)RTW;
#pragma unroll 8
    for (int i = 0; i < 16; ++i) wxT[F.tid + NTHREADS * i] = src[F.tid + NTHREADS * i];
#pragma unroll
    for (int i = 0; i < 2; ++i) wgT[F.tid + NTHREADS * i] = src[8192 + F.tid + NTHREADS * i];
    __syncthreads();
}
struct RouteOut { int ea, eb; float w1, w2; };
__device__ __forceinline__ void route_load_row(int t, int lane, const bf16* XN, f32x4 (&v)[4]) {
    const u32x2* xr = (const u32x2*)(XN + (size_t)t * DM) + lane;
#pragma unroll
    for (int j = 0; j < 4; ++j) { const u32x2 w = xr[64 * j]; v[j] = (f32x4){__uint_as_float(w.x << 16), __uint_as_float(w.x & 0xffff0000u), __uint_as_float(w.y << 16), __uint_as_float(w.y & 0xffff0000u)}; }
}
template <int COMMIT> __device__ __forceinline__ void route_row_pre(Frame& F, int t, const f32x4 (&v)[4], const float* g2, const float* MOD, const float* bgrp, const float* bexp,
                                              bf16* H2, int* EID, float* RW, int* CNT, int* LIST, RouteOut* ro = nullptr, const f32x4 (*wgr)[4] = nullptr, const f32x4 (*gms)[4] = nullptr);
template <int COMMIT> __device__ __forceinline__ void route_row_lds(Frame& F, int t, const bf16* XN, const float* g2, const float* MOD, const float* bgrp, const float* bexp,
                                              bf16* H2, int* EID, float* RW, int* CNT, int* LIST) {
    f32x4 v[4]; route_load_row(t, F.lane, XN, v); route_row_pre<COMMIT>(F, t, v, g2, MOD, bgrp, bexp, H2, EID, RW, CNT, LIST);
}
template <int COMMIT> __device__ __forceinline__ void route_row_pre(Frame& F, int t, const f32x4 (&v)[4], const float* g2, const float* MOD, const float* bgrp, const float* bexp,
                                              bf16* H2, int* EID, float* RW, int* CNT, int* LIST, RouteOut* ro, const f32x4 (*wgr)[4], const f32x4 (*gms)[4]) {
    const int lane = F.lane;
    const LAS float* wxT = (const LAS float*)(F.lds + RING_OFF); const LAS float* wgT = (const LAS float*)(F.lds + RT_OFF);
    float ss = 0.f;
#pragma unroll
    for (int j = 0; j < 4; ++j) ss += (v[j].x * v[j].x + v[j].y * v[j].y) + (v[j].z * v[j].z + v[j].w * v[j].w);
#if defined(DIAG_CK) && DIAG_CK == 1
    { unsigned cx = 0;
#pragma unroll
      for (int j = 0; j < 4; ++j) cx ^= (__float_as_uint(v[j].x) * 3u) ^ (__float_as_uint(v[j].y) * 5u) ^ (__float_as_uint(v[j].z) * 7u) ^ (__float_as_uint(v[j].w) * 11u);
      cx *= (unsigned)(t * 2 + 1);
#pragma unroll
      for (int o = 1; o < 64; o <<= 1) cx ^= (unsigned)__shfl_xor((int)cx, o);
      if (COMMIT && lane == 0) atomicXor((unsigned*)(CNT) + 64, cx); }
#endif
    const float rstd = rsqrtf(wave_sum(ss) * (1.f / DM) + EPS);
    float gl[4]; pg8::f32x2 gl2[4] = {{0.f, 0.f}, {0.f, 0.f}, {0.f, 0.f}, {0.f, 0.f}};
    f32x4 h[4];
#pragma unroll
    for (int j = 0; j < 4; ++j) {
        const int n = 4 * lane + 256 * j;
        if (gms) h[j] = (v[j] * rstd) * gms[0][j] + gms[1][j];
        else { const f32x4 g = *(const f32x4*)(g2 + n), sh = *(const f32x4*)(MOD + 3072 + n), sc = *(const f32x4*)(MOD + 4096 + n);
#pragma unroll
            for (int i = 0; i < 4; ++i) h[j][i] = (v[j][i] * rstd) * g[i] * (1.f + sc[i]) + sh[i]; }
#pragma unroll
        for (int c = 0; c < 4; ++c) { const f32x4 w = wgr ? wgr[c][j] : *(const LAS f32x4*)(wgT + c * 1024 + n); gl2[c] += (pg8::f32x2){h[j].x, h[j].y} * (pg8::f32x2){w.x, w.y}; gl2[c] += (pg8::f32x2){h[j].z, h[j].w} * (pg8::f32x2){w.z, w.w}; }
        u32x2 o; o.x = pk2(h[j].x, h[j].y); o.y = pk2(h[j].z, h[j].w);
        st8_sel(H2 + (size_t)t * DM + n, o, (WT_MASK & 16) != 0);
    }
#pragma unroll
    for (int c = 0; c < 4; ++c) gl[c] = wave_sum(gl2[c].x + gl2[c].y) + bgrp[c];
    int g = 0; float gm = gl[0];
#pragma unroll
    for (int c = 1; c < 4; ++c) if (gl[c] > gm) { gm = gl[c]; g = c; }
    g = __builtin_amdgcn_readfirstlane(g);
    float gs = 0.f;
#pragma unroll
    for (int c = 0; c < 4; ++c) gs += __expf(gl[c] - gm);
    const float pg = __builtin_amdgcn_rcpf(gs);
    float el[8]; pg8::f32x2 el2[8] = {{0.f, 0.f}, {0.f, 0.f}, {0.f, 0.f}, {0.f, 0.f}, {0.f, 0.f}, {0.f, 0.f}, {0.f, 0.f}, {0.f, 0.f}};
#pragma unroll
    for (int j = 0; j < 4; ++j)
#pragma unroll
        for (int c = 0; c < 8; ++c) { const f32x4 w = *(const LAS f32x4*)(wxT + (g * 8 + c) * 1024 + 4 * lane + 256 * j); el2[c] += (pg8::f32x2){h[j].x, h[j].y} * (pg8::f32x2){w.x, w.y}; el2[c] += (pg8::f32x2){h[j].z, h[j].w} * (pg8::f32x2){w.z, w.w}; }
#pragma unroll
    for (int c = 0; c < 8; ++c) el[c] = wave_sum(el2[c].x + el2[c].y) + bexp[g * 8 + c];
    int j1 = 0; float m1 = el[0];
#pragma unroll
    for (int c = 1; c < 8; ++c) if (el[c] > m1) { m1 = el[c]; j1 = c; }
    int j2 = -1; float m2 = -INFINITY;
#pragma unroll
    for (int c = 0; c < 8; ++c) if (c != j1 && el[c] > m2) { m2 = el[c]; j2 = c; }
    const float e2 = __expf(m2 - m1), r12 = __builtin_amdgcn_rcpf(1.f + e2), w1 = pg * r12, w2 = pg * e2 * r12;
    if (COMMIT == 2) { ro->ea = __builtin_amdgcn_readfirstlane(g * 8 + j1); ro->eb = __builtin_amdgcn_readfirstlane(g * 8 + j2); ro->w1 = __uint_as_float(__builtin_amdgcn_readfirstlane(__float_as_uint(w1))); ro->w2 = __uint_as_float(__builtin_amdgcn_readfirstlane(__float_as_uint(w2))); return; }
    if (lane == 0) {
        const int ea = g * 8 + j1, eb = g * 8 + j2;
        EID[2 * t] = ea; EID[2 * t + 1] = eb; RW[2 * t] = w1; RW[2 * t + 1] = w2;
        if (COMMIT == 1) {
            const int sa = atomicAdd(CNT + ea, 1); __hip_atomic_store(LIST + ea * SEQ + sa, 2 * t, __ATOMIC_RELAXED, __HIP_MEMORY_SCOPE_AGENT);
            const int sb = atomicAdd(CNT + eb, 1); __hip_atomic_store(LIST + eb * SEQ + sb, 2 * t + 1, __ATOMIC_RELAXED, __HIP_MEMORY_SCOPE_AGENT); }
    }
}

namespace pg8 {
struct AMapDirect { __device__ __forceinline__ int row(const Unit& u, int r) const { return u.pm * BM + r; }
    __device__ __forceinline__ int raw(const Unit& u, int r) const { return row(u, r); } __device__ __forceinline__ int fix(int x) const { return x; } };
struct MoeTable { const LAS int* tt; const int* LIST;
    __device__ __forceinline__ int e(int T) const { return tt[T]; }
    __device__ __forceinline__ int s0(int T) const { return tt[MAXT + T]; }
    __device__ __forceinline__ int cnt(int e_) const { return tt[2 * MAXT + e_]; }
    __device__ __forceinline__ int ntiles() const { return tt[2 * MAXT + 32]; }
};
struct AMapGather { MoeTable mt;
    __device__ __forceinline__ int row(const Unit& u, int r) const { const int T = u.pm, e = mt.e(T), c = mt.cnt(e); int s = mt.s0(T) + r; s = s < c ? s : c - 1; return mt.LIST[e * SEQ + s] >> 1; }
    __device__ __forceinline__ int raw(const Unit& u, int r) const { const int T = u.pm, e = mt.e(T), c = mt.cnt(e); int s = mt.s0(T) + r; s = s < c ? s : c - 1; return mt.LIST[e * SEQ + s]; }
    __device__ __forceinline__ int fix(int x) const { return x >> 1; } };
struct MoeOrder { MoeTable mt; int G, c;
    __device__ __forceinline__ bool next(int i, Unit& u) const { const int L = i * G + c; if (L >= 4 * mt.ntiles()) return false; const int T = L >> 2; u.pm = T; u.pn = mt.e(T) * 4 + (L & 3); return true; }
    __device__ __forceinline__ void a_ready(const Unit&) const {}
    __device__ __forceinline__ void done(const Unit&) const {}
};
struct MoeOrder1 { MoeTable mt; int G, c; unsigned* tcnt;
    __device__ __forceinline__ bool next(int i, Unit& u) const { const int L = i * G + c; if (L >= 4 * mt.ntiles()) return false; const int T = L >> 2; u.pm = T; u.pn = mt.e(T) * 4 + (L & 3); return true; }
    __device__ __forceinline__ void a_ready(const Unit&) const {}
    __device__ __forceinline__ void done(const Unit& u) const { asm volatile("s_waitcnt vmcnt(0)" ::: "memory");
        if (fresh_lane() == 0) (void)__hip_atomic_fetch_add(tcnt + 64 * u.pm, 1u, __ATOMIC_RELAXED, __HIP_MEMORY_SCOPE_AGENT); }
};
#ifndef NOACQ_MASK
#define NOACQ_MASK 0
#endif
#ifndef MOE_NOACQ
#define MOE_NOACQ 0
#endif
#ifndef MOE_PEEK
#define MOE_PEEK 0
#endif
struct MoeOrder2 { MoeTable mt; int G, c, wave; unsigned* tcnt; unsigned* tmo; mutable bool acq_all = false;
    __device__ __forceinline__ bool next(int i, Unit& u) const {
        const int n1 = 4 * mt.ntiles(), k3 = n1 - 512; int L;
        if (G != 256 || k3 < 0 || k3 > 255) L = i * G + c;
        else if (c < k3) { if (i > 0) return false; L = 512 + c; }
        else { const int nb = 256 - k3; L = (c - k3) + i * nb; if (L >= 512) return false; }
        if (L >= n1) return false; const int T = L >> 2; u.pm = T; u.pn = mt.e(T) * 4 + (L & 3); return true; }
    __device__ __forceinline__ void a_ready(const Unit& u) const {
        if (wave == 0 && !acq_all) { unsigned sp = 0;
            while ((unsigned)__builtin_amdgcn_readfirstlane(__hip_atomic_load(tcnt + 64 * u.pm, __ATOMIC_RELAXED, __HIP_MEMORY_SCOPE_AGENT)) < 32u) { __builtin_amdgcn_s_sleep(2);
                if ((++sp & 1023u) == 0u && (sp > (1u << 22) || __builtin_amdgcn_readfirstlane(__hip_atomic_load(tmo, __ATOMIC_RELAXED, __HIP_MEMORY_SCOPE_AGENT)) != 0u)) { if (fresh_lane() == 0) __hip_atomic_store(tmo, 1u, __ATOMIC_RELAXED, __HIP_MEMORY_SCOPE_AGENT); break; } }
            if (MOE_PEEK) { bool all = true;
#pragma unroll
                for (int j = 0; j < 3; ++j) { Unit o; if (next(j, o)) all = all && ((unsigned)__builtin_amdgcn_readfirstlane(__hip_atomic_load(tcnt + 64 * o.pm, __ATOMIC_RELAXED, __HIP_MEMORY_SCOPE_AGENT)) >= 32u); }
                acq_all = all; }
            if (!MOE_NOACQ) __builtin_amdgcn_fence(__ATOMIC_ACQUIRE, "agent"); asm volatile("s_waitcnt vmcnt(0)" ::: "memory"); }
        asm volatile("" ::: "memory"); __builtin_amdgcn_s_barrier(); asm volatile("" ::: "memory");
    }
    __device__ __forceinline__ void done(const Unit&) const {}
};
__device__ __forceinline__ u32x4 pack8(const f32x4& a, const f32x4& b) { u32x4 w; w.x = cvt_pk_bf16(a[0], a[1]); w.y = cvt_pk_bf16(a[2], a[3]); w.z = cvt_pk_bf16(b[0], b[1]); w.w = cvt_pk_bf16(b[2], b[3]); return w; }

struct EpiInProj {
    static constexpr bool PERM = true, AFTER_DRAIN = false;
    bf16 *Q, *K, *V, *QR, *KR, *VR, *GR; const float *gq, *gk, *ROPE;
    __device__ __forceinline__ void operator()(const f32x4 (&acc)[2][2][4][2], const Unit& u, int wr, int wc, int fr, int fq) const {
        const int pn = u.pn; int kind, h;
        if (pn < 2) { kind = 0; h = pn * 4 + wc; } else if (pn == 2) { if (wc < 2) { kind = 1; h = wc; } else { kind = 2; h = wc - 2; } }
        else if (pn == 3) { kind = 3; h = wc; } else if (pn == 4) { kind = 4; h = wc; } else if (pn < 7) { kind = 5; h = (pn - 5) * 4 + wc; } else { kind = 6; h = (pn - 7) * 4 + wc; }
        const bool isctx = (u.pm == 0);
        if (isctx && (kind == 0 || kind == 3 || kind == 6)) return;
        const bool norm = kind <= 1, rope = !isctx && (kind == 0 || kind == 1 || kind == 3 || kind == 4);
        f32x4 gg[2][2];
#pragma unroll
        for (int bj = 0; bj < 2; ++bj)
#pragma unroll
            for (int n = 0; n < 2; ++n) gg[bj][n] = norm ? *(const f32x4*)((kind == 0 ? gq : gk) + 32 * bj + 8 * fq + 4 * n) : (f32x4){1.f, 1.f, 1.f, 1.f};
        const float osc = kind == 0 ? QSCALE : (kind == 4 ? 0.125f : 1.f);
        bf16* obase; int ostride; bool use_t;
        switch (kind) {
            case 0: obase = Q + h * 64; ostride = 512; use_t = true; break;
            case 1: obase = K + (size_t)h * NKV * 64; ostride = 64; use_t = false; break;
            case 2: obase = V + (size_t)h * NKV * 64; ostride = 64; use_t = false; break;
            case 3: obase = QR + (size_t)h * SEQ * 64; ostride = 64; use_t = true; break;
            case 4: obase = KR + (size_t)h * NKV * 64; ostride = 64; use_t = false; break;
            case 5: obase = VR + (size_t)(h >> 1) * NKV * 128 + (h & 1) * 64; ostride = 128; use_t = false; break;
            default: obase = GR + h * 64; ostride = 512; use_t = true; break;
        }
        f32x4 csr[2][2], csc[4][2];
        if (rope) { const int tb = u.pm * BM - CL + wr * 64;
#pragma unroll
            for (int ai = 0; ai < 2; ++ai)
#pragma unroll
                for (int n = 0; n < 2; ++n) csr[ai][n] = *(const f32x4*)(ROPE + ((((tb + ai * HALF) >> 6) * 16 + 4 * fq) * 2) + 4 * n);
#pragma unroll
            for (int m = 0; m < 4; ++m)
#pragma unroll
                for (int n = 0; n < 2; ++n) csc[m][n] = *(const f32x4*)(ROPE + (((m * 16 + fr) * 16 + 4 * fq) * 2) + 4 * n); }
#pragma unroll
        for (int ai = 0; ai < 2; ++ai)
#pragma unroll
            for (int m = 0; m < 4; ++m) {
                const int r = u.pm * BM + ai * HALF + wr * 64 + m * 16 + fr, t = r - CL;
                f32x4 v[2][2];
#pragma unroll
                for (int bj = 0; bj < 2; ++bj)
#pragma unroll
                    for (int n = 0; n < 2; ++n) v[bj][n] = acc[ai][bj][m][n];
                if (norm) { float ss = 0.f;
#pragma unroll
                    for (int bj = 0; bj < 2; ++bj)
#pragma unroll
                        for (int n = 0; n < 2; ++n) ss += (v[bj][n][0] * v[bj][n][0] + v[bj][n][1] * v[bj][n][1]) + (v[bj][n][2] * v[bj][n][2] + v[bj][n][3] * v[bj][n][3]);
                    ss += __shfl_xor(ss, 16); ss += __shfl_xor(ss, 32);
                    const float rn = rsqrtf(ss * (1.f / 64.f) + EPS);
#pragma unroll
                    for (int bj = 0; bj < 2; ++bj)
#pragma unroll
                        for (int n = 0; n < 2; ++n) v[bj][n] = v[bj][n] * rn * gg[bj][n]; }
                if (rope) {
#pragma unroll
                    for (int bj = 0; bj < 2; ++bj) {
#pragma unroll
                        for (int n = 0; n < 2; ++n) { const f32x4 cs = bj ? csc[m][n] : csr[ai][n]; const f32x4 x = v[bj][n];
                            v[bj][n] = (f32x4){x[0] * cs[0] - x[1] * cs[1], x[0] * cs[1] + x[1] * cs[0], x[2] * cs[2] - x[3] * cs[3], x[2] * cs[3] + x[3] * cs[2]}; } } }
#pragma unroll
                for (int bj = 0; bj < 2; ++bj) {
                    st16_sel(obase + (size_t)(use_t ? t : r) * ostride + 32 * bj + 8 * fq, pack8(v[bj][0] * osc, v[bj][1] * osc), (WT_MASK & 2) != 0); }
            }
    }
};
template <bool WT> struct EpiOutProj {
    static constexpr bool PERM = true, AFTER_DRAIN = false;
    const float* x; const float* gt1; bf16* XN;
    __device__ __forceinline__ void operator()(const f32x4 (&acc)[2][2][4][2], const Unit& u, int wr, int wc, int fr, int fq) const {
        const int c0 = u.pn * BM + wc * 32 + 8 * fq;
        f32x4 g[2][2];
#pragma unroll
        for (int bj = 0; bj < 2; ++bj)
#pragma unroll
            for (int n = 0; n < 2; ++n) g[bj][n] = *(const f32x4*)(gt1 + c0 + bj * HALF + 4 * n);
#pragma unroll
        for (int ai = 0; ai < 2; ++ai) { f32x4 xv[4][2][2];
#pragma unroll
            for (int m = 0; m < 4; ++m) { const size_t off = (size_t)(u.pm * BM + ai * HALF + wr * 64 + m * 16 + fr) * DM + c0;
#pragma unroll
                for (int bj = 0; bj < 2; ++bj)
#pragma unroll
                    for (int n = 0; n < 2; ++n) xv[m][bj][n] = NT_LD((const f32x4*)(x + off + bj * HALF + 4 * n)); }
#pragma unroll
            for (int m = 0; m < 4; ++m) { const size_t off = (size_t)(u.pm * BM + ai * HALF + wr * 64 + m * 16 + fr) * DM + c0;
#pragma unroll
                for (int bj = 0; bj < 2; ++bj) { const u32x4 w = pack8(xv[m][bj][0] + g[bj][0] * acc[ai][bj][m][0], xv[m][bj][1] + g[bj][1] * acc[ai][bj][m][1]);
                    if (WT) store16_wt(XN + off + bj * HALF, __builtin_bit_cast(f32x4, w)); else *(u32x4*)(XN + off + bj * HALF) = w; } } }
    }
};
#ifndef ACT_ST16
#define ACT_ST16 0
#endif
template <bool WT> struct EpiSwiGLU {
    static constexpr bool PERM = true, AFTER_DRAIN = false;
    bf16* ACT;
    __device__ __forceinline__ void operator()(const f32x4 (&acc)[2][2][4][2], const Unit& u, int wr, int wc, int fr, int fq) const {
        const int c0 = (u.pn & 3) * 128 + wc * 32 + 8 * fq;
#pragma unroll
        for (int ai = 0; ai < 2; ++ai)
#pragma unroll
            for (int m = 0; m < 4; ++m) { f32x4 o[2];
#pragma unroll
                for (int n = 0; n < 2; ++n)
#pragma unroll
                    for (int i = 0; i < 4; ++i) { const float gv = acc[ai][0][m][n][i]; o[n][i] = gv * __builtin_amdgcn_rcpf(1.f + __expf(-gv)) * acc[ai][1][m][n][i]; }
                const u32x4 w = pack8(o[0], o[1]); bf16* dst = ACT + (size_t)(u.pm * BM + ai * HALF + wr * 64 + m * 16 + fr) * DEXP + c0;
                if (WT && !ACT_ST16) { __hip_atomic_store((unsigned long long*)dst, (unsigned long long)w.x | ((unsigned long long)w.y << 32), __ATOMIC_RELAXED, __HIP_MEMORY_SCOPE_AGENT);
                          __hip_atomic_store((unsigned long long*)dst + 1, (unsigned long long)w.z | ((unsigned long long)w.w << 32), __ATOMIC_RELAXED, __HIP_MEMORY_SCOPE_AGENT); }
                else st16_sel(dst, w, WT); }
    }
};
struct EpiScatter {
    static constexpr bool PERM = true, AFTER_DRAIN = false;
    MoeTable mt; bf16* Y; int* FLAG;
    __device__ __forceinline__ void operator()(const f32x4 (&acc)[2][2][4][2], const Unit& u, int wr, int wc, int fr, int fq) const {
        const int T = u.pm, e = mt.e(T), cnt = mt.cnt(e), s0 = mt.s0(T); const int c0 = (u.pn & 3) * BM + wc * 32 + 8 * fq;
        int al[2][4];
#pragma unroll
        for (int ai = 0; ai < 2; ++ai)
#pragma unroll
            for (int m = 0; m < 4; ++m) { const int s = s0 + ai * HALF + wr * 64 + m * 16 + fr; al[ai][m] = s < cnt ? mt.LIST[e * SEQ + s] : -1; }
#pragma unroll
        for (int ai = 0; ai < 2; ++ai)
#pragma unroll
            for (int m = 0; m < 4; ++m) { const int a = al[ai][m];
                if (a >= 0) { bf16* dst = Y + ((size_t)(a & 1) * SEQ + (a >> 1)) * DM + c0;
#ifdef DIAG_FLAG
                    if ((u.pn & 3) == 0 && wc == 0 && fq == 0) atomicAdd(FLAG + a, 1);
#endif
#pragma unroll
                    for (int bj = 0; bj < 2; ++bj) st16_sel(dst + bj * HALF, pack8(acc[ai][bj][m][0], acc[ai][bj][m][1]), (WT_MASK & 32) != 0); } }
    }
};
}
__device__ __forceinline__ void moe_build_table(Frame& F, const int* CNT) {
    LAS int* tt = (LAS int*)(F.lds + TT_OFF);
    if (F.wave == 0) { const int lane = fresh_lane(); const int c = lane < NEXP ? CNT[lane] : 0; const int nt = (c + 255) >> 8; int incl = nt;
#pragma unroll
        for (int o = 1; o < 32; o <<= 1) { const int v = __shfl_up(incl, o); if (lane >= o) incl += v; }
        const int first = incl - nt;
        if (lane < NEXP) { tt[2 * MAXT + lane] = c; for (int k = 0; k < nt; ++k) if (first + k < MAXT) { tt[first + k] = lane; tt[MAXT + first + k] = 256 * k; } }
        const int total = __shfl(incl, NEXP - 1); if (lane == 0) tt[2 * MAXT + 32] = total < MAXT ? total : MAXT; }
    __syncthreads();
}

namespace ret {
typedef short bf16x8 __attribute__((ext_vector_type(8)));
typedef short s16x4 __attribute__((ext_vector_type(4)));
constexpr int KS = 144, VS = 272, PS = 272;
constexpr int NCH = 130;
#define RET_MFMA(a, b, c) __builtin_amdgcn_mfma_f32_16x16x32_bf16(a, b, c, 0, 0, 0)
__device__ __forceinline__ bf16x8 tr_frag(LAS unsigned char* base, int S, int tok0, int feat0, int lane) {
    const int g = lane >> 4, i = lane & 15;
#ifndef RET_NO_TR
    const int q = i >> 2, p = i & 3;
    LAS unsigned char* a0 = base + (tok0 + 8 * g + q) * S + (feat0 + 4 * p) * 2;
    const s16x4 lo = __builtin_bit_cast(s16x4, __builtin_amdgcn_ds_read_tr16_b64_v4i16((LAS s16x4*)a0));
    const s16x4 hi = __builtin_bit_cast(s16x4, __builtin_amdgcn_ds_read_tr16_b64_v4i16((LAS s16x4*)(a0 + 4 * S)));
    return (bf16x8){lo[0], lo[1], lo[2], lo[3], hi[0], hi[1], hi[2], hi[3]};
#else
    bf16x8 r;
#pragma unroll
    for (int j = 0; j < 8; ++j) r[j] = *(LAS short*)(base + (tok0 + 8 * g + j) * S + (feat0 + i) * 2);
    return r;
#endif
}
__device__ __forceinline__ u32x4 scale8(u32x4 w, float s) {
    u32x4 o;
#pragma unroll
    for (int i = 0; i < 4; ++i) { const float lo = __uint_as_float(w[i] << 16) * s, hi = __uint_as_float(w[i] & 0xffff0000u) * s; o[i] = pk2(lo, hi); }
    return o;
}
#ifndef RET_WT
#define RET_WT 0
#endif
__device__ __forceinline__ void r1_unit(Frame& F, int h, int j, const bf16* KR, const bf16* VR, float lgf, float lgb, float* U) {
    LAS unsigned char* Kf = F.lds, *Kb = F.lds + 128 * KS, *Vs = F.lds + 2 * 128 * KS;
    const int lane = fresh_lane(), tid = F.wave * 64 + lane;
    const bf16* kc = KR + ((size_t)h * NKV + 128 * j) * 64; const bf16* vc = VR + ((size_t)h * NKV + 128 * j) * 128;
#pragma unroll
    for (int i = 0; i < 2; ++i) { const int id = tid + 512 * i, row = id >> 3, ch = id & 7; const u32x4 w = *(const u32x4*)(kc + row * 64 + ch * 8);
        *(LAS u32x4*)(Kf + row * KS + ch * 16) = scale8(w, __expf(lgf * (float)(127 - row))); *(LAS u32x4*)(Kb + row * KS + ch * 16) = scale8(w, __expf(lgb * (float)row)); }
#pragma unroll
    for (int i = 0; i < 4; ++i) { const int id = tid + 512 * i, row = id >> 4, ch = id & 15; *(LAS u32x4*)(Vs + row * VS + ch * 16) = *(const u32x4*)(vc + row * 128 + ch * 8); }
    __syncthreads();
    const int w = F.wave, g = lane >> 4, li = lane & 15;
    bf16x8 a[4];
#pragma unroll
    for (int ks = 0; ks < 4; ++ks) a[ks] = tr_frag(Vs, VS, 32 * ks, 16 * w, lane);
#pragma unroll
    for (int dir = 0; dir < 2; ++dir)
#pragma unroll
        for (int c = 0; c < 4; ++c) { f32x4 acc = {0.f, 0.f, 0.f, 0.f}; bf16x8 bfr[4];
#pragma unroll
            for (int ks = 0; ks < 4; ++ks) bfr[ks] = tr_frag(dir ? Kb : Kf, KS, 32 * ks, 16 * c, lane);
#pragma unroll
            for (int ks = 0; ks < 4; ++ks) acc = RET_MFMA(a[ks], bfr[ks], acc);
            float* up = U + ((size_t)((h * NCH + j) * 2 + dir)) * 8192 + (16 * w + 4 * g) * 64 + 16 * c + li;
#pragma unroll
            for (int r = 0; r < 4; ++r) { if (RET_WT) __hip_atomic_store(up + r * 64, acc[r], __ATOMIC_RELAXED, __HIP_MEMORY_SCOPE_AGENT); else up[r * 64] = acc[r]; } }
    __syncthreads();
}
__device__ __forceinline__ void r2_scan(int gid, const float* U, float lgf, float lgb, int h, int dir, bf16* SP) {
    const int e = gid & 8191; const float gC = __expf((dir ? lgb : lgf) * 128.f); float S = 0.f;
    const float* up = U + (size_t)(h * NCH * 2 + dir) * 8192 + e; bf16* sp = SP + (size_t)(h * 128 * 2 + dir) * 8192 + e;
    if (dir == 0) {
#pragma unroll 44
        for (int j = 0; j < NCH; ++j) { if (j >= 2) sp[(size_t)(j - 2) * 16384] = f2bf(S); S = gC * S + up[(size_t)j * 16384]; }
    } else {
        S = up[(size_t)1 * 16384]; S = gC * S + up[0];
#pragma unroll 43
        for (int j = NCH - 1; j >= 2; --j) { sp[(size_t)(j - 2) * 16384] = f2bf(S); S = gC * S + up[(size_t)j * 16384]; }
    }
}
__device__ __forceinline__ void r2_scan_block(Frame& F, int blk, const float* U, const float* dec_f, const float* dec_b, bf16* SP) {
    const int cid0 = blk * 256, combo = cid0 >> 13, h = combo >> 1, dir = combo & 1, s = F.wave, lane = fresh_lane(), vz = lane >> 6;
    const float lg = lsig(dir ? dec_b[h] : dec_f[h]), gC = __expf(lg * 128.f), D16 = __expf(lg * 128.f * 16.f);
    LAS float* Tl = (LAS float*)(F.lds + RING_OFF);
    float pre[4][16], c0[4];
#pragma unroll
    for (int q = 0; q < 4; ++q) { const int e = (cid0 + q * 64 + lane) & 8191; const float* up = U + (size_t)(h * NCH * 2 + dir) * 8192 + e;
        const float ua = up[(size_t)(dir + vz) * 16384], ub = up[(size_t)(1 - dir + vz) * 16384];
        float u[16];
#pragma unroll
        for (int k = 0; k < 16; ++k) { const int n = (dir == 0 ? 16 * s + k : 127 - 16 * s - k) + vz; u[k] = up[(size_t)(2 + n) * 16384]; }
        c0[q] = gC * ua + ub;
        float P = 0.f;
#pragma unroll
        for (int k = 0; k < 16; ++k) { pre[q][k] = P; P = gC * P + u[k]; }
        Tl[s * 256 + q * 64 + lane] = P; }
    __syncthreads();
#pragma unroll
    for (int q = 0; q < 4; ++q) { float C = c0[q];
        for (int s2 = 0; s2 < s; ++s2) C = C * D16 + Tl[s2 * 256 + q * 64 + lane];
        const int e = (cid0 + q * 64 + lane) & 8191; bf16* sp = SP + (size_t)(h * 128 * 2 + dir) * 8192 + e; float cur = C;
#pragma unroll
        for (int k = 0; k < 16; ++k) { const int n = (dir == 0 ? 16 * s + k : 127 - 16 * s - k) + vz; const bf16 sv = f2bf(cur + pre[q][k]); if (RET_WT) __hip_atomic_store(sp + (size_t)n * 16384, sv, __ATOMIC_RELAXED, __HIP_MEMORY_SCOPE_AGENT); else sp[(size_t)n * 16384] = sv; cur *= gC; } }
    __syncthreads();
}
struct R3Regs { u32x4 kreg[2], vreg[4], sreg[4]; bf16x8 qa[2]; };
__device__ __forceinline__ void r3_load(R3Regs& R, int wv, int lane, int h, int n, const bf16* QR, const bf16* KR, const bf16* VR, const bf16* SP) {
    const int t0 = 128 * n, tid = wv * 64 + lane, g = lane >> 4, li = lane & 15; const bf16* kc = KR + ((size_t)h * NKV + CL + t0) * 64; const bf16* vc = VR + ((size_t)h * NKV + CL + t0) * 128;
    const bf16* spc = SP + (size_t)((h * 128 + n) * 2) * 8192;
#pragma unroll
    for (int q = 0; q < 2; ++q) { const int id = tid + 512 * q; R.kreg[q] = *(const u32x4*)(kc + (id >> 3) * 64 + (id & 7) * 8); }
#pragma unroll
    for (int q = 0; q < 4; ++q) { const int id = tid + 512 * q; R.vreg[q] = *(const u32x4*)(vc + (id >> 4) * 128 + (id & 15) * 8); R.sreg[q] = *(const u32x4*)(spc + (size_t)id * 8); }
#pragma unroll
    for (int ks = 0; ks < 2; ++ks) R.qa[ks] = *(const bf16x8*)(QR + ((size_t)h * SEQ + t0 + 16 * wv + li) * 64 + 32 * ks + 8 * g);
}
__device__ __forceinline__ void r3_unit(Frame& F, R3Regs& R, int h, int n, int hn, int nn, const bf16* QR, const bf16* KR, const bf16* VR, const bf16* GR, const bf16* SP,
                                        float lgf, float lgb, const float* gn_g, const float* gn_b, bf16* MIX) {
    LAS unsigned char* Ks = F.lds, *Vs = F.lds + 128 * KS, *Ps = F.lds + 128 * KS + 128 * VS, *Ss = F.lds + 128 * KS + 2 * 128 * VS;
    const int t0 = 128 * n;
    const int w = F.wave, lane = fresh_lane(), g = lane >> 4, li = lane & 15, tid = w * 64 + lane;
    const int i = 16 * w + li, t = t0 + i;
    bf16x8 qa[2]; qa[0] = R.qa[0]; qa[1] = R.qa[1];
#pragma unroll
    for (int q = 0; q < 2; ++q) { const int id = tid + 512 * q; *(LAS u32x4*)(Ks + (id >> 3) * KS + (id & 7) * 16) = R.kreg[q]; }
#pragma unroll
    for (int q = 0; q < 4; ++q) { const int id = tid + 512 * q; *(LAS u32x4*)(Vs + (id >> 4) * VS + (id & 15) * 16) = R.vreg[q]; *(LAS u32x4*)(Ss + (id >> 3) * KS + (id & 7) * 16) = R.sreg[q]; }
    if (hn >= 0) r3_load(R, w, lane, hn, nn, QR, KR, VR, SP);
    __syncthreads();
    u32x2 greg[8];
#pragma unroll
    for (int d = 0; d < 8; ++d) greg[d] = *(const u32x2*)(GR + (size_t)t * 512 + h * 128 + 16 * d + 4 * g);
    float cf[4], cb[4];
#pragma unroll
    for (int r = 0; r < 4; ++r) { cf[r] = __expf(-lgf * (float)r); cb[r] = __expf(lgb * (float)r); }
    bf16x8 kfr[8][2];
#pragma unroll
    for (int jt = 0; jt < 8; ++jt)
#pragma unroll
        for (int ks = 0; ks < 2; ++ks) kfr[jt][ks] = *(LAS bf16x8*)(Ks + (16 * jt + li) * KS + (32 * ks + 8 * g) * 2);
#pragma unroll
    for (int jt = 0; jt < 8; ++jt) { f32x4 s = {0.f, 0.f, 0.f, 0.f};
#pragma unroll
        for (int ks = 0; ks < 2; ++ks) s = RET_MFMA(kfr[jt][ks], qa[ks], s);
        const int df0 = i - (16 * jt + 4 * g); const float ef0 = __expf(lgf * (float)df0), eb0 = __expf(-lgb * (float)df0);
        float p[4];
#pragma unroll
        for (int r = 0; r < 4; ++r) p[r] = s[r] * ((df0 - r >= 0) ? ef0 * cf[r] : eb0 * cb[r]);
        u32x2 pw; pw.x = pk2(p[0], p[1]); pw.y = pk2(p[2], p[3]);
        *(LAS u32x2*)(Ps + i * PS + (16 * jt + 4 * g) * 2) = pw; }
    LDS_WAIT();
    f32x4 acc[8], af[8], ab[8];
#pragma unroll
    for (int d = 0; d < 8; ++d) { acc[d] = (f32x4){0.f, 0.f, 0.f, 0.f}; af[d] = acc[d]; ab[d] = acc[d]; }
#pragma unroll
    for (int ks = 0; ks < 4; ++ks) { const bf16x8 pf = *(LAS bf16x8*)(Ps + i * PS + (32 * ks + 8 * g) * 2); bf16x8 vf[8];
#pragma unroll
        for (int d = 0; d < 8; ++d) vf[d] = tr_frag(Vs, VS, 32 * ks, 16 * d, lane);
#pragma unroll
        for (int d = 0; d < 8; ++d) acc[d] = RET_MFMA(vf[d], pf, acc[d]); }
#pragma unroll
    for (int ks = 0; ks < 2; ++ks) { bf16x8 sf[8], sb[8];
#pragma unroll
        for (int d = 0; d < 8; ++d) { const int off = (16 * d + li) * KS + (32 * ks + 8 * g) * 2; sf[d] = *(LAS bf16x8*)(Ss + off); sb[d] = *(LAS bf16x8*)(Ss + 128 * KS + off); }
#pragma unroll
        for (int d = 0; d < 8; ++d) { af[d] = RET_MFMA(sf[d], qa[ks], af[d]); ab[d] = RET_MFMA(sb[d], qa[ks], ab[d]); } }
    const float xf = __expf(lgf * (float)(i + 1)), xb = __expf(lgb * (float)(128 - i));
    float s1 = 0.f;
#pragma unroll
    for (int d = 0; d < 8; ++d) { acc[d] = acc[d] + xf * af[d] + xb * ab[d]; s1 += (acc[d][0] + acc[d][1]) + (acc[d][2] + acc[d][3]); }
    s1 += __shfl_xor(s1, 16); s1 += __shfl_xor(s1, 32);
    const float mu = s1 * (1.f / 128.f); float s2 = 0.f;
#pragma unroll
    for (int d = 0; d < 8; ++d) { acc[d] = acc[d] - mu; s2 += (acc[d][0] * acc[d][0] + acc[d][1] * acc[d][1]) + (acc[d][2] * acc[d][2] + acc[d][3] * acc[d][3]); }
    s2 += __shfl_xor(s2, 16); s2 += __shfl_xor(s2, 32);
    const float rs = rsqrtf(s2 * (1.f / 128.f) + EPS);
#pragma unroll
    for (int d = 0; d < 8; ++d) { const int c0 = h * 128 + 16 * d + 4 * g; const f32x4 gg = *(const f32x4*)(gn_g + c0), bb = *(const f32x4*)(gn_b + c0); const u32x2 gr = greg[d];
        const float r0 = __uint_as_float(gr.x << 16), r1 = __uint_as_float(gr.x & 0xffff0000u), r2 = __uint_as_float(gr.y << 16), r3 = __uint_as_float(gr.y & 0xffff0000u);
        u32x2 o; o.x = pk2((acc[d][0] * rs * gg[0] + bb[0]) * silu_f(r0), (acc[d][1] * rs * gg[1] + bb[1]) * silu_f(r1));
        o.y = pk2((acc[d][2] * rs * gg[2] + bb[2]) * silu_f(r2), (acc[d][3] * rs * gg[3] + bb[3]) * silu_f(r3));
        st8_sel(MIX + (size_t)t * 1024 + 512 + c0, o, (WT_MASK & 8) != 0); }
    __syncthreads();
}
#undef RET_MFMA
}
#ifndef FUSE67_WT
#define FUSE67_WT false
#endif
constexpr int N_PHASES = 11;
struct Args { const float* in[24]; float* out; unsigned char* ws; int ph_lo, ph_hi, flags, pad; };
__global__ void __launch_bounds__(NTHREADS, 2) mega_fwd(Args args) {
    extern __shared__ __attribute__((aligned(16))) unsigned char lds[];
    Frame F;
    F.lds = (LAS unsigned char*)lds; F.MISC = (volatile LAS unsigned*)(F.lds + MISC_OFF);
    F.tid = threadIdx.x; F.lane = F.tid & 63; F.wave = __builtin_amdgcn_readfirstlane(F.tid >> 6);
    F.G = gridDim.x; { const int bx = blockIdx.x; F.vcu = (F.G % 8 == 0) ? (bx % 8) * (F.G / 8) + bx / 8 : bx; }
    unsigned char* ws = args.ws; const float* const* in = args.in;
    F.ctl = (unsigned*)(ws + WS_CTL);
    float* MOD = (float*)(ws + WS_MOD); float* ROPE = (float*)(ws + WS_ROPE);
    int* EID = (int*)(ws + WS_EID); float* RW = (float*)(ws + WS_RW); int* LIST = (int*)(ws + WS_LIST); int* CNT = (int*)(ws + WS_CTL) + CW_CNT;
    bf16 *Wi = (bf16*)(ws + WS_WI), *Wo = (bf16*)(ws + WS_WO), *Wgu = (bf16*)(ws + WS_WGU), *Wd = (bf16*)(ws + WS_WD);
    bf16 *HX = (bf16*)(ws + WS_HX), *MIX = (bf16*)(ws + WS_MIX), *H2 = (bf16*)(ws + WS_H2), *Q = (bf16*)(ws + WS_Q), *K = (bf16*)(ws + WS_K), *V = (bf16*)(ws + WS_V);
    bf16 *QR = (bf16*)(ws + WS_QR), *KR = (bf16*)(ws + WS_KR), *VR = (bf16*)(ws + WS_VR), *GR = (bf16*)(ws + WS_GR), *SP = (bf16*)(ws + WS_SP), *ACT = (bf16*)(ws + WS_ACT), *Y = (bf16*)(ws + WS_Y);
    float* U = (float*)(ws + WS_U); bf16* XN = (bf16*)(ws + WS_XNB);
    for (int u = F.tid; u < (LDS_BYTES - LDSCTL_OFF) / 4; u += NTHREADS) ((LAS unsigned*)(F.lds + LDSCTL_OFF))[u] = 0u;
    __syncthreads();
#ifdef DIAG_STOP
    const int lo = args.ph_lo, hi = (args.ph_hi < DIAG_STOP ? args.ph_hi : DIAG_STOP);
#else
    const int lo = args.ph_lo, hi = args.ph_hi;
#endif
    XcdBarrier bar; bar.bar = (unsigned*)F.ctl + CW_BAR; bar.x = 0; bar.st = nullptr;
    if (hi - lo > 1) bar = xcd_barrier_post((unsigned*)F.ctl + CW_BAR, F.MISC + 8);
#define IN(k) (lo <= (k) && (k) < hi)
#ifndef PROBE_PHASE
#define PROBE_PHASE -1
#endif
#define PH(k, ...) do { if (IN(k)) { { __VA_ARGS__ } if (PROBE_PHASE == (k) || PROBE_PHASE == -2) { __syncthreads(); { __VA_ARGS__ } } } } while (0)
#define REFRESH() do { F.lane = fresh_lane(); F.tid = F.wave * 64 + F.lane; } while (0)
#define SEAM(k) do { if (IN(k) && IN((k) + 1)) { xcd_barrier(bar, F.wave == 0 && fresh_lane() == 0); } REFRESH(); } while (0)
    const int gw = F.vcu * NWAVES + F.wave, NGW = F.G * NWAVES;
    REFRESH();

#ifdef DIAG_FLAG
    if (IN(0)) { int* FLAG = (int*)(ws + WS_EID + 512 * 1024); for (int i = F.vcu * NTHREADS + F.tid; i < 2 * SEQ; i += F.G * NTHREADS) FLAG[i] = 0; }
#endif
#ifdef DIAG_CK
#define CKBUF(ptr, n16) do { const u32x4* cp_ = (const u32x4*)(ptr); unsigned cx_ = 0; \
        for (size_t q_ = (size_t)F.vcu * NTHREADS + F.tid; q_ < (size_t)(n16); q_ += (size_t)F.G * NTHREADS) { const u32x4 w_ = cp_[q_]; const unsigned k_ = (unsigned)(q_ * 2654435761ull) | 1u; \
            cx_ ^= (w_.x * k_) ^ (w_.y * (k_ + 2u)) ^ (w_.z * (k_ + 4u)) ^ (w_.w * (k_ + 6u)); } \
        _Pragma("unroll") for (int o_ = 1; o_ < 64; o_ <<= 1) cx_ ^= (unsigned)__shfl_xor((int)cx_, o_); \
        if (F.lane == 0) atomicXor((unsigned*)(CNT) + 64, cx_); } while (0)
#else
#define CKBUF(ptr, n16) do {} while (0)
#endif
    PH(0,  const P0Args a{(unsigned*)F.ctl + CW_MODCNT, in[1], in[3], in[4], in[5], in[7], in[14], in[20], in[21], in[22], in[16], in[18], MOD, ROPE, (float*)(ws + WS_RTW), Wi, Wo, Wgu, Wd}; p0_prologue(F, a); );
    REFRESH();
#ifdef PROBE_BAR
    if (hi - lo > 1) { for (int q = 0; q < PROBE_BAR; ++q) xcd_barrier(bar, F.wave == 0 && fresh_lane() == 0); }
#endif
    PH(1,  wait_ge((unsigned*)F.ctl + CW_MODCNT, 192u, F.tid == 0, (unsigned*)F.ctl + CW_TMO); { int r = gw; for (; r + 3 * NGW < NKV; r += 4 * NGW) { const int rows[4] = {r, r + NGW, r + 2 * NGW, r + 3 * NGW}; norm1_rows<4>(rows, F.lane, in[0], in[2], in[6], MOD, HX); }
            for (; r < NKV; r += NGW) { const int rows[1] = {r}; norm1_rows<1>(rows, F.lane, in[0], in[2], in[6], MOD, HX); } } );
    SEAM(1);
#if defined(DIAG_CK) && DIAG_CK == 4
    CKBUF(HX, (size_t)NKV * DM / 8);
#endif
#if defined(DIAG_CK) && DIAG_CK == 7
    CKBUF(Wi, (size_t)NPROJ * DM / 8); CKBUF(MOD, 12288 / 4); CKBUF(ROPE, 8192 / 4);
#endif
    PH(2,
        pg8::Gemm g{HX, Wi, NKV, NPROJ, DM}; pg8::StaticOrder S; S.init(NKV, NPROJ, F.G, (int)blockIdx.x);
        pg8::EpiInProj E{Q, K, V, QR, KR, VR, GR, in[8], in[9], ROPE}; pg8::AMapDirect AM;
        pg8::gemm_phase<pg8::EpiInProj, pg8::StaticOrder, pg8::AMapDirect, true, true>(F.lds + RING_OFF, g, S, E, AM, F.tid);
        {
          const int nun = (NKV / 256) * (NPROJ / 256), maxu = (nun + F.G - 1) / F.G, first_idle = nun - (maxu - 1) * F.G, bx = (int)blockIdx.x;
          const P0Args a{(unsigned*)F.ctl + CW_MODCNT, in[1], in[3], in[4], in[5], in[7], in[14], in[20], in[21], in[22], in[16], in[18], MOD, ROPE, (float*)(ws + WS_RTW), Wi, Wo, Wgu, Wd};
          if (maxu >= 2 && first_idle < F.G) { if (bx >= first_idle) { REFRESH(); convert_items(F, a, P0_ITEMS, CV_ITEMS, (bx - first_idle) * NWAVES + F.wave, (F.G - first_idle) * NWAVES); } }
          else { REFRESH(); convert_items(F, a, P0_ITEMS, CV_ITEMS, F.vcu * NWAVES + F.wave, F.G * NWAVES); } }
    );
    SEAM(2);
#if defined(DIAG_CK) && DIAG_CK == 3
    CKBUF(Q, (size_t)SEQ * 512 / 8); CKBUF(K, (size_t)2 * NKV * 64 / 8); CKBUF(V, (size_t)2 * NKV * 64 / 8);
#endif
#if defined(DIAG_CK) && DIAG_CK == 5
    CKBUF(QR, (size_t)4 * SEQ * 64 / 8); CKBUF(KR, (size_t)4 * NKV * 64 / 8); CKBUF(VR, (size_t)4 * NKV * 128 / 8); CKBUF(GR, (size_t)SEQ * 512 / 8);
#endif
    if (IN(5)) {
        unsigned* r1cnt = (unsigned*)F.ctl + CW_R1CNT; unsigned* sccnt = (unsigned*)F.ctl + CW_SCANCNT; unsigned* tmo = (unsigned*)F.ctl + CW_TMO;
        const bool do_att = (args.flags & 1) != 0, do_ret = (args.flags & 2) != 0;
        const int ah = (F.G == 256) ? (((F.vcu >> 5) & 1) * 4 + (F.vcu >> 6)) : 0, ac = F.vcu & 31;
        for (int rep = 0; rep < ((PROBE_PHASE == 5 || PROBE_PHASE == 3 || PROBE_PHASE == -2) ? 2 : 1); ++rep) {
        const bool att = do_att && (rep == 0 || PROBE_PHASE != 3), retp = do_ret && (rep == 0 || PROBE_PHASE != 5);
        if (retp) { for (int q = 0; q < (PROBE_PHASE == 31 ? 2 : 1); ++q) for (int u = F.vcu; u < 4 * ret::NCH; u += F.G) { const int h = u & 3, j = u >> 2; ret::r1_unit(F, h, j, KR, VR, lsig(in[10][h]), lsig(in[11][h]), U); }
            if (rep == 0) { if (RET_WT) publish_add_wt(r1cnt, F.tid == 0); else publish_add(r1cnt, F.tid == 0); } }
        if (att) { if (F.G == 256) { attn_body::attn_unit<8>(ah, ac, Q, K, V, MIX, (char*)lds + RING_OFF, F.tid); }
                   else { for (int u = F.vcu; u < 512; u += 2 * F.G) attn_body::attn_unit<8>(u >> 6, u & 63, Q, K, V, MIX, (char*)lds + RING_OFF, F.tid); } }
        REFRESH();
        if (retp) { wait_ge(r1cnt, (unsigned)F.G, F.tid == 0, tmo, !(RET_WT && (NOACQ_MASK & 1)));
            for (int q = 0; q < (PROBE_PHASE == 32 ? 2 : 1); ++q) for (int b = F.vcu; b < 256; b += F.G) ret::r2_scan_block(F, b, U, in[10], in[11], SP);
            if (rep == 0) { if (RET_WT) publish_add_wt(sccnt, F.tid == 0); else publish_add(sccnt, F.tid == 0); } }
        if (att) { if (F.G == 256) { attn_body::attn_unit<8>(ah, ac + 32, Q, K, V, MIX, (char*)lds + RING_OFF, F.tid); }
                   else { for (int u = F.vcu + F.G; u < 512; u += 2 * F.G) attn_body::attn_unit<8>(u >> 6, u & 63, Q, K, V, MIX, (char*)lds + RING_OFF, F.tid); } }
        REFRESH();
        if (retp) { wait_ge(sccnt, (unsigned)F.G, F.tid == 0, tmo, !(RET_WT && (NOACQ_MASK & 2)));
            for (int q = 0; q < (PROBE_PHASE == 33 ? 2 : 1); ++q) { ret::R3Regs R3; if (F.vcu < 512) ret::r3_load(R3, F.wave, fresh_lane(), F.vcu & 3, F.vcu >> 2, QR, KR, VR, SP);
              for (int u = F.vcu; u < 512; u += F.G) { const int h = u & 3, n = u >> 2, un = u + F.G; ret::r3_unit(F, R3, h, n, un < 512 ? (un & 3) : -1, un >> 2, QR, KR, VR, GR, SP, lsig(in[10][h]), lsig(in[11][h]), in[12], in[13], MIX); } } }
        }
    }
    SEAM(5);
#if defined(DIAG_CK) && DIAG_CK == 2
    CKBUF(MIX, (size_t)SEQ * DM / 8);
#endif
#if defined(DIAG_CK) && (DIAG_CK == 8 || DIAG_CK == 9)
    { const u32x4* cp_ = (const u32x4*)MIX; unsigned cx_ = 0;
      for (size_t q_ = (size_t)F.vcu * NTHREADS + F.tid; q_ < (size_t)SEQ * DM / 8; q_ += (size_t)F.G * NTHREADS) { if ((((q_ & 127) < 64) ? 8 : 9) != DIAG_CK) continue; const u32x4 w_ = cp_[q_]; const unsigned k_ = (unsigned)(q_ * 2654435761ull) | 1u;
          cx_ ^= (w_.x * k_) ^ (w_.y * (k_ + 2u)) ^ (w_.z * (k_ + 4u)) ^ (w_.w * (k_ + 6u)); }
#pragma unroll
      for (int o_ = 1; o_ < 64; o_ <<= 1) cx_ ^= (unsigned)__shfl_xor((int)cx_, o_);
      if (F.lane == 0) atomicXor((unsigned*)(CNT) + 64, cx_); }
#endif
#if defined(DIAG_CK) && DIAG_CK == 6
    CKBUF(SP, (size_t)4 * 128 * 2 * 8192 / 8); CKBUF(U, (size_t)4 * 130 * 2 * 8192 / 4);
#endif
    const bool fuse67 = IN(6) && IN(7) && F.G == 256 && PROBE_PHASE != 6 && PROBE_PHASE != -2;
    if (PROBE_PHASE == 66 && IN(6)) { pg8::Gemm g{MIX, Wo, SEQ, DM, DM}; pg8::StaticOrder S; S.init(SEQ, DM, F.G, (int)blockIdx.x); pg8::EpiOutProj<false> E{in[0], MOD + 2048, XN}; pg8::AMapDirect AM;
        pg8::gemm_phase<pg8::EpiOutProj<false>, pg8::StaticOrder, pg8::AMapDirect, true, true>(F.lds + RING_OFF, g, S, E, AM, F.tid); REFRESH(); }
    if (fuse67) {
        pg8::Gemm g{MIX, Wo, SEQ, DM, DM}; pg8::StaticOrder S; S.init(SEQ, DM, F.G, (int)blockIdx.x);
        pg8::EpiOutProj<FUSE67_WT> E{in[0], MOD + 2048, XN}; pg8::AMapDirect AM;
        pg8::gemm_phase<pg8::EpiOutProj<FUSE67_WT>, pg8::StaticOrder, pg8::AMapDirect, true, true>(F.lds + RING_OFF, g, S, E, AM, F.tid);
    } else {
    PH(6,
        pg8::Gemm g{MIX, Wo, SEQ, DM, DM}; pg8::StaticOrder S; S.init(SEQ, DM, F.G, (int)blockIdx.x);
        pg8::EpiOutProj<false> E{in[0], MOD + 2048, XN}; pg8::AMapDirect AM;
        pg8::gemm_phase<pg8::EpiOutProj<false>, pg8::StaticOrder, pg8::AMapDirect, true, true>(F.lds + RING_OFF, g, S, E, AM, F.tid);
    );
    }
    if (fuse67) {
        pg8::StaticOrder S; S.init(SEQ, DM, F.G, (int)blockIdx.x); pg8::Unit u; (void)S.next(0, u);
        unsigned* pc = (unsigned*)F.ctl + CW_PANEL + 64 * u.pm;
        REFRESH();
        if (FUSE67_WT) publish_add_wt(pc, F.tid == 0); else publish_add(pc, F.tid == 0);
        route_stage_weights(F, (const float*)(ws + WS_RTW));
        wait_ge(pc, 4u, F.tid == 0, (unsigned*)F.ctl + CW_TMO, !(FUSE67_WT && (NOACQ_MASK & 4)));
        { const int tb = u.pm * 256 + u.pn * 64 + F.wave * 8; RouteOut ro[8];
          f32x4 gms[2][4];
#pragma unroll
          for (int j = 0; j < 4; ++j) { const int n = 4 * F.lane + 256 * j; const f32x4 g = *(const f32x4*)(in[15] + n), sc = *(const f32x4*)(MOD + 4096 + n); gms[0][j] = g * (sc + 1.f); gms[1][j] = *(const f32x4*)(MOD + 3072 + n); }
          f32x4 xa[4], xb[4]; route_load_row(tb, F.lane, XN, xa);
#pragma unroll
          for (int k = 0; k < 8; k += 2) { route_load_row(tb + k + 1, F.lane, XN, xb); route_row_pre<2>(F, tb + k, xa, in[15], MOD, in[17], in[19], H2, EID, RW, CNT, LIST, &ro[k], nullptr, gms);
              if (k + 2 < 8) route_load_row(tb + k + 2, F.lane, XN, xa); route_row_pre<2>(F, tb + k + 1, xb, in[15], MOD, in[17], in[19], H2, EID, RW, CNT, LIST, &ro[k + 1], nullptr, gms); }
          int ea = ro[0].ea, eb = ro[0].eb; float w1 = ro[0].w1, w2 = ro[0].w2;
#pragma unroll
          for (int k = 1; k < 8; ++k) if (F.lane == k) { ea = ro[k].ea; eb = ro[k].eb; w1 = ro[k].w1; w2 = ro[k].w2; }
          if (PROBE_PHASE == 77) {
#pragma unroll
              for (int k = 0; k < 8; ++k) { f32x4 xv[4]; route_load_row(tb + k, F.lane, XN, xv); route_row_pre<2>(F, tb + k, xv, in[15], MOD, in[17], in[19], H2, EID, RW, CNT, LIST, &ro[k]); } }
          if (F.lane < 8) { const int t = tb + F.lane; EID[2 * t] = ea; EID[2 * t + 1] = eb; RW[2 * t] = w1; RW[2 * t + 1] = w2;
              const int sa = atomicAdd(CNT + ea, 1), sb = atomicAdd(CNT + eb, 1);
              __hip_atomic_store(LIST + ea * SEQ + sa, 2 * t, __ATOMIC_RELAXED, __HIP_MEMORY_SCOPE_AGENT); __hip_atomic_store(LIST + eb * SEQ + sb, 2 * t + 1, __ATOMIC_RELAXED, __HIP_MEMORY_SCOPE_AGENT); } }
        __syncthreads();
    } else {
    SEAM(6);
    if (IN(7)) { route_stage_weights(F, (const float*)(ws + WS_RTW)); for (int t = gw; t < SEQ; t += NGW) route_row_lds<1>(F, t, XN, in[15], MOD, in[17], in[19], H2, EID, RW, CNT, LIST);
        if (PROBE_PHASE == 7 || PROBE_PHASE == -2) { for (int t = gw; t < SEQ; t += NGW) route_row_lds<0>(F, t, XN, in[15], MOD, in[17], in[19], H2, EID, RW, CNT, LIST); }
        __syncthreads(); }
    }
    SEAM(7);
#ifdef DIAG_THRASH
#define THRASH(src) do { const f32x4* tp = (const f32x4*)(src) + (size_t)F.vcu * 16384; f32x4 ts = {0.f, 0.f, 0.f, 0.f}; \
        for (int q = F.tid; q < 16384; q += NTHREADS) ts += tp[q]; \
        if (ts.x + ts.y + ts.z + ts.w == 12345.678f) ((float*)(ws + WS_CTL))[2000 + (F.tid & 7)] = ts.x; __syncthreads(); } while (0)
#else
#define THRASH(src) do {} while (0)
#endif
    THRASH(in[20]);
    const bool fuse89 = IN(8) && IN(9) && F.G == 256 && PROBE_PHASE != 8 && PROBE_PHASE != 9 && PROBE_PHASE != -2;
    if (fuse89) {
        moe_build_table(F, CNT);
        pg8::MoeTable mt{(const LAS int*)(F.lds + TT_OFF), LIST}; unsigned* tcnt = (unsigned*)F.ctl + CW_TILE;
        { pg8::Gemm g{H2, Wgu, 0, 0, DM}; pg8::MoeOrder1 S{mt, F.G, F.vcu, tcnt}; pg8::EpiSwiGLU<true> E{ACT}; pg8::AMapGather AM{mt};
          pg8::gemm_phase<pg8::EpiSwiGLU<true>, pg8::MoeOrder1, pg8::AMapGather, true, true>(F.lds + RING_OFF, g, S, E, AM, F.tid); }
        REFRESH();
        { pg8::Gemm g{ACT, Wd, 0, 0, DEXP}; pg8::MoeOrder2 S{mt, F.G, F.vcu, F.wave, tcnt, (unsigned*)F.ctl + CW_TMO}; pg8::EpiScatter E{mt, Y, (int*)(ws + WS_EID + 512 * 1024)}; pg8::AMapDirect AM;
          pg8::gemm_phase<pg8::EpiScatter, pg8::MoeOrder2, pg8::AMapDirect, true, true>(F.lds + RING_OFF, g, S, E, AM, F.tid); }
    } else {
    PH(8,
        moe_build_table(F, CNT);
        pg8::MoeTable mt{(const LAS int*)(F.lds + TT_OFF), LIST};
        pg8::Gemm g{H2, Wgu, 0, 0, DM}; pg8::MoeOrder S{mt, F.G, F.vcu}; pg8::EpiSwiGLU<false> E{ACT}; pg8::AMapGather AM{mt};
        pg8::gemm_phase<pg8::EpiSwiGLU<false>, pg8::MoeOrder, pg8::AMapGather, true, true>(F.lds + RING_OFF, g, S, E, AM, F.tid);
    );
    SEAM(8);
    THRASH(in[21]);
    PH(9,
        moe_build_table(F, CNT);
        pg8::MoeTable mt{(const LAS int*)(F.lds + TT_OFF), LIST};
        pg8::Gemm g{ACT, Wd, 0, 0, DEXP}; pg8::MoeOrder S{mt, F.G, F.vcu}; pg8::EpiScatter E{mt, Y, (int*)(ws + WS_EID + 512 * 1024)}; pg8::AMapDirect AM;
        pg8::gemm_phase<pg8::EpiScatter, pg8::MoeOrder, pg8::AMapDirect, true, true>(F.lds + RING_OFF, g, S, E, AM, F.tid);
    );
    }
    SEAM(9);
    THRASH(in[22]);
#ifdef DIAG_CK
    float diag_scale = 1.f;
    if (IN(10)) { const unsigned cur = __hip_atomic_load((unsigned*)(CNT) + 64, __ATOMIC_RELAXED, __HIP_MEMORY_SCOPE_AGENT); unsigned* prev = (unsigned*)(ws + 264 * MiB);
        const unsigned p0 = __hip_atomic_load(prev, __ATOMIC_RELAXED, __HIP_MEMORY_SCOPE_AGENT), p1 = __hip_atomic_load(prev + 1, __ATOMIC_RELAXED, __HIP_MEMORY_SCOPE_AGENT);
        if (p1 == (p0 ^ 0x5a5a1234u) && p0 != cur) diag_scale = 3.f; }
#endif
#ifdef DIAG_FLAG
    if (IN(10)) { const int* FLAG = (const int*)(ws + WS_EID + 512 * 1024); for (int t = gw; t < SEQ; t += NGW) { if (FLAG[2 * t] != 1 || FLAG[2 * t + 1] != 1) { const float qn = __builtin_nanf(""); for (int i = F.lane; i < DM; i += 64) Y[(size_t)t * DM + i] = 0x7fc0; (void)qn; } } }
#endif
    if (IN(10)) { if (PROBE_PHASE == 10 || PROBE_PHASE == -2) { for (int t = gw; t < SEQ; t += NGW) final_row(t, F.lane, XN, Y, RW, MOD, in[23], (float*)(ws + WS_HX)); }
        { int t = gw; for (; t + 3 * NGW < SEQ; t += 4 * NGW) { const int rows[4] = {t, t + NGW, t + 2 * NGW, t + 3 * NGW}; final_rows<4>(rows, F.lane, XN, Y, RW, MOD, in[23], args.out); }
          for (; t < SEQ; t += NGW) final_row(t, F.lane, XN, Y, RW, MOD, in[23], args.out); } }
#ifdef DIAG_CK
    if (IN(10)) { __syncthreads(); if (diag_scale != 1.f) { for (int t = gw; t < SEQ; t += NGW) for (int i = F.lane; i < DM; i += 64) args.out[(size_t)t * DM + i] *= diag_scale; }
        if (blockIdx.x == 0 && F.tid == 0) { const unsigned cur = __hip_atomic_load((unsigned*)(CNT) + 64, __ATOMIC_RELAXED, __HIP_MEMORY_SCOPE_AGENT); unsigned* prev = (unsigned*)(ws + 264 * MiB);
            __hip_atomic_store(prev, cur, __ATOMIC_RELAXED, __HIP_MEMORY_SCOPE_AGENT); __hip_atomic_store(prev + 1, cur ^ 0x5a5a1234u, __ATOMIC_RELAXED, __HIP_MEMORY_SCOPE_AGENT); } }
#endif
    if (PROBE_PHASE == 108 || PROBE_PHASE == 109) { xcd_barrier(bar, F.wave == 0 && fresh_lane() == 0); REFRESH();
        moe_build_table(F, CNT); pg8::MoeTable mt{(const LAS int*)(F.lds + TT_OFF), LIST}; pg8::MoeOrder S{mt, F.G, F.vcu};
        if (PROBE_PHASE == 108) { pg8::Gemm g{H2, Wgu, 0, 0, DM}; pg8::EpiSwiGLU<false> E{ACT}; pg8::AMapGather AM{mt};
            pg8::gemm_phase<pg8::EpiSwiGLU<false>, pg8::MoeOrder, pg8::AMapGather, true, true>(F.lds + RING_OFF, g, S, E, AM, F.tid); }
        else { pg8::Gemm g{ACT, Wd, 0, 0, DEXP}; pg8::EpiScatter E{mt, Y, (int*)(ws + WS_EID + 512 * 1024)}; pg8::AMapDirect AM;
            pg8::gemm_phase<pg8::EpiScatter, pg8::MoeOrder, pg8::AMapDirect, true, true>(F.lds + RING_OFF, g, S, E, AM, F.tid); } }
    if (PROBE_PHASE == 100) { REFRESH(); const P0Args a{(unsigned*)F.ctl + CW_MODCNT, in[1], in[3], in[4], in[5], in[7], in[14], in[20], in[21], in[22], in[16], in[18], MOD, ROPE, (float*)(ws + WS_RTW), Wi, Wo, Wgu, Wd}; p0_prologue(F, a); }
#undef IN
#undef SEAM
}

#ifndef FAST_MASK
#define FAST_MASK 0xff
#endif
#ifndef ONE_LAUNCH
#define ONE_LAUNCH 0
#endif
static int g_grid = 0;
static void launch_fast(Args a, int lo, int hi, int flags, hipStream_t stream) {
    a.ph_lo = lo; a.ph_hi = hi; a.flags = flags; a.pad = 0;
    hipLaunchKernelGGL(mega_fwd, dim3(g_grid), dim3(NTHREADS), LDS_BYTES, stream, a);
}
extern "C" void kernel_launch(void* const* d_in, const int* in_sizes, int n_in, void* d_out, int out_size, void* d_ws, size_t ws_size, hipStream_t stream) {
    if (n_in != 24 || out_size != SEQ * DM || ws_size < WS_END) { fprintf(stderr, "kernel_launch: unexpected shapes / workspace (%d inputs, out %d, ws %zu < %zu)\n", n_in, out_size, ws_size, (size_t)WS_END); return; }
    if (g_grid == 0) {
        int dev = 0, cus = 0;
        if (hipGetDevice(&dev) != hipSuccess || hipDeviceGetAttribute(&cus, hipDeviceAttributeMultiprocessorCount, dev) != hipSuccess) { g_grid = -1; return; }
        if (hipFuncSetAttribute((const void*)mega_fwd, hipFuncAttributeMaxDynamicSharedMemorySize, LDS_BYTES) != hipSuccess) { g_grid = -1; return; }
        int per_cu = 0; (void)hipOccupancyMaxActiveBlocksPerMultiprocessor(&per_cu, (const void*)mega_fwd, NTHREADS, LDS_BYTES); (void)hipGetLastError();
        g_grid = cus;
    }
    if (g_grid < 0) return;
    const float* const* in = (const float* const*)d_in;
    unsigned char* ws = (unsigned char*)d_ws; float* out = (float*)d_out;
    (void)hipMemsetAsync(ws + WS_CTL, 0, CTL_ZERO_BYTES, stream);
    Args a{}; for (int i = 0; i < 24; ++i) a.in[i] = in[i]; a.out = out; a.ws = ws;
#if ONE_LAUNCH
    launch_fast(a, 0, N_PHASES, 3, stream);
#ifdef DIAG_2LAUNCH
    (void)hipMemsetAsync(ws + WS_CTL, 0, CTL_ZERO_BYTES, stream); launch_fast(a, 0, N_PHASES, 3, stream);
#endif
#ifdef DIAG_RERUN_LO
    (void)hipMemsetAsync(ws + WS_CTL + 4 * CW_MODCNT, 0, CTL_ZERO_BYTES - 4 * CW_MODCNT, stream); launch_fast(a, DIAG_RERUN_LO, DIAG_RERUN_HI, DIAG_RERUN_FLAGS, stream);
#endif
#else
    float* MOD = (float*)(ws + WS_MOD); float* ROPE = (float*)(ws + WS_ROPE);
    int* EID = (int*)(ws + WS_EID); float* RW = (float*)(ws + WS_RW); int* LIST = (int*)(ws + WS_LIST); int* CNT = (int*)(ws + WS_CTL) + CW_CNT;
    bf16 *HX = (bf16*)(ws + WS_HX), *MIX = (bf16*)(ws + WS_MIX), *H2 = (bf16*)(ws + WS_H2), *Q = (bf16*)(ws + WS_Q), *K = (bf16*)(ws + WS_K), *V = (bf16*)(ws + WS_V);
    bf16 *QR = (bf16*)(ws + WS_QR), *KR = (bf16*)(ws + WS_KR), *VR = (bf16*)(ws + WS_VR), *GR = (bf16*)(ws + WS_GR), *Y = (bf16*)(ws + WS_Y);
    (void)EID; (void)RW; (void)LIST; (void)CNT; (void)H2; (void)Y;
    const int FM = FAST_MASK;
    if (FM & 1) launch_fast(a, 0, 1, 0, stream);
    if (!(FM & 1)) { nv::k_mod<<<dim3(24, 2), 256, 0, stream>>>(in[1], in[3], in[4], in[5], MOD); nv::k_rope<<<16, 256, 0, stream>>>(ROPE); }
    if (FM & 2) launch_fast(a, 1, 2, 0, stream); else nv::k_norm1<<<NKV, 256, 0, stream>>>(in[0], in[2], in[6], MOD, HX);
#ifdef DUP_P2
    launch_fast(a, 2, 3, 0, stream);
#endif
    if (FM & 4) launch_fast(a, 2, 3, 0, stream); else nv::k_inproj<<<dim3(36, NKV / 64), 256, 0, stream>>>(HX, in[7], in[8], in[9], ROPE, Q, K, V, QR, KR, VR, GR);
    if (FM & 8) { launch_fast(a, 3, 4, 0, stream); launch_fast(a, 4, 5, 0, stream); launch_fast(a, 5, 6, 2, stream);
#ifdef DUP_R3
    launch_fast(a, 5, 6, 2, stream);
#endif
    }
    else nv::k_ret<<<dim3(SEQ / 128, 4), 256, 0, stream>>>(QR, KR, VR, GR, in[10], in[11], in[12], in[13], MIX);
    if (FM & 16) launch_fast(a, 5, 6, 1, stream); else nv::k_attn<<<dim3(SEQ / 256, 8), 256, 0, stream>>>(Q, K, V, MIX);
    if (FM & 32) launch_fast(a, 6, 7, 0, stream); else nv::k_outproj<<<dim3(16, SEQ / 64), 256, 0, stream>>>(MIX, in[14], in[0], MOD, out);
    launch_fast(a, 7, 8, 0, stream);
    if (FM & 64) { launch_fast(a, 8, 9, 0, stream); launch_fast(a, 9, 10, 0, stream); }
    else nv::k_moe<<<dim3(SEQ / 8, NEXP), 256, 0, stream>>>(H2, CNT, LIST, in[20], in[21], in[22], Y);
    launch_fast(a, 10, 11, 0, stream);
#endif
}
```

```cpp
#define ONE_LAUNCH 1
#define FILL_ITEMS 16384
#define NT_POLICY 1
#define FUSE67_WT true
#define RET_WT 1
#define MOE_NOACQ 1
#define ACT_ST16 1
#define NOACQ_MASK 7
#define WSUM_DPP 1
#define WT_MASK 7
#define ROWS_SWAP 1
#define P0_EXTRA 768
#include <hip/hip_runtime.h>
#include <cstdio>
#include <cstdint>
#include <cmath>

constexpr int DM = 1024, SEQ = 16384, CL = 256, NKV = SEQ + CL  , GRIDW = 64, NPROJ = 2304;
constexpr int NEXP = 32, DEXP = 512;
constexpr float EPS = 1e-6f;
constexpr float QSCALE = 0.125f * 1.4426950408889634f;
typedef unsigned short bf16;
typedef float f32x4 __attribute__((ext_vector_type(4)));
typedef unsigned u32x4 __attribute__((ext_vector_type(4)));
typedef unsigned u32x2 __attribute__((ext_vector_type(2)));

__host__ __device__ __forceinline__ float bf2f(bf16 v) { union { unsigned u; float f; } c; c.u = ((unsigned)v) << 16; return c.f; }
__host__ __device__ __forceinline__ bf16 f2bf(float f) { union { unsigned u; float f; } c; c.f = f; return (bf16)((c.u + 0x7fffu + ((c.u >> 16) & 1u)) >> 16); }
__device__ __forceinline__ unsigned pk2(float lo, float hi) { unsigned r; asm("v_cvt_pk_bf16_f32 %0, %1, %2" : "=v"(r) : "v"(lo), "v"(hi)); return r; }
#ifndef WSUM_DPP
#define WSUM_DPP 0
#endif
__device__ __forceinline__ float dpp_add_(float v, const int ctrl_sel) {
    int r; const int iv = __float_as_int(v);
    switch (ctrl_sel) { case 0: r = __builtin_amdgcn_update_dpp(iv, iv, 0xB1, 0xF, 0xF, false); break;
                        case 1: r = __builtin_amdgcn_update_dpp(iv, iv, 0x4E, 0xF, 0xF, false); break;
                        case 2: r = __builtin_amdgcn_update_dpp(iv, iv, 0x141, 0xF, 0xF, false); break;
                        default: r = __builtin_amdgcn_update_dpp(iv, iv, 0x140, 0xF, 0xF, false); break; }
    return v + __int_as_float(r);
}
__device__ __forceinline__ float rows_sum(float v) {
#if WSUM_DPP
    { auto rr = __builtin_amdgcn_permlane16_swap(__float_as_uint(v), __float_as_uint(v), false, false); v = __uint_as_float(rr[0]) + __uint_as_float(rr[1]); }
    { auto rr = __builtin_amdgcn_permlane32_swap(__float_as_uint(v), __float_as_uint(v), false, false); v = __uint_as_float(rr[0]) + __uint_as_float(rr[1]); }
    return v;
#else
    v += __shfl_xor(v, 16); v += __shfl_xor(v, 32); return v;
#endif
}
__device__ __forceinline__ float wave_sum(float v) {
#if WSUM_DPP
    v = dpp_add_(v, 0); v = dpp_add_(v, 1); v = dpp_add_(v, 2); v = dpp_add_(v, 3);
    { auto rr = __builtin_amdgcn_permlane16_swap(__float_as_uint(v), __float_as_uint(v), false, false); v = __uint_as_float(rr[0]) + __uint_as_float(rr[1]); }
    { auto rr = __builtin_amdgcn_permlane32_swap(__float_as_uint(v), __float_as_uint(v), false, false); v = __uint_as_float(rr[0]) + __uint_as_float(rr[1]); }
    return v;
#else
#pragma unroll
    for (int o = 1; o < 64; o <<= 1) v += __shfl_xor(v, o);
    return v;
#endif
}

#ifdef NT_POLICY
#define NT_LD(p) __builtin_nontemporal_load(p)
#define NT_ST(v, p) __builtin_nontemporal_store(v, p)
#else
#define NT_LD(p) (*(p))
#define NT_ST(v, p) (*(p) = (v))
#endif
#ifndef WT_MASK
#define WT_MASK 0
#endif
__device__ __forceinline__ void st16_sel(void* p, u32x4 v, bool wt) { if (wt) asm volatile("global_store_dwordx4 %0, %1, off sc1\n\ts_nop 1" :: "v"(p), "v"(v) : "memory"); else *(u32x4*)p = v; }
#define ATTN_STORE16(p, v) st16_sel((p), (v), (WT_MASK & 4) != 0)
__device__ __forceinline__ void st8_sel(void* p, u32x2 v, bool wt) { if (wt) asm volatile("global_store_dwordx2 %0, %1, off sc1\n\ts_nop 1" :: "v"(p), "v"(v) : "memory"); else *(u32x2*)p = v; }

__device__ __forceinline__ int fresh_lane() { int l; asm volatile("v_mbcnt_lo_u32_b32 %0, -1, 0\n\tv_mbcnt_hi_u32_b32 %0, -1, %0" : "=v"(l)); return l; }

constexpr size_t MiB = 1u << 20;
constexpr size_t WS_CTL = 0, CTL_ZERO_BYTES = 128 * 1024;
constexpr size_t WS_MOD = 1 * MiB;
constexpr size_t WS_ROPE = 1 * MiB + 64 * 1024;
constexpr size_t WS_RTW = 1 * MiB + 128 * 1024;
constexpr size_t WS_EID = 2 * MiB;
constexpr size_t WS_RW = 2 * MiB + 256 * 1024;
constexpr size_t WS_LIST = 3 * MiB;
constexpr size_t WS_WI = 6 * MiB;
constexpr size_t WS_WO = 11 * MiB;
constexpr size_t WS_WGU = 13 * MiB;
constexpr size_t WS_WD = 77 * MiB;
constexpr size_t WS_HX = 109 * MiB;
constexpr size_t WS_MIX = WS_HX, WS_H2 = WS_HX;
constexpr size_t WS_Q = 142 * MiB;
constexpr size_t WS_K = 158 * MiB;
constexpr size_t WS_V = WS_K + 4352 * 1024;
constexpr size_t WS_QR = WS_V + 4352 * 1024;
constexpr size_t WS_KR = WS_QR + 8 * MiB;
constexpr size_t WS_VR = WS_KR + 8448 * 1024;
constexpr size_t WS_GR = WS_VR + 16896 * 1024;
constexpr size_t WS_U = WS_GR + 16 * MiB;
constexpr size_t WS_SP = WS_U + 33280 * 1024;
constexpr size_t WS_C_END = WS_SP + 16 * MiB;
constexpr size_t WS_ACT = 142 * MiB;
constexpr size_t WS_Y = 182 * MiB;
constexpr size_t WS_XNB = 246 * MiB;
constexpr size_t WS_END = WS_XNB + 32 * MiB;
constexpr int CW_TMO = 0, CW_CODE = 1, CW_CNT = 1024  , CW_MODCNT = 2048, CW_R1CNT = 2112, CW_SCANCNT = 2176, CW_BAR = 4096, CW_PANEL = 8192  , CW_TILE = 16384  ;

__device__ __forceinline__ void route_row(int t, int lane, const float* XN, const float* g2, const float* MOD, const float* wgrp, const float* bgrp,
                                          const float* wexp, const float* bexp, bf16* H2, int* EID, float* RW, int* CNT, int* LIST) {
    const f32x4* xr = (const f32x4*)(XN + (size_t)t * DM) + lane;
    f32x4 v[4]; float ss = 0.f;
#pragma unroll
    for (int j = 0; j < 4; ++j) { v[j] = xr[64 * j]; ss += (v[j].x * v[j].x + v[j].y * v[j].y) + (v[j].z * v[j].z + v[j].w * v[j].w); }
    const float rstd = rsqrtf(wave_sum(ss) * (1.f / DM) + EPS);
    float gl[4] = {0.f, 0.f, 0.f, 0.f};
    float h[16];
#pragma unroll
    for (int j = 0; j < 4; ++j) {
        const int n = 4 * lane + 256 * j;
        const f32x4 g = *(const f32x4*)(g2 + n), sh = *(const f32x4*)(MOD + 3072 + n), sc = *(const f32x4*)(MOD + 4096 + n);
#pragma unroll
        for (int i = 0; i < 4; ++i) { const float hv = (v[j][i] * rstd) * g[i] * (1.f + sc[i]) + sh[i]; h[4 * j + i] = hv;
            const f32x4 w = *(const f32x4*)(wgrp + (size_t)(n + i) * 4); gl[0] += hv * w.x; gl[1] += hv * w.y; gl[2] += hv * w.z; gl[3] += hv * w.w; }
        u32x2 o; o.x = pk2(h[4 * j], h[4 * j + 1]); o.y = pk2(h[4 * j + 2], h[4 * j + 3]);
        *(u32x2*)(H2 + (size_t)t * DM + n) = o;
    }
#pragma unroll
    for (int c = 0; c < 4; ++c) gl[c] = wave_sum(gl[c]) + bgrp[c];
    int g = 0; float gm = gl[0];
#pragma unroll
    for (int c = 1; c < 4; ++c) if (gl[c] > gm) { gm = gl[c]; g = c; }
    float gs = 0.f;
#pragma unroll
    for (int c = 0; c < 4; ++c) gs += expf(gl[c] - gm);
    const float pg = 1.f / gs;
    float el[8] = {0.f, 0.f, 0.f, 0.f, 0.f, 0.f, 0.f, 0.f};
#pragma unroll
    for (int j = 0; j < 4; ++j)
#pragma unroll
        for (int i = 0; i < 4; ++i) { const int n = 4 * lane + 256 * j + i; const f32x4 w0 = *(const f32x4*)(wexp + (size_t)n * 32 + g * 8), w1 = *(const f32x4*)(wexp + (size_t)n * 32 + g * 8 + 4);
            const float hv = h[4 * j + i]; el[0] += hv * w0.x; el[1] += hv * w0.y; el[2] += hv * w0.z; el[3] += hv * w0.w; el[4] += hv * w1.x; el[5] += hv * w1.y; el[6] += hv * w1.z; el[7] += hv * w1.w; }
#pragma unroll
    for (int c = 0; c < 8; ++c) el[c] = wave_sum(el[c]) + bexp[g * 8 + c];
    int j1 = 0; float m1 = el[0];
#pragma unroll
    for (int c = 1; c < 8; ++c) if (el[c] > m1) { m1 = el[c]; j1 = c; }
    int j2 = -1; float m2 = -INFINITY;
#pragma unroll
    for (int c = 0; c < 8; ++c) if (c != j1 && el[c] > m2) { m2 = el[c]; j2 = c; }
    const float e2 = expf(m2 - m1), w1 = pg / (1.f + e2), w2 = pg * e2 / (1.f + e2);
    if (lane == 0) {
        const int ea = g * 8 + j1, eb = g * 8 + j2;
        EID[2 * t] = ea; EID[2 * t + 1] = eb; RW[2 * t] = w1; RW[2 * t + 1] = w2;
        const int sa = atomicAdd(CNT + ea, 1); LIST[ea * SEQ + sa] = 2 * t;
        const int sb = atomicAdd(CNT + eb, 1); LIST[eb * SEQ + sb] = 2 * t + 1;
    }
}
template <int NB> __device__ __forceinline__ void final_rows(const int (&rows)[NB], int lane, const bf16* XN, const bf16* Y, const float* RW, const float* MOD, const float* gfin, float* out, const f32x4 (*hv)[4] = nullptr) {
    f32x4 xv[NB][4]; u32x2 ya[NB][4], yb[NB][4]; float w0[NB], w1[NB];
#pragma unroll
    for (int b = 0; b < NB; ++b) { const int t = rows[b]; w0[b] = RW[2 * t]; w1[b] = RW[2 * t + 1];
#pragma unroll
        for (int j = 0; j < 4; ++j) { const int n = 4 * lane + 256 * j; { const u32x2 xw = NT_LD((const u32x2*)(XN + (size_t)t * DM + n)); xv[b][j] = (f32x4){__uint_as_float(xw.x << 16), __uint_as_float(xw.x & 0xffff0000u), __uint_as_float(xw.y << 16), __uint_as_float(xw.y & 0xffff0000u)}; }
            ya[b][j] = NT_LD((const u32x2*)(Y + (size_t)t * DM + n)); yb[b][j] = NT_LD((const u32x2*)(Y + ((size_t)SEQ + t) * DM + n)); } }
#pragma unroll
    for (int b = 0; b < NB; ++b) { const int t = rows[b]; f32x4 v[4]; float ss = 0.f;
#pragma unroll
        for (int j = 0; j < 4; ++j) { const int n = 4 * lane + 256 * j; const f32x4 gt = hv ? hv[0][j] : *(const f32x4*)(MOD + 5120 + n); const u32x2 a = ya[b][j], c = yb[b][j];
            const float fa[4] = {__uint_as_float(a.x << 16), __uint_as_float(a.x & 0xffff0000u), __uint_as_float(a.y << 16), __uint_as_float(a.y & 0xffff0000u)};
            const float fb[4] = {__uint_as_float(c.x << 16), __uint_as_float(c.x & 0xffff0000u), __uint_as_float(c.y << 16), __uint_as_float(c.y & 0xffff0000u)};
#pragma unroll
            for (int i = 0; i < 4; ++i) { v[j][i] = xv[b][j][i] + gt[i] * (fa[i] * w0[b] + fb[i] * w1[b]); ss += v[j][i] * v[j][i]; } }
        const float rstd = rsqrtf(wave_sum(ss) * (1.f / DM) + EPS);
#pragma unroll
        for (int j = 0; j < 4; ++j) { const int n = 4 * lane + 256 * j; const f32x4 g = hv ? hv[1][j] : *(const f32x4*)(gfin + n);
            f32x4 o; o.x = v[j].x * rstd * g.x; o.y = v[j].y * rstd * g.y; o.z = v[j].z * rstd * g.z; o.w = v[j].w * rstd * g.w;
            NT_ST(o, (f32x4*)(out + (size_t)t * DM + n)); } }
}
__device__ __forceinline__ void final_row(int t, int lane, const bf16* XN, const bf16* Y, const float* RW, const float* MOD, const float* gfin, float* out) {
    const int rows[1] = {t}; final_rows<1>(rows, lane, XN, Y, RW, MOD, gfin, out);
}
#ifdef WITH_NAIVE
__global__ void k_route(const float* XN, const float* g2, const float* MOD, const float* wgrp, const float* bgrp, const float* wexp, const float* bexp,
                        bf16* H2, int* EID, float* RW, int* CNT, int* LIST) {
    const int t = blockIdx.x * 4 + (threadIdx.x >> 6);
    route_row(t, threadIdx.x & 63, XN, g2, MOD, wgrp, bgrp, wexp, bexp, H2, EID, RW, CNT, LIST);
}
__global__ void k_final(const float* XN, const bf16* Y, const float* RW, const float* MOD, const float* gfin, float* out) {
    const int t = blockIdx.x * 4 + (threadIdx.x >> 6);
    final_row(t, threadIdx.x & 63, XN, Y, RW, MOD, gfin, out);
}

#endif
#define GAS __attribute__((address_space(1)))
#define LAS __attribute__((address_space(3)))
typedef unsigned v4u __attribute__((ext_vector_type(4)));
typedef short bf16x8 __attribute__((ext_vector_type(8)));
typedef GAS unsigned gu32;
typedef GAS unsigned long long gu64;
#define RLX_AGENT __ATOMIC_RELAXED, __HIP_MEMORY_SCOPE_AGENT
#define LDS_WAIT() asm volatile("s_waitcnt lgkmcnt(0)" ::: "memory")
#define VM_WAIT() asm volatile("s_waitcnt vmcnt(0)" ::: "memory")
__device__ __forceinline__ unsigned long long rt() { return __builtin_amdgcn_s_memrealtime(); }

#define XB_TMO      128
#define XB_XCNT(j)  (256  + 64 * (j))
#define XB_XSUB(j)  (1280 + 64 * (j))
#define XB_XGEN(j)  (2304 + 64 * (j))
#define XB_TOP      3328
#define XB_TOPGEN   3392
#define XCD_BAR_WORDS 3456
#define XB_SPIN_CAP (1u << 18)

__device__ __forceinline__ unsigned xb_ld(unsigned* p)              { return __hip_atomic_load(p, __ATOMIC_RELAXED, __HIP_MEMORY_SCOPE_AGENT); }
__device__ __forceinline__ unsigned xb_add(unsigned* p, unsigned v) { return __hip_atomic_fetch_add(p, v, __ATOMIC_RELAXED, __HIP_MEMORY_SCOPE_AGENT); }
__device__ __forceinline__ unsigned xb_xcc_id() { return (unsigned)__builtin_amdgcn_s_getreg((3 << 11) | 20) & 0xFu; }
#define XB_SPIN(cond, bar) do { unsigned _sp = 0; while (cond) { __builtin_amdgcn_s_sleep(1); \
    if ((++_sp & 255u) == 0u) { if (xb_ld(&(bar)[XB_TMO])) break; if (_sp > XB_SPIN_CAP) { atomicAdd(&(bar)[XB_TMO], 1u); break; } } } } while (0)

struct XcdBarrier {
    unsigned* bar; unsigned x;
    volatile LAS unsigned* st;
};

__device__ __forceinline__ XcdBarrier xcd_barrier_post(unsigned* bar, volatile LAS unsigned* st) {
    XcdBarrier b; b.bar = bar; b.x = xb_xcc_id(); b.st = st;
    if (threadIdx.x == 0) (void)xb_add(&bar[XB_XCNT(b.x)], 1u);
    return b;
}
__device__ __forceinline__ void xcd_barrier_complete(unsigned* bar, unsigned x, unsigned& nloc, unsigned& nx) {
    const unsigned G = gridDim.x * gridDim.y * gridDim.z;
    unsigned sum, cnt, mine, sp = 0u;
    for (;;) {
        sum = 0u; cnt = 0u; mine = 0u;
#pragma unroll
        for (unsigned j = 0; j < 16; ++j) { const unsigned c = xb_ld(&bar[XB_XCNT(j)]); sum += c; cnt += (c > 0u) ? 1u : 0u; mine = (j == x) ? c : mine; }
        if (sum == G) break;
        __builtin_amdgcn_s_sleep(1);
        if ((++sp & 255u) == 0u) { if (xb_ld(&bar[XB_TMO])) break; if (sp > XB_SPIN_CAP) { atomicAdd(&bar[XB_TMO], 1u); break; } }
    }
    nloc = mine > 0u ? mine : 1u; nx = cnt > 0u ? cnt : 1u;
}

__device__ __forceinline__ void xcd_barrier(const XcdBarrier& b, const bool leader_thread) {
    asm volatile("s_waitcnt vmcnt(0)" ::: "memory");
    __syncthreads();
    if (leader_thread) {
        unsigned* bar = b.bar;
        __builtin_amdgcn_s_waitcnt(0);
        unsigned nloc = b.st[0], nx = b.st[1];
        if (nloc == 0u) { xcd_barrier_complete(bar, b.x, nloc, nx); b.st[0] = nloc; b.st[1] = nx; }
        const unsigned old = xb_add(&bar[XB_XSUB(b.x)], 1u);
        const unsigned gen = old / nloc;
        if (old + 1u == (gen + 1u) * nloc) {
            __builtin_amdgcn_fence(__ATOMIC_RELEASE, "agent");
            asm volatile("s_waitcnt vmcnt(0)" ::: "memory");
            const unsigned og = xb_add(&bar[XB_TOP], 1u);
            const unsigned tg = og / nx;
            if (og + 1u == (tg + 1u) * nx) xb_add(&bar[XB_TOPGEN], 1u);
            else XB_SPIN(xb_ld(&bar[XB_TOPGEN]) == tg, bar);
            __builtin_amdgcn_fence(__ATOMIC_ACQUIRE, "agent");
            xb_add(&bar[XB_XGEN(b.x)], 1u);
            asm volatile("s_waitcnt vmcnt(0)" ::: "memory");
        } else {
            XB_SPIN(xb_ld(&bar[XB_XGEN(b.x)]) == gen, bar);
            __builtin_amdgcn_fence(__ATOMIC_ACQUIRE, "agent");
            asm volatile("s_waitcnt vmcnt(0)" ::: "memory");
        }
    }
    __syncthreads();
}
namespace pg8 {
#define PG8_LAS __attribute__((address_space(3)))
typedef unsigned short bf16_t;
typedef short bf16x8 __attribute__((ext_vector_type(8)));
typedef float f32x4 __attribute__((ext_vector_type(4)));
typedef unsigned u32x4 __attribute__((ext_vector_type(4)));
constexpr int BM = 256, BK = 64, HALF = 128, HTB = HALF * BK * 2  , STAGE_BYTES = 8 * HTB, NXCD = 8, WGM = 8;

__host__ __device__ __forceinline__ int lds_byte(int r, int c) { const int st = (r >> 4) * 2 + (c >> 5), rr = r & 15, cc = c & 31, ob = rr * 64 + cc * 2; return st * 1024 + (ob ^ (((ob >> 9) & 1) << 5)); }
__host__ __device__ __forceinline__ void stage_rc(int b, int& R, int& C) { const int st = b / 1024, sb = b % 1024, swz = sb ^ (((sb >> 9) & 1) << 5); R = (st >> 1) * 16 + swz / 64; C = (st & 1) * 32 + (swz % 64) / 2; }
__host__ __device__ __forceinline__ int perm32(int rho) { const int n = rho >> 4, i = rho & 15; return 8 * (i >> 2) + 4 * n + (i & 3); }

struct Unit { int pm, pn; };
struct Gemm { const bf16_t* A; const bf16_t* Bt; int M, N, K; };

struct StaticOrder {
    int nM, nN, nwg, G, c;
    __host__ __device__ void init(int M, int N, int G_, int c_) { nM = M / BM; nN = N / BM; nwg = nM * nN; G = G_; c = c_; }
    __host__ __device__ bool next(int i, Unit& u) const {
        const long L = (long)i * G + c; if (L >= nwg) return false;
        int wgid = (int)L; { const int q = nwg / NXCD, r = nwg % NXCD, xcd = wgid % NXCD, off = wgid / NXCD; wgid = (xcd < r ? xcd * (q + 1) : r * (q + 1) + (xcd - r) * q) + off; }
        const int nig = WGM * nN, gid = wgid / nig, fm = gid * WGM, gsz = (nM - fm) < WGM ? (nM - fm) : WGM;
        u.pm = fm + ((wgid % nig) % gsz); u.pn = (wgid % nig) / gsz; return true;
    }
    __device__ __forceinline__ void a_ready(const Unit&) const {}
    __device__ __forceinline__ void done(const Unit&) const {}
};

__device__ __forceinline__ unsigned cvt_pk_bf16(float lo, float hi) { unsigned r; asm volatile("v_cvt_pk_bf16_f32 %0, %1, %2" : "=v"(r) : "v"(lo), "v"(hi)); return r; }
typedef float f32x2 __attribute__((ext_vector_type(2)));
template <class Epi, class Sched, class AMap, bool ALIGN_EPI = false, bool SP2 = false>
__device__ __forceinline__ void gemm_phase(PG8_LAS unsigned char* lds, const Gemm g, const Sched& S, const Epi& E, const AMap& AM, const int tid) {
    const int wid = __builtin_amdgcn_readfirstlane(tid >> 6), lane = tid & 63, wr = wid >> 2, wc = wid & 3, fr = lane & 15, fq = lane >> 4;
    const int K = g.K, nt = K / BK;
    unsigned voffB[2]; int stR[2], stC[2];
#pragma unroll
    for (int i = 0; i < 2; ++i) { int R, C; stage_rc(tid * 16 + i * 8192, R, C); const int Rb = Epi::PERM ? ((R & ~31) + perm32(R & 31)) : R;
        stR[i] = R; stC[i] = C; voffB[i] = (unsigned)(Rb * K + C) * 2u; }
    unsigned vAc[2][2], vAn[2][2]; int rN[2][2], rNN[2][2];
#define PG8_AOFF(dst, un) do { _Pragma("unroll") for (int _h = 0; _h < 2; ++_h) _Pragma("unroll") for (int _i = 0; _i < 2; ++_i) \
        dst[_h][_i] = (unsigned)AM.row(un, _h * HALF + stR[_i]) * (unsigned)(K * 2) + (unsigned)(stC[_i] * 2); } while (0)
#define PG8_AROW(dst, un) do { _Pragma("unroll") for (int _h = 0; _h < 2; ++_h) _Pragma("unroll") for (int _i = 0; _i < 2; ++_i) dst[_h][_i] = AM.raw(un, _h * HALF + stR[_i]); } while (0)
#define PG8_AOFFR(dst, raw) do { _Pragma("unroll") for (int _h = 0; _h < 2; ++_h) _Pragma("unroll") for (int _i = 0; _i < 2; ++_i) \
        dst[_h][_i] = (unsigned)AM.fix(raw[_h][_i]) * (unsigned)(K * 2) + (unsigned)(stC[_i] * 2); } while (0)
    const size_t kstep = (size_t)(BK * 2);
    const size_t hstep = (size_t)HALF * K * 2;
    const size_t tstep = 2 * hstep;
    const unsigned ldsw = (unsigned)wid * 1024u;
    const int aoff = lds_byte(wr * 64 + fr, fq * 8), boff = lds_byte(wc * 32 + fr, fq * 8);
#define PG8_SA(b, h) (((b) * 2 + (h)) * HTB)
#define PG8_SB(b, h) ((4 + (b) * 2 + (h)) * HTB)
#define PG8_STAGE(bufoff, gbase, voff) do { _Pragma("unroll") for (int _i = 0; _i < 2; ++_i) \
        __builtin_amdgcn_global_load_lds((const unsigned*)((const char*)(gbase) + (voff)[_i]), (PG8_LAS unsigned*)(lds + (bufoff) + ldsw + _i * 8192), 16, 0, 0); } while (0)
#define PG8_STAGEA(bufoff, koff, vo) do { _Pragma("unroll") for (int _i = 0; _i < 2; ++_i) \
        __builtin_amdgcn_global_load_lds((const unsigned*)((const char*)g.A + (koff) + (vo)[_i]), (PG8_LAS unsigned*)(lds + (bufoff) + ldsw + _i * 8192), 16, 0, 0); } while (0)
#define PG8_LDA(dst, b, h) do { _Pragma("unroll") for (int m = 0; m < 4; ++m) _Pragma("unroll") for (int k = 0; k < 2; ++k) dst[m][k] = *(const PG8_LAS bf16x8*)(lds + PG8_SA(b, h) + aoff + m * 2048 + k * 1024); } while (0)
#define PG8_LDB(dst, b, h) do { _Pragma("unroll") for (int n = 0; n < 2; ++n) _Pragma("unroll") for (int k = 0; k < 2; ++k) dst[n][k] = *(const PG8_LAS bf16x8*)(lds + PG8_SB(b, h) + boff + n * 2048 + k * 1024); } while (0)
#define PG8_MMA(ai, bj, At, Bt) do { __builtin_amdgcn_s_setprio(1); _Pragma("unroll") for (int m = 0; m < 4; ++m) _Pragma("unroll") for (int n = 0; n < 2; ++n) _Pragma("unroll") for (int k = 0; k < 2; ++k) \
        acc[ai][bj][m][n] = __builtin_amdgcn_mfma_f32_16x16x32_bf16(Bt[n][k], At[m][k], acc[ai][bj][m][n], 0, 0, 0); __builtin_amdgcn_s_setprio(0); } while (0)
#define PG8_WAIT_V(n) asm volatile("s_waitcnt vmcnt(" #n ")" ::: "memory")
#define PG8_WAIT_L(n) asm volatile("s_waitcnt lgkmcnt(" #n ")" ::: "memory")
#define PG8_BAR __builtin_amdgcn_s_barrier()
#define PG8_SCHED __builtin_amdgcn_sched_barrier(0)
    Unit cur, nxt, nn; int ui = 0;
    if (!S.next(0, cur)) return;
    f32x4 acc[2][2][4][2];
#pragma unroll
    for (int a = 0; a < 2; ++a)
#pragma unroll
        for (int b = 0; b < 2; ++b)
#pragma unroll
            for (int m = 0; m < 4; ++m)
#pragma unroll
                for (int n = 0; n < 2; ++n) acc[a][b][m][n] = (f32x4){0.f, 0.f, 0.f, 0.f};
    bf16x8 At[4][2], B0[2][2], B1[2][2];
    const char* cB = (const char*)g.Bt + (size_t)cur.pn * tstep;
    S.a_ready(cur);
    PG8_AOFF(vAc, cur);
    bool has_next = S.next(1, nxt);
    if (has_next) PG8_AROW(rN, nxt);
    if constexpr (SP2) {
        PG8_STAGE(PG8_SB(0, 0), cB, voffB); PG8_STAGE(PG8_SB(0, 1), cB + hstep, voffB); PG8_STAGEA(PG8_SA(0, 0), 0, vAc[0]); PG8_STAGEA(PG8_SA(0, 1), 0, vAc[1]);
        if (wr == 1) PG8_BAR;
        PG8_WAIT_V(2); PG8_BAR;
        PG8_STAGE(PG8_SB(1, 0), cB + kstep, voffB); PG8_STAGEA(PG8_SA(1, 0), kstep, vAc[0]); PG8_STAGE(PG8_SB(1, 1), cB + hstep + kstep, voffB);
        PG8_WAIT_V(6); PG8_BAR;
    } else {
        PG8_STAGE(PG8_SB(0, 0), cB, voffB); PG8_STAGEA(PG8_SA(0, 0), 0, vAc[0]); PG8_STAGE(PG8_SB(0, 1), cB + hstep, voffB); PG8_STAGEA(PG8_SA(0, 1), 0, vAc[1]);
        if (wr == 1) PG8_BAR;
        PG8_WAIT_V(4); PG8_BAR;
        PG8_STAGE(PG8_SB(1, 0), cB + kstep, voffB); PG8_STAGEA(PG8_SA(1, 0), kstep, vAc[0]); PG8_STAGE(PG8_SB(1, 1), cB + hstep + kstep, voffB);
        PG8_WAIT_V(6); PG8_BAR;
    }
    for (;;) {
        const bool has_nn = has_next && S.next(ui + 2, nn);
        if (has_nn) PG8_AROW(rNN, nn);
        const char* nB = has_next ? (const char*)g.Bt + (size_t)nxt.pn * tstep : cB;
        if (has_next) { PG8_AOFFR(vAn, rN); } else { _Pragma("unroll") for (int _h = 0; _h < 2; ++_h) _Pragma("unroll") for (int _i = 0; _i < 2; ++_i) vAn[_h][_i] = vAc[_h][_i]; }
        for (int t = 0; t < nt; t += 2) {
            const bool last = (t == nt - 2);
            const size_t a1 = (size_t)(t + 1) * kstep;
            const size_t a2 = last ? (size_t)0 : (size_t)(t + 2) * kstep; const char* b2 = last ? nB : cB + (size_t)(t + 2) * kstep;
            const size_t a3 = a2 + kstep; const char* b3 = b2 + kstep;
#define PG8_SWAPA() do { if (last) { _Pragma("unroll") for (int _h = 0; _h < 2; ++_h) _Pragma("unroll") for (int _i = 0; _i < 2; ++_i) vAc[_h][_i] = vAn[_h][_i]; } } while (0)
            if (last && has_next) S.a_ready(nxt);
            if constexpr (SP2) {
            PG8_LDB(B0, 0, 0); PG8_LDB(B1, 0, 1); PG8_SCHED; PG8_LDA(At, 0, 0); PG8_STAGEA(PG8_SA(1, 1), a1, vAc[1]); PG8_SWAPA();
            PG8_WAIT_V(8); PG8_WAIT_L(0); PG8_BAR; PG8_MMA(0, 0, At, B0); PG8_MMA(0, 1, At, B1); PG8_BAR; PG8_SCHED;
            PG8_LDA(At, 0, 1); PG8_STAGE(PG8_SB(0, 0), b2, voffB); PG8_STAGE(PG8_SB(0, 1), b2 + hstep, voffB); PG8_STAGEA(PG8_SA(0, 0), a2, vAc[0]);
            PG8_WAIT_V(8); PG8_WAIT_L(0); PG8_BAR; PG8_MMA(1, 0, At, B0); PG8_MMA(1, 1, At, B1); PG8_BAR; PG8_SCHED;
            PG8_LDB(B0, 1, 0); PG8_LDB(B1, 1, 1); PG8_SCHED; PG8_LDA(At, 1, 0); PG8_STAGEA(PG8_SA(0, 1), a2, vAc[1]);
            PG8_WAIT_V(8); PG8_WAIT_L(0); PG8_BAR; PG8_MMA(0, 0, At, B0); PG8_MMA(0, 1, At, B1); PG8_BAR; PG8_SCHED;
            PG8_LDA(At, 1, 1); PG8_STAGE(PG8_SB(1, 0), b3, voffB); PG8_STAGE(PG8_SB(1, 1), b3 + hstep, voffB); PG8_STAGEA(PG8_SA(1, 0), a3, vAc[0]);
            PG8_WAIT_V(8); PG8_WAIT_L(0); PG8_BAR; PG8_MMA(1, 0, At, B0); PG8_MMA(1, 1, At, B1); PG8_BAR; PG8_SCHED;
            } else {
            PG8_LDB(B0, 0, 0); PG8_SCHED; PG8_LDA(At, 0, 0); PG8_STAGEA(PG8_SA(1, 1), a1, vAc[1]); PG8_SWAPA();
            PG8_WAIT_L(8); PG8_BAR; PG8_WAIT_L(0); PG8_MMA(0, 0, At, B0); PG8_BAR; PG8_SCHED;
            PG8_LDB(B1, 0, 1); PG8_STAGE(PG8_SB(0, 0), b2, voffB);
            PG8_BAR; PG8_WAIT_L(0); PG8_MMA(0, 1, At, B1); PG8_BAR;
            PG8_LDA(At, 0, 1); PG8_STAGEA(PG8_SA(0, 0), a2, vAc[0]);
            PG8_BAR; PG8_WAIT_L(0); PG8_MMA(1, 0, At, B0); PG8_BAR; PG8_SCHED;
            PG8_STAGE(PG8_SB(0, 1), b2 + hstep, voffB);
            PG8_WAIT_V(6); PG8_BAR; PG8_MMA(1, 1, At, B1); PG8_BAR;
            PG8_LDB(B0, 1, 0); PG8_SCHED; PG8_LDA(At, 1, 0); PG8_STAGEA(PG8_SA(0, 1), a2, vAc[1]);
            PG8_WAIT_L(8); PG8_BAR; PG8_WAIT_L(0); PG8_MMA(0, 0, At, B0); PG8_BAR; PG8_SCHED;
            PG8_LDB(B1, 1, 1); PG8_STAGE(PG8_SB(1, 0), b3, voffB);
            PG8_BAR; PG8_WAIT_L(0); PG8_MMA(0, 1, At, B1); PG8_BAR;
            PG8_LDA(At, 1, 1); PG8_STAGEA(PG8_SA(1, 0), a3, vAc[0]);
            PG8_BAR; PG8_WAIT_L(0); PG8_MMA(1, 0, At, B0); PG8_BAR; PG8_SCHED;
            PG8_STAGE(PG8_SB(1, 1), b3 + hstep, voffB);
            PG8_WAIT_V(6); PG8_BAR; PG8_MMA(1, 1, At, B1); PG8_BAR;
            }
        }
        if constexpr (ALIGN_EPI) { if (wr == 0) PG8_BAR; }
        if constexpr (!Epi::AFTER_DRAIN) { E(acc, cur, wr, wc, fr, fq); S.done(cur); }
        if (!has_next) break;
#pragma unroll
        for (int a = 0; a < 2; ++a)
#pragma unroll
            for (int b = 0; b < 2; ++b)
#pragma unroll
                for (int m = 0; m < 4; ++m)
#pragma unroll
                    for (int n = 0; n < 2; ++n) acc[a][b][m][n] = (f32x4){0.f, 0.f, 0.f, 0.f};
        cur = nxt; nxt = nn; has_next = has_nn; cB = nB; ++ui;
        _Pragma("unroll") for (int _h = 0; _h < 2; ++_h) _Pragma("unroll") for (int _i = 0; _i < 2; ++_i) rN[_h][_i] = rNN[_h][_i];
        if constexpr (ALIGN_EPI) { if (wr == 1) PG8_BAR; }
    }
    PG8_WAIT_V(0);
    if constexpr (!ALIGN_EPI) { if (wr == 0) PG8_BAR; }
    PG8_BAR;
    if constexpr (Epi::AFTER_DRAIN) { E.fused(acc, cur, wr, wc, fr, fq, lds, wid, lane); S.done(cur); }
#undef PG8_SA
#undef PG8_SB
#undef PG8_STAGE
#undef PG8_STAGEA
#undef PG8_AOFF
#undef PG8_AROW
#undef PG8_AOFFR
#undef PG8_SWAPA
#undef PG8_LDA
#undef PG8_LDB
#undef PG8_MMA
#undef PG8_WAIT_V
#undef PG8_WAIT_L
#undef PG8_BAR
#undef PG8_SCHED
}
}
namespace attn_body {
using bf16=unsigned short;
using bf16x8=__attribute__((ext_vector_type(8)))short;
using s16x4=__attribute__((ext_vector_type(4)))short;
using f32x16=__attribute__((ext_vector_type(16)))float;
using u32x4=__attribute__((ext_vector_type(4)))unsigned;
constexpr int D=64,QP=512,KVP=64,OP=1024,NKEYS=16640;
constexpr int NW=8,QBLK=32,QB=QBLK*NW,KVBLK=64;
constexpr int ATTN_UNIT_ROWS=QB;
__device__ __forceinline__ int crow(int r,int hi){return (r&3)+8*(r>>2)+4*hi;}
#define SBAR() __builtin_amdgcn_sched_barrier(0)
constexpr int NSLOT=3, SLOTB=8192;
constexpr int LDS_K=0, LDS_V=NSLOT*SLOTB, LDS_WS=2*NSLOT*SLOTB, LDS_OST=LDS_WS+NW*64*4, LDS_BYTES=LDS_OST+NW*4096;
constexpr float C2=0.125f*1.4426950408889634f;
__device__ __forceinline__ void glds16(const void*gsrc,unsigned lds_dst){unsigned keep;
  asm volatile("s_mov_b32 %0, m0\n\ts_mov_b32 m0, %2\n\ts_nop 0\n\tglobal_load_lds_dwordx4 %1, off\n\ts_mov_b32 m0, %0":"=&s"(keep):"v"(gsrc),"s"(lds_dst):"memory");}
__device__ __forceinline__ float max3f(float a,float b,float c){float r;asm("v_max3_f32 %0, %1, %2, %3":"=v"(r):"v"(a),"v"(b),"v"(c));return r;}
__device__ __forceinline__ float max2f(float a,float b){float r;asm("v_max_f32_e32 %0, %1, %2":"=v"(r):"v"(a),"v"(b));return r;}
__device__ __forceinline__ float fadd_s(float a,float b){float r;asm("v_add_f32_e32 %0, %1, %2":"=v"(r):"v"(a),"v"(b));return r;}
__device__ __forceinline__ float fsub_s(float a,float b){float r;asm("v_sub_f32_e32 %0, %1, %2":"=v"(r):"v"(a),"v"(b));return r;}
typedef float f32x2_t __attribute__((ext_vector_type(2))); typedef __bf16 bf16x2_t __attribute__((ext_vector_type(2)));
__device__ __forceinline__ unsigned cvtpk_s(float lo,float hi){f32x2_t v={lo,hi};bf16x2_t b=__builtin_convertvector(v,bf16x2_t);return __builtin_bit_cast(unsigned,b);}
#define WAIT_BAR(N) asm volatile("s_waitcnt vmcnt(" #N ") lgkmcnt(0)\n\ts_barrier":::"memory")

__device__ __forceinline__ void qkt(f32x16&p0,f32x16&p1,const char*Kslot,const bf16x8*qr,const f32x16&negm,int r32,int hi){
  const char*kb=Kslot+hi*1024+r32*16;
  #pragma unroll
  for(int d0=0;d0<4;++d0){
    const bf16x8 b0=*reinterpret_cast<const bf16x8*>(kb+d0*2048);
    const bf16x8 b1=*reinterpret_cast<const bf16x8*>(kb+d0*2048+512);
    if(d0==0){p0=__builtin_amdgcn_mfma_f32_32x32x16_bf16(b0,qr[0],negm,0,0,0);p1=__builtin_amdgcn_mfma_f32_32x32x16_bf16(b1,qr[0],negm,0,0,0);}
    else{p0=__builtin_amdgcn_mfma_f32_32x32x16_bf16(b0,qr[d0],p0,0,0,0);p1=__builtin_amdgcn_mfma_f32_32x32x16_bf16(b1,qr[d0],p1,0,0,0);}}
}
typedef __attribute__((address_space(3))) const char* lds_cptr;
typedef short v4i16_t __attribute__((ext_vector_type(4)));
__device__ __forceinline__ void kload8(bf16x8*kf,lds_cptr kp){
  kf[0]=*(const __attribute__((address_space(3))) bf16x8*)(kp);      kf[1]=*(const __attribute__((address_space(3))) bf16x8*)(kp+512);
  kf[2]=*(const __attribute__((address_space(3))) bf16x8*)(kp+2048); kf[3]=*(const __attribute__((address_space(3))) bf16x8*)(kp+2560);
  kf[4]=*(const __attribute__((address_space(3))) bf16x8*)(kp+4096); kf[5]=*(const __attribute__((address_space(3))) bf16x8*)(kp+4608);
  kf[6]=*(const __attribute__((address_space(3))) bf16x8*)(kp+6144); kf[7]=*(const __attribute__((address_space(3))) bf16x8*)(kp+6656);
}
__device__ __forceinline__ void kload2(bf16x8*kf,lds_cptr kp,int j){ kf[2*j]=*(const __attribute__((address_space(3))) bf16x8*)(kp+j*2048); kf[2*j+1]=*(const __attribute__((address_space(3))) bf16x8*)(kp+j*2048+512); }
__device__ __forceinline__ s16x4 vtr(lds_cptr p){ return __builtin_bit_cast(s16x4,__builtin_amdgcn_ds_read_tr16_b64_v4i16((__attribute__((address_space(3))) v4i16_t*)p)); }
__device__ __forceinline__ float rowmax(const f32x16&p0,const f32x16&p1){
  float a=max3f(p0[0],p0[1],p1[0]),b=max3f(p0[2],p0[3],p1[1]);a=max3f(a,p1[2],p1[3]);
  #pragma unroll
  for(int r=4;r<16;r+=4){a=max3f(a,p0[r],p0[r+1]);b=max3f(b,p0[r+2],p0[r+3]);a=max3f(a,p1[r],p1[r+1]);b=max3f(b,p1[r+2],p1[r+3]);}
  const float m=max2f(a,b);
  auto rr=__builtin_amdgcn_permlane32_swap(__float_as_uint(m),__float_as_uint(m),false,false);
  return max2f(__uint_as_float(rr[0]),__uint_as_float(rr[1]));
}
__device__ __forceinline__ void pv(f32x16*o,int vb,bf16x8 pa0,bf16x8 pa1,bf16x8 pa2,bf16x8 pa3){
  #pragma unroll
  for(int d0=0;d0<2;++d0){s16x4 lo[4],hi[4];
    #pragma unroll
    for(int ks=0;ks<4;++ks){
      asm volatile("ds_read_b64_tr_b16 %0,%1 offset:%c2":"=&v"(lo[ks]):"v"(vb),"i"(d0*4096+ks*1024):"memory");
      asm volatile("ds_read_b64_tr_b16 %0,%1 offset:%c2":"=&v"(hi[ks]):"v"(vb),"i"(d0*4096+ks*1024+512):"memory");}
    asm volatile("s_waitcnt lgkmcnt(0)":::"memory");SBAR();
    #define PK(k) (bf16x8){lo[k][0],lo[k][1],lo[k][2],lo[k][3],hi[k][0],hi[k][1],hi[k][2],hi[k][3]}
    o[d0]=__builtin_amdgcn_mfma_f32_32x32x16_bf16(pa0,PK(0),o[d0],0,0,0);
    o[d0]=__builtin_amdgcn_mfma_f32_32x32x16_bf16(pa1,PK(1),o[d0],0,0,0);
    o[d0]=__builtin_amdgcn_mfma_f32_32x32x16_bf16(pa2,PK(2),o[d0],0,0,0);
    o[d0]=__builtin_amdgcn_mfma_f32_32x32x16_bf16(pa3,PK(3),o[d0],0,0,0);
    #undef PK
  }
}

#ifndef ATTN_STORE16
#define ATTN_STORE16(p,v) (*(u32x4*)(p)=(v))
#endif
template<int THRL> __device__ __forceinline__ void attn_unit(int h,int qb,const bf16*Q,const bf16*__restrict__ K,const bf16*__restrict__ V,bf16*O,char*shm,const int tid){
  const int lane=tid&63,r32=lane&31,hi=lane>>5; const int wid=__builtin_amdgcn_readfirstlane(tid>>6);
  const int q0=qb*QB;
  const bf16*Qw=Q+(long)(q0+wid*QBLK)*QP+h*D;
  const bf16*Kh=K+(long)(h>>2)*NKEYS*KVP,*Vh=V+(long)(h>>2)*NKEYS*KVP;
  const unsigned lds0=(unsigned)(uintptr_t)shm;
  float*wsf=(float*)(shm+LDS_WS)+wid*64;
  const bf16*ksrc=Kh+(long)lane*KVP+wid*8;
  const bf16*vsrc=Vh+(long)(16*(wid&3)+(lane>>2))*KVP+(wid>>2)*32+(lane&3)*8;
  const unsigned kdst=lds0+LDS_K+wid*1024, vdst=lds0+LDS_V+wid*1024;
  #define DMA_K(t,slot) glds16(ksrc+(long)(t)*KVBLK*KVP,(unsigned)__builtin_amdgcn_readfirstlane(kdst+(slot)))
  #define DMA_V(t,slot) glds16(vsrc+(long)(t)*KVBLK*KVP,(unsigned)__builtin_amdgcn_readfirstlane(vdst+(slot)))
  const int vb0=(int)(lds0+LDS_V)+((lane>>4)&1)*32+(lane&3)*8+(4*hi+((lane&15)>>2))*64;
  const char*Kbase=shm+LDS_K; bf16x8 kf[8];
  const lds_cptr shm3=(lds_cptr)shm; const lds_cptr kp0=shm3+LDS_K+hi*1024+r32*16; const lds_cptr vp0=shm3+LDS_V+((lane>>4)&1)*32+(lane&3)*8+(4*hi+((lane&15)>>2))*64;
  constexpr int NT=NKEYS/KVBLK;
  DMA_K(0,0);DMA_V(0,0);DMA_K(1,SLOTB);
  bf16x8 qr[4];
  #pragma unroll
  for(int d0=0;d0<4;++d0)qr[d0]=*reinterpret_cast<const bf16x8*>(&Qw[(long)r32*QP+d0*16+hi*8]);
  float l_reg=0.f;f32x16 o[2];o[0]=f32x16{};o[1]=f32x16{};const f32x16 negm=f32x16{};
  #define CMASK(P0,P1,t) do{}while(0)
  #define START(P0,P1) do{ _Pragma("unroll") for(int r=0;r<16;++r)P0[r]=__builtin_amdgcn_exp2f(P0[r]); }while(0)
  #define RESC() do{}while(0)
  f32x16 pA0,pA1,pB0,pB1;
  int sl_prev=0,sl_cur=0,sl_next=SLOTB;
  #define ROT() do{sl_prev=sl_cur;sl_cur=sl_next;sl_next=(sl_next==(NSLOT-1)*SLOTB)?0:sl_next+SLOTB;}while(0)
  DMA_K(2,2*SLOTB);
  WAIT_BAR(3);
  qkt(pA0,pA1,Kbase,qr,negm,r32,hi);asm volatile("s_nop 15\n\ts_nop 7":"+v"(pA0),"+v"(pA1));CMASK(pA0,pA1,0);
  START(pA0,pA1);
  _Pragma("unroll") for(int r=0;r<16;++r)pA1[r]=__builtin_amdgcn_exp2f(pA1[r]);
  WAIT_BAR(0);
  DMA_K(3,0);DMA_V(1,SLOTB);
  ROT();
  kload8(kf,kp0+sl_cur);
  WAIT_BAR(2);
  s16x4 vlo[8],vhi[8]; u32x4 pw0,pw1,pw2,pw3;
  #define PKW(P,B) cvtpk_s(P[B],P[B+1])
  #define PAF(k) __builtin_bit_cast(bf16x8,pw##k)
  #define VFR(i) (bf16x8){vlo[i][0],vlo[i][1],vlo[i][2],vlo[i][3],vhi[i][0],vhi[i][1],vhi[i][2],vhi[i][3]}
  #define PIN(x) asm volatile("":"+v"(x))
  #define MX3(a,b,c) __builtin_fmaxf(__builtin_fmaxf((a),(b)),(c))
  #define GAPA(MF,A0,A1,A2,A3,W0,W1,PW) do{ MF; sacc+=A0; sacc+=A1; sacc+=A2; sacc+=A3; PIN(sacc); W0; W1; PIN(PW); SBAR(); }while(0)
  #define EX(v) __builtin_amdgcn_exp2f(v)
  #define GAPB(MF,X,B) do{ MF; X[B]=EX(X[B]); X[B+1]=EX(X[B+1]); X[B+2]=EX(X[B+2]); X[B+3]=EX(X[B+3]); PIN(X); SBAR(); }while(0)
  #define VRD(i) do{ vlo[i]=vtr(vp_+(((i)>>2)*4096+((i)&3)*1024)); vhi[i]=vtr(vp_+(((i)>>2)*4096+((i)&3)*1024+512)); }while(0)
  #define KRD(G,j) do{ if(G){ kload2(kf,kp0+sl_next,j); SBAR(); } }while(0)
  #define STEP(C0,C1,P0,P1,t,GK,GV,GL) do{ SBAR(); \
    const lds_cptr vp_=vp0+sl_prev; \
    VRD(0); SBAR(); float sacc=(P0[0]+P0[1]); \
    GAPA(C0=__builtin_amdgcn_mfma_f32_32x32x16_bf16(kf[0],qr[0],negm,0,0,0), P0[2],P0[3],P0[4],P0[5],     pw0[0]=PKW(P0,0), pw0[1]=PKW(P0,2), pw0); \
    VRD(4); SBAR(); GAPA(C1=__builtin_amdgcn_mfma_f32_32x32x16_bf16(kf[1],qr[0],negm,0,0,0), P0[6],P0[7],P0[8],P0[9],     pw0[2]=PKW(P0,4), pw0[3]=PKW(P0,6), pw0); \
    VRD(1); SBAR(); GAPA(C0=__builtin_amdgcn_mfma_f32_32x32x16_bf16(kf[2],qr[1],C0,0,0,0),   P0[10],P0[11],P0[12],P0[13], pw1[0]=PKW(P0,8), pw1[1]=PKW(P0,10), pw1); \
    VRD(5); SBAR(); GAPA(C1=__builtin_amdgcn_mfma_f32_32x32x16_bf16(kf[3],qr[1],C1,0,0,0),   P0[14],P0[15],P1[0],P1[1],   pw1[2]=PKW(P0,12),pw1[3]=PKW(P0,14), pw1); \
    VRD(2); SBAR(); GAPA(C0=__builtin_amdgcn_mfma_f32_32x32x16_bf16(kf[4],qr[2],C0,0,0,0),   P1[2],P1[3],P1[4],P1[5],     pw2[0]=PKW(P1,0), pw2[1]=PKW(P1,2), pw2); \
    VRD(6); SBAR(); GAPA(C1=__builtin_amdgcn_mfma_f32_32x32x16_bf16(kf[5],qr[2],C1,0,0,0),   P1[6],P1[7],P1[8],P1[9],     pw2[2]=PKW(P1,4), pw2[3]=PKW(P1,6), pw2); \
    VRD(3); SBAR(); GAPA(C0=__builtin_amdgcn_mfma_f32_32x32x16_bf16(kf[6],qr[3],C0,0,0,0),   P1[10],P1[11],P1[12],P1[13], pw3[0]=PKW(P1,8), pw3[1]=PKW(P1,10), pw3); \
    VRD(7); SBAR(); GAPA(C1=__builtin_amdgcn_mfma_f32_32x32x16_bf16(kf[7],qr[3],C1,0,0,0),   P1[14],P1[15],0.f,0.f,       pw3[2]=PKW(P1,12),pw3[3]=PKW(P1,14), pw3); \
    l_reg+=sacc; \
    if(GK){DMA_K((t)+3,sl_cur);} if(GV){DMA_V((t)+1,sl_next);} \
    CMASK(C0,C1,t); \
    SBAR(); \
    GAPB(o[0]=__builtin_amdgcn_mfma_f32_32x32x16_bf16(PAF(0),VFR(0),o[0],0,0,0), C0,0); \
    GAPB(o[1]=__builtin_amdgcn_mfma_f32_32x32x16_bf16(PAF(0),VFR(4),o[1],0,0,0), C0,4); \
    KRD(GL,0); GAPB(o[0]=__builtin_amdgcn_mfma_f32_32x32x16_bf16(PAF(1),VFR(1),o[0],0,0,0), C0,8); \
    KRD(GL,1); GAPB(o[1]=__builtin_amdgcn_mfma_f32_32x32x16_bf16(PAF(1),VFR(5),o[1],0,0,0), C0,12); \
    KRD(GL,2); GAPB(o[0]=__builtin_amdgcn_mfma_f32_32x32x16_bf16(PAF(2),VFR(2),o[0],0,0,0), C1,0); \
    KRD(GL,3); GAPB(o[1]=__builtin_amdgcn_mfma_f32_32x32x16_bf16(PAF(2),VFR(6),o[1],0,0,0), C1,4); \
    GAPB(o[0]=__builtin_amdgcn_mfma_f32_32x32x16_bf16(PAF(3),VFR(3),o[0],0,0,0), C1,8); \
    GAPB(o[1]=__builtin_amdgcn_mfma_f32_32x32x16_bf16(PAF(3),VFR(7),o[1],0,0,0), C1,12); \
    }while(0)
  int t=1;
  for(;t+5<NT;t+=2){
    STEP(pB0,pB1,pA0,pA1,t,true,true,true);     WAIT_BAR(2); RESC(); ROT();
    STEP(pA0,pA1,pB0,pB1,t+1,true,true,true);   WAIT_BAR(2); RESC(); ROT();
  }
  #define ENDW(tt) do{ if((tt)+3<NT){WAIT_BAR(2);} else if((tt)+2<NT){WAIT_BAR(1);} else {WAIT_BAR(0);} }while(0)
  for(;t+1<NT;t+=2){
    STEP(pB0,pB1,pA0,pA1,t,(t+3<NT),(t+1<NT),(t+1<NT));       ENDW(t);   RESC(); ROT();
    STEP(pA0,pA1,pB0,pB1,t+1,(t+4<NT),(t+2<NT),(t+2<NT));     ENDW(t+1); RESC(); ROT();
  }
  STEP(pB0,pB1,pA0,pA1,NT-1,false,false,false); RESC();
  { float sacc=pB0[0]+pB0[1]; _Pragma("unroll") for(int r=2;r<16;++r)sacc+=pB0[r]; _Pragma("unroll") for(int r=0;r<16;++r)sacc+=pB1[r]; l_reg+=sacc;
    pw0=(u32x4){PKW(pB0,0),PKW(pB0,2),PKW(pB0,4),PKW(pB0,6)};pw1=(u32x4){PKW(pB0,8),PKW(pB0,10),PKW(pB0,12),PKW(pB0,14)};pw2=(u32x4){PKW(pB1,0),PKW(pB1,2),PKW(pB1,4),PKW(pB1,6)};pw3=(u32x4){PKW(pB1,8),PKW(pB1,10),PKW(pB1,12),PKW(pB1,14)};
    SBAR(); pv(o,vb0+sl_cur,PAF(0),PAF(1),PAF(2),PAF(3)); }
  #undef PKW
  #undef PAF
  #undef VFR
  #undef PIN
  #undef MX3
  #undef GAPA
  #undef GAPB
  #undef EX
  #undef VRD
  #undef KRD
  #undef STEP
  #undef ENDW
  {auto rr=__builtin_amdgcn_permlane32_swap(__float_as_uint(l_reg),__float_as_uint(l_reg),false,false);l_reg=__uint_as_float(rr[0])+__uint_as_float(rr[1]);}
  if(hi==0)wsf[32+r32]=l_reg;asm volatile("s_waitcnt lgkmcnt(0)":::"memory");
  float rli[16];
  #pragma unroll
  for(int r=0;r<16;++r)rli[r]=__builtin_amdgcn_rcpf(wsf[32+crow(r,hi)]);
  bf16*Ow=O+(long)(q0+wid*QBLK)*OP+h*D;
  { bf16*stg=(bf16*)(shm+LDS_OST)+wid*2048;
    #pragma unroll
    for(int r=0;r<16;++r){const int orow=crow(r,hi);
      #pragma unroll
      for(int d0=0;d0<2;++d0)stg[orow*64+d0*32+r32]=f2bf(o[d0][r]*rli[r]);}
    asm volatile("s_waitcnt lgkmcnt(0)":::"memory");
    #pragma unroll
    for(int i=0;i<4;++i){const int row=i*8+(lane>>3),ch=lane&7; const u32x4 v=*(const u32x4*)(stg+row*64+ch*8); ATTN_STORE16(Ow+(long)row*OP+ch*8,v);} }
  asm volatile("s_waitcnt lgkmcnt(0)\n\ts_barrier":::"memory");
  #undef DMA_K
  #undef DMA_V
  #undef CMASK
  #undef START
  #undef RESC
  #undef ROT
}
constexpr int ATTN_LDS_BYTES=LDS_BYTES;
struct AttnTensors { const bf16* Q; const bf16* K; const bf16* V; bf16* O; };
#undef SBAR
#undef WAIT_BAR
}
#ifndef ROWS_SWAP
#define ROWS_SWAP 0
#endif
__device__ __forceinline__ float rows_sum_shfl(float v) { v += __shfl_xor(v, 16); v += __shfl_xor(v, 32); return v; }
constexpr int NWAVES = 8, NTHREADS = 512;
constexpr int RING_OFF = 0, RING_BYTES = 131072;
constexpr int LDSCTL_OFF = RING_BYTES, MISC_OFF = LDSCTL_OFF + 320;
constexpr int TT_OFF = LDSCTL_OFF + 1024;
constexpr int RT_OFF = LDSCTL_OFF + 4096;
constexpr int LDS_BYTES = RT_OFF + 16384 + 1024;
constexpr int MAXT = 192;

struct Frame {
    LAS unsigned char* lds; volatile LAS unsigned* MISC; unsigned* ctl;
    int tid, lane, wave, vcu, G;
};
__device__ __forceinline__ float silu_f(float v) { return v * __builtin_amdgcn_rcpf(1.f + __expf(-v)); }
__device__ __forceinline__ float lsig(float x) { return -log1pf(expf(-x)); }

__device__ __forceinline__ void publish_add(unsigned* cnt, bool leader) {
    asm volatile("s_waitcnt vmcnt(0)" ::: "memory"); __syncthreads();
    if (leader) { __builtin_amdgcn_fence(__ATOMIC_RELEASE, "agent"); asm volatile("s_waitcnt vmcnt(0)" ::: "memory");
        (void)__hip_atomic_fetch_add(cnt, 1u, __ATOMIC_RELAXED, __HIP_MEMORY_SCOPE_AGENT); }
}
__device__ __forceinline__ void store16_wt(void* p, f32x4 v) { asm volatile("global_store_dwordx4 %0, %1, off sc1\n\ts_nop 1" :: "v"(p), "v"(v) : "memory"); }
__device__ __forceinline__ void publish_add_wt(unsigned* cnt, bool leader) {
    asm volatile("s_waitcnt vmcnt(0)" ::: "memory"); __syncthreads();
    if (leader) (void)__hip_atomic_fetch_add(cnt, 1u, __ATOMIC_RELAXED, __HIP_MEMORY_SCOPE_AGENT);
}
__device__ __forceinline__ void wait_ge(unsigned* cnt, unsigned want, bool leader, unsigned* tmo, bool acq = true) {
    if (leader) { unsigned sp = 0;
        while (__hip_atomic_load(cnt, __ATOMIC_RELAXED, __HIP_MEMORY_SCOPE_AGENT) < want) { __builtin_amdgcn_s_sleep(2);
            if ((++sp & 1023u) == 0u) { if (sp > (1u << 22) || __hip_atomic_load(tmo, __ATOMIC_RELAXED, __HIP_MEMORY_SCOPE_AGENT) != 0u) { __hip_atomic_store(tmo, 1u, __ATOMIC_RELAXED, __HIP_MEMORY_SCOPE_AGENT); break; } } }
        if (acq) __builtin_amdgcn_fence(__ATOMIC_ACQUIRE, "agent"); asm volatile("s_waitcnt vmcnt(0)" ::: "memory"); }
    __syncthreads();
}

__device__ __forceinline__ void p0_transpose_item(const float* W, int N, bf16* WT, int Kd, int k0, int n0, int drow0, LAS float* scr, int lane) {
    float wv[32];
#pragma unroll
    for (int i = 0; i < 32; ++i) wv[i] = NT_LD(&W[(size_t)(k0 + 2 * i + (lane >> 5)) * N + n0 + (lane & 31)]);
#pragma unroll
    for (int i = 0; i < 32; ++i) scr[(2 * i + (lane >> 5)) * 33 + (lane & 31)] = wv[i];
    LDS_WAIT(); asm volatile("" ::: "memory");
    const int c = lane & 7;
#pragma unroll
    for (int j = 0; j < 4; ++j) { const int n = (lane >> 3) + 8 * j; const LAS float* s = scr + (8 * c) * 33 + n;
        u32x4 o; o.x = pk2(s[0 * 33], s[1 * 33]); o.y = pk2(s[2 * 33], s[3 * 33]); o.z = pk2(s[4 * 33], s[5 * 33]); o.w = pk2(s[6 * 33], s[7 * 33]);
        if (WT_MASK & 64) st16_sel(WT + (size_t)(drow0 + n) * Kd + k0 + 8 * c, o, true); else NT_ST(o, (u32x4*)(WT + (size_t)(drow0 + n) * Kd + k0 + 8 * c)); }
    LDS_WAIT(); asm volatile("" ::: "memory");
}
struct P0Args { unsigned* modcnt; const float *c, *cctx, *w_ada, *b_ada, *w_in, *w_out, *wg, *wu, *wd, *wgrp, *wexp; float *MOD, *ROPE, *RTW; bf16 *Wi, *Wo, *Wgu, *Wd; };
constexpr int CV_IN = 16 * 72, CV_OUT = 16 * 32, CV_G = 32 * 256, CV_D = 32 * 256, CV_ITEMS = CV_IN + CV_OUT + 2 * CV_G + CV_D;
#ifndef FILL_ITEMS
#define FILL_ITEMS 10240
#endif
constexpr int P0_ITEMS = CV_ITEMS - FILL_ITEMS;
__device__ __forceinline__ void convert_items(Frame& F, const P0Args& a, int first, int last, int w, int nw) {
    LAS float* scr = (LAS float*)(F.lds + RING_OFF + F.wave * 16384);
    for (int it = first + w; it < last; it += nw) {
        int r = it;
        if (r < CV_IN) { const int kb = r / 72, nb = r % 72, n0 = 32 * nb, pn = n0 >> 8, off = n0 & 255, wc = off >> 6, bj = (off >> 5) & 1;
            p0_transpose_item(a.w_in, NPROJ, a.Wi, 1024, 64 * kb, n0, pn * 256 + 128 * bj + 32 * wc, scr, F.lane); continue; } r -= CV_IN;
        if (r < CV_OUT) { const int kb = r >> 5, nb = r & 31; p0_transpose_item(a.w_out, 1024, a.Wo, 1024, 64 * kb, 32 * nb, 32 * nb, scr, F.lane); continue; } r -= CV_OUT;
        if (r < 2 * CV_G) { const int up = r >= CV_G; if (up) r -= CV_G; const int e = r >> 8, q = r & 255, kb = q >> 4, nb = q & 15, n0 = 32 * nb, pn = n0 >> 7, p = n0 & 127;
            p0_transpose_item((up ? a.wu : a.wg) + (size_t)e * 1024 * 512, 512, a.Wgu, 1024, 64 * kb, n0, e * 1024 + pn * 256 + (up ? 128 : 0) + p, scr, F.lane); continue; } r -= 2 * CV_G;
        { const int e = r >> 8, q = r & 255, kb = q >> 5, nb = q & 31; p0_transpose_item(a.wd + (size_t)e * 512 * 1024, 1024, a.Wd, 512, 64 * kb, 32 * nb, e * 1024 + 32 * nb, scr, F.lane); }
    }
}
#ifndef P0_EXTRA
#define P0_EXTRA 0
#endif
__device__ __forceinline__ void p0_prologue(Frame& F, const P0Args& a) {
    for (int cb = F.vcu; cb < 192; cb += F.G) {
        LAS float* sv = (LAS float*)(F.lds);
        LAS float* red = (LAS float*)(F.lds + 8192);
        for (int i = F.tid; i < 2048; i += NTHREADS) sv[i] = silu_f(i < 1024 ? a.c[i] : a.cctx[i - 1024]);
        __syncthreads();
        const int col = F.tid & 31, kg = F.tid >> 5, j0 = cb * 32;
        float a0 = 0.f, a1 = 0.f;
#pragma unroll 8
        for (int i = 0; i < 64; ++i) { const int k = kg + 16 * i; const float w = NT_LD(&a.w_ada[(size_t)k * 6144 + j0 + col]); a0 += sv[k] * w; a1 += sv[1024 + k] * w; }
        red[(kg * 32 + col) * 2] = a0; red[(kg * 32 + col) * 2 + 1] = a1;
        __syncthreads();
        if (F.tid < 64) { const int cc = F.tid & 31, s = F.tid >> 5; float t = 0.f;
#pragma unroll
            for (int g = 0; g < 16; ++g) t += red[(g * 32 + cc) * 2 + s];
            if (WT_MASK & 128) __hip_atomic_store(a.MOD + s * 6144 + j0 + cc, t + a.b_ada[j0 + cc], __ATOMIC_RELAXED, __HIP_MEMORY_SCOPE_AGENT); else a.MOD[s * 6144 + j0 + cc] = t + a.b_ada[j0 + cc]; }
        if (WT_MASK & 128) publish_add_wt(a.modcnt, F.tid == 0); else publish_add(a.modcnt, F.tid == 0);
        __syncthreads();
    }
    if (F.G == 256) {
        if (F.vcu >= 192) { const int tb = (F.vcu - 192) * NTHREADS + F.tid, ts = 64 * NTHREADS;
            for (int i = tb; i < 4096; i += ts) { const int pos = i >> 4, f = i & 15; const float freq = powf(10000.f, -(float)(2 * f) / 32.f), ang = (float)pos * freq;
                a.ROPE[2 * i] = cosf(ang); a.ROPE[2 * i + 1] = sinf(ang); }
            for (int i = tb; i < 36 * 1024; i += ts) { const int cc = i >> 10, n = i & 1023; a.RTW[i] = cc < 32 ? a.wexp[(size_t)n * 32 + cc] : a.wgrp[(size_t)n * 4 + cc - 32]; } }
    } else {
    if (F.vcu == F.G - 1) {
        for (int i = F.tid; i < 4096; i += NTHREADS) { const int pos = i >> 4, f = i & 15; const float freq = powf(10000.f, -(float)(2 * f) / 32.f), ang = (float)pos * freq;
            a.ROPE[2 * i] = cosf(ang); a.ROPE[2 * i + 1] = sinf(ang); }
        __syncthreads();
    }
    if (F.vcu == (F.G >= 2 ? F.G - 2 : 0)) {
        for (int i = F.tid; i < 36 * 1024; i += NTHREADS) { const int cc = i >> 10, n = i & 1023; a.RTW[i] = cc < 32 ? a.wexp[(size_t)n * 32 + cc] : a.wgrp[(size_t)n * 4 + cc - 32]; }
    }
    }
    { const int X = (F.G == 256 && P0_EXTRA < P0_ITEMS) ? P0_EXTRA : 0;
      if (X > 0 && F.vcu >= 192) convert_items(F, a, 0, X, (F.vcu - 192) * NWAVES + F.wave, 64 * NWAVES);
      convert_items(F, a, X, P0_ITEMS, F.vcu * NWAVES + F.wave, F.G * NWAVES); }
}
template <int NB> __device__ __forceinline__ void norm1_rows(const int (&rows)[NB], int lane, const float* x, const float* ctx, const float* g1, const float* MOD, bf16* HX, const f32x4 (*lat)[4] = nullptr) {
    f32x4 v[NB][4];
#pragma unroll
    for (int b = 0; b < NB; ++b) { const int r = rows[b]; const float* src = r < CL ? ctx + (size_t)r * DM : x + (size_t)(r - CL) * DM;
#pragma unroll
        for (int j = 0; j < 4; ++j) v[b][j] = NT_LD((const f32x4*)src + 2 * lane + (j & 1) + 128 * (j >> 1)); }
#pragma unroll
    for (int b = 0; b < NB; ++b) { const int r = rows[b]; const float* mod = MOD + (r < CL ? 6144 : 0); float ss = 0.f;
#pragma unroll
        for (int j = 0; j < 4; ++j) ss += (v[b][j].x * v[b][j].x + v[b][j].y * v[b][j].y) + (v[b][j].z * v[b][j].z + v[b][j].w * v[b][j].w);
        const float rstd = rsqrtf(wave_sum(ss) * (1.f / DM) + EPS);
#pragma unroll
        for (int jp = 0; jp < 2; ++jp) { u32x4 o;
#pragma unroll
            for (int q = 0; q < 2; ++q) { const int j = 2 * jp + q, n = 8 * lane + 4 * q + 512 * jp;
                float h[4];
                if (lat && r >= CL) { const f32x4 hv = (v[b][j] * rstd) * lat[0][j] + lat[1][j]; h[0] = hv.x; h[1] = hv.y; h[2] = hv.z; h[3] = hv.w; }
                else { const f32x4 g = *(const f32x4*)(g1 + n), sh = *(const f32x4*)(mod + n), sc = *(const f32x4*)(mod + 1024 + n);
#pragma unroll
                    for (int i = 0; i < 4; ++i) h[i] = (v[b][j][i] * rstd) * g[i] * (1.f + sc[i]) + sh[i]; }
                if (q == 0) { o.x = pk2(h[0], h[1]); o.y = pk2(h[2], h[3]); } else { o.z = pk2(h[0], h[1]); o.w = pk2(h[2], h[3]); } }
            st16_sel(HX + (size_t)r * DM + 8 * lane + 512 * jp, o, (WT_MASK & 1) != 0); } }
}

__device__ __forceinline__ void route_stage_weights(Frame& F, const float* RTW) {
    LAS u32x4* wxT = (LAS u32x4*)(F.lds + RING_OFF); LAS u32x4* wgT = (LAS u32x4*)(F.lds + RT_OFF); const u32x4* src = (const u32x4*)RTW;
#pragma unroll 8
    for (int i = 0; i < 16; ++i) wxT[F.tid + NTHREADS * i] = src[F.tid + NTHREADS * i];
#pragma unroll
    for (int i = 0; i < 2; ++i) wgT[F.tid + NTHREADS * i] = src[8192 + F.tid + NTHREADS * i];
    __syncthreads();
}
struct RouteOut { int ea, eb; float w1, w2; };
struct RouteRaw { float gl[4], el[8]; int g; };
__device__ __forceinline__ void route_load_row(int t, int lane, const bf16* XN, f32x4 (&v)[4]) {
    const u32x2* xr = (const u32x2*)(XN + (size_t)t * DM) + lane;
#pragma unroll
    for (int j = 0; j < 4; ++j) { const u32x2 w = xr[64 * j]; v[j] = (f32x4){__uint_as_float(w.x << 16), __uint_as_float(w.x & 0xffff0000u), __uint_as_float(w.y << 16), __uint_as_float(w.y & 0xffff0000u)}; }
}
template <int COMMIT> __device__ __forceinline__ void route_row_pre(Frame& F, int t, const f32x4 (&v)[4], const float* g2, const float* MOD, const float* bgrp, const float* bexp,
                                              bf16* H2, int* EID, float* RW, int* CNT, int* LIST, RouteOut* ro = nullptr, const f32x4 (*wgr)[4] = nullptr, const f32x4 (*gms)[4] = nullptr, RouteRaw* raw = nullptr);
template <int COMMIT> __device__ __forceinline__ void route_row_lds(Frame& F, int t, const bf16* XN, const float* g2, const float* MOD, const float* bgrp, const float* bexp,
                                              bf16* H2, int* EID, float* RW, int* CNT, int* LIST) {
    f32x4 v[4]; route_load_row(t, F.lane, XN, v); route_row_pre<COMMIT>(F, t, v, g2, MOD, bgrp, bexp, H2, EID, RW, CNT, LIST);
}
template <int COMMIT> __device__ __forceinline__ void route_row_pre(Frame& F, int t, const f32x4 (&v)[4], const float* g2, const float* MOD, const float* bgrp, const float* bexp,
                                              bf16* H2, int* EID, float* RW, int* CNT, int* LIST, RouteOut* ro, const f32x4 (*wgr)[4], const f32x4 (*gms)[4], RouteRaw* raw) {
    const int lane = F.lane;
    const LAS float* wxT = (const LAS float*)(F.lds + RING_OFF); const LAS float* wgT = (const LAS float*)(F.lds + RT_OFF);
    float ss = 0.f;
#pragma unroll
    for (int j = 0; j < 4; ++j) ss += (v[j].x * v[j].x + v[j].y * v[j].y) + (v[j].z * v[j].z + v[j].w * v[j].w);
#if defined(DIAG_CK) && DIAG_CK == 1
    { unsigned cx = 0;
#pragma unroll
      for (int j = 0; j < 4; ++j) cx ^= (__float_as_uint(v[j].x) * 3u) ^ (__float_as_uint(v[j].y) * 5u) ^ (__float_as_uint(v[j].z) * 7u) ^ (__float_as_uint(v[j].w) * 11u);
      cx *= (unsigned)(t * 2 + 1);
#pragma unroll
      for (int o = 1; o < 64; o <<= 1) cx ^= (unsigned)__shfl_xor((int)cx, o);
      if (COMMIT && lane == 0) atomicXor((unsigned*)(CNT) + 64, cx); }
#endif
    const float rstd = rsqrtf(wave_sum(ss) * (1.f / DM) + EPS);
    float gl[4]; pg8::f32x2 gl2[4] = {{0.f, 0.f}, {0.f, 0.f}, {0.f, 0.f}, {0.f, 0.f}};
    f32x4 h[4];
#pragma unroll
    for (int j = 0; j < 4; ++j) {
        const int n = 4 * lane + 256 * j;
        if (gms) h[j] = (v[j] * rstd) * gms[0][j] + gms[1][j];
        else { const f32x4 g = *(const f32x4*)(g2 + n), sh = *(const f32x4*)(MOD + 3072 + n), sc = *(const f32x4*)(MOD + 4096 + n);
#pragma unroll
            for (int i = 0; i < 4; ++i) h[j][i] = (v[j][i] * rstd) * g[i] * (1.f + sc[i]) + sh[i]; }
#pragma unroll
        for (int c = 0; c < 4; ++c) { const f32x4 w = wgr ? wgr[c][j] : *(const LAS f32x4*)(wgT + c * 1024 + n); gl2[c] += (pg8::f32x2){h[j].x, h[j].y} * (pg8::f32x2){w.x, w.y}; gl2[c] += (pg8::f32x2){h[j].z, h[j].w} * (pg8::f32x2){w.z, w.w}; }
        u32x2 o; o.x = pk2(h[j].x, h[j].y); o.y = pk2(h[j].z, h[j].w);
        st8_sel(H2 + (size_t)t * DM + n, o, (WT_MASK & 16) != 0);
    }
#pragma unroll
    for (int c = 0; c < 4; ++c) gl[c] = wave_sum(gl2[c].x + gl2[c].y) + bgrp[c];
    int g = 0; float gm = gl[0];
#pragma unroll
    for (int c = 1; c < 4; ++c) if (gl[c] > gm) { gm = gl[c]; g = c; }
    g = __builtin_amdgcn_readfirstlane(g);
    float gs = 0.f;
#pragma unroll
    for (int c = 0; c < 4; ++c) gs += __expf(gl[c] - gm);
    const float pg = __builtin_amdgcn_rcpf(gs);
    float el[8]; pg8::f32x2 el2[8] = {{0.f, 0.f}, {0.f, 0.f}, {0.f, 0.f}, {0.f, 0.f}, {0.f, 0.f}, {0.f, 0.f}, {0.f, 0.f}, {0.f, 0.f}};
#pragma unroll
    for (int j = 0; j < 4; ++j)
#pragma unroll
        for (int c = 0; c < 8; ++c) { const f32x4 w = *(const LAS f32x4*)(wxT + (g * 8 + c) * 1024 + 4 * lane + 256 * j); el2[c] += (pg8::f32x2){h[j].x, h[j].y} * (pg8::f32x2){w.x, w.y}; el2[c] += (pg8::f32x2){h[j].z, h[j].w} * (pg8::f32x2){w.z, w.w}; }
#pragma unroll
    for (int c = 0; c < 8; ++c) el[c] = wave_sum(el2[c].x + el2[c].y) + bexp[g * 8 + c];
    if (raw) {
#pragma unroll
        for (int c = 0; c < 4; ++c) raw->gl[c] = gl[c];
#pragma unroll
        for (int c = 0; c < 8; ++c) raw->el[c] = el[c];
        raw->g = g; return; }
    int j1 = 0; float m1 = el[0];
#pragma unroll
    for (int c = 1; c < 8; ++c) if (el[c] > m1) { m1 = el[c]; j1 = c; }
    int j2 = -1; float m2 = -INFINITY;
#pragma unroll
    for (int c = 0; c < 8; ++c) if (c != j1 && el[c] > m2) { m2 = el[c]; j2 = c; }
    const float e2 = __expf(m2 - m1), r12 = __builtin_amdgcn_rcpf(1.f + e2), w1 = pg * r12, w2 = pg * e2 * r12;
    if (COMMIT == 2) { ro->ea = __builtin_amdgcn_readfirstlane(g * 8 + j1); ro->eb = __builtin_amdgcn_readfirstlane(g * 8 + j2); ro->w1 = __uint_as_float(__builtin_amdgcn_readfirstlane(__float_as_uint(w1))); ro->w2 = __uint_as_float(__builtin_amdgcn_readfirstlane(__float_as_uint(w2))); return; }
    if (lane == 0) {
        const int ea = g * 8 + j1, eb = g * 8 + j2;
        EID[2 * t] = ea; EID[2 * t + 1] = eb; RW[2 * t] = w1; RW[2 * t + 1] = w2;
        if (COMMIT == 1) {
            const int sa = atomicAdd(CNT + ea, 1); __hip_atomic_store(LIST + ea * SEQ + sa, 2 * t, __ATOMIC_RELAXED, __HIP_MEMORY_SCOPE_AGENT);
            const int sb = atomicAdd(CNT + eb, 1); __hip_atomic_store(LIST + eb * SEQ + sb, 2 * t + 1, __ATOMIC_RELAXED, __HIP_MEMORY_SCOPE_AGENT); }
    }
}

namespace pg8 {
struct AMapDirect { __device__ __forceinline__ int row(const Unit& u, int r) const { return u.pm * BM + r; }
    __device__ __forceinline__ int raw(const Unit& u, int r) const { return row(u, r); } __device__ __forceinline__ int fix(int x) const { return x; } };
struct MoeTable { const LAS int* tt; const int* LIST;
    __device__ __forceinline__ int e(int T) const { return tt[T]; }
    __device__ __forceinline__ int s0(int T) const { return tt[MAXT + T]; }
    __device__ __forceinline__ int cnt(int e_) const { return tt[2 * MAXT + e_]; }
    __device__ __forceinline__ int ntiles() const { return tt[2 * MAXT + 32]; }
};
struct AMapGather { MoeTable mt;
    __device__ __forceinline__ int row(const Unit& u, int r) const { const int T = u.pm, e = mt.e(T), c = mt.cnt(e); int s = mt.s0(T) + r; s = s < c ? s : c - 1; return mt.LIST[e * SEQ + s] >> 1; }
    __device__ __forceinline__ int raw(const Unit& u, int r) const { const int T = u.pm, e = mt.e(T), c = mt.cnt(e); int s = mt.s0(T) + r; s = s < c ? s : c - 1; return mt.LIST[e * SEQ + s]; }
    __device__ __forceinline__ int fix(int x) const { return x >> 1; } };
struct MoeOrder { MoeTable mt; int G, c;
    __device__ __forceinline__ bool next(int i, Unit& u) const { const int L = i * G + c; if (L >= 4 * mt.ntiles()) return false; const int T = L >> 2; u.pm = T; u.pn = mt.e(T) * 4 + (L & 3); return true; }
    __device__ __forceinline__ void a_ready(const Unit&) const {}
    __device__ __forceinline__ void done(const Unit&) const {}
};
struct MoeOrder1 { MoeTable mt; int G, c; unsigned* tcnt;
    __device__ __forceinline__ bool next(int i, Unit& u) const { const int L = i * G + c; if (L >= 4 * mt.ntiles()) return false; const int T = L >> 2; u.pm = T; u.pn = mt.e(T) * 4 + (L & 3); return true; }
    __device__ __forceinline__ void a_ready(const Unit&) const {}
    __device__ __forceinline__ void done(const Unit& u) const { asm volatile("s_waitcnt vmcnt(0)" ::: "memory");
        if (fresh_lane() == 0) (void)__hip_atomic_fetch_add(tcnt + 64 * u.pm, 1u, __ATOMIC_RELAXED, __HIP_MEMORY_SCOPE_AGENT); }
};
#ifndef NOACQ_MASK
#define NOACQ_MASK 0
#endif
#ifndef MOE_NOACQ
#define MOE_NOACQ 0
#endif
#ifndef MOE_PEEK
#define MOE_PEEK 0
#endif
struct MoeOrder2 { MoeTable mt; int G, c, wave; unsigned* tcnt; unsigned* tmo; mutable bool acq_all = false;
    __device__ __forceinline__ bool next(int i, Unit& u) const {
        const int n1 = 4 * mt.ntiles(), k3 = n1 - 512; int L;
        if (G != 256 || k3 < 0 || k3 > 255) L = i * G + c;
        else if (c < k3) { if (i > 0) return false; L = 512 + c; }
        else { const int nb = 256 - k3; L = (c - k3) + i * nb; if (L >= 512) return false; }
        if (L >= n1) return false; const int T = L >> 2; u.pm = T; u.pn = mt.e(T) * 4 + (L & 3); return true; }
    __device__ __forceinline__ void a_ready(const Unit& u) const {
        if (wave == 0 && !acq_all) { unsigned sp = 0;
            while ((unsigned)__builtin_amdgcn_readfirstlane(__hip_atomic_load(tcnt + 64 * u.pm, __ATOMIC_RELAXED, __HIP_MEMORY_SCOPE_AGENT)) < 32u) { __builtin_amdgcn_s_sleep(2);
                if ((++sp & 1023u) == 0u && (sp > (1u << 22) || __builtin_amdgcn_readfirstlane(__hip_atomic_load(tmo, __ATOMIC_RELAXED, __HIP_MEMORY_SCOPE_AGENT)) != 0u)) { if (fresh_lane() == 0) __hip_atomic_store(tmo, 1u, __ATOMIC_RELAXED, __HIP_MEMORY_SCOPE_AGENT); break; } }
            if (MOE_PEEK) { bool all = true;
#pragma unroll
                for (int j = 0; j < 3; ++j) { Unit o; if (next(j, o)) all = all && ((unsigned)__builtin_amdgcn_readfirstlane(__hip_atomic_load(tcnt + 64 * o.pm, __ATOMIC_RELAXED, __HIP_MEMORY_SCOPE_AGENT)) >= 32u); }
                acq_all = all; }
            if (!MOE_NOACQ) __builtin_amdgcn_fence(__ATOMIC_ACQUIRE, "agent"); asm volatile("s_waitcnt vmcnt(0)" ::: "memory"); }
        asm volatile("" ::: "memory"); __builtin_amdgcn_s_barrier(); asm volatile("" ::: "memory");
    }
    __device__ __forceinline__ void done(const Unit&) const {}
};
__device__ __forceinline__ u32x4 pack8(const f32x4& a, const f32x4& b) { u32x4 w; w.x = cvt_pk_bf16(a[0], a[1]); w.y = cvt_pk_bf16(a[2], a[3]); w.z = cvt_pk_bf16(b[0], b[1]); w.w = cvt_pk_bf16(b[2], b[3]); return w; }

struct EpiInProj {
    static constexpr bool PERM = true, AFTER_DRAIN = false;
    bf16 *Q, *K, *V, *QR, *KR, *VR, *GR; const float *gq, *gk, *ROPE;
    __device__ __forceinline__ void operator()(const f32x4 (&acc)[2][2][4][2], const Unit& u, int wr, int wc, int fr, int fq) const {
        const int pn = u.pn; int kind, h;
        if (pn < 2) { kind = 0; h = pn * 4 + wc; } else if (pn == 2) { if (wc < 2) { kind = 1; h = wc; } else { kind = 2; h = wc - 2; } }
        else if (pn == 3) { kind = 3; h = wc; } else if (pn == 4) { kind = 4; h = wc; } else if (pn < 7) { kind = 5; h = (pn - 5) * 4 + wc; } else { kind = 6; h = (pn - 7) * 4 + wc; }
        const bool isctx = (u.pm == 0);
        if (isctx && (kind == 0 || kind == 3 || kind == 6)) return;
        const bool norm = kind <= 1, rope = !isctx && (kind == 0 || kind == 1 || kind == 3 || kind == 4);
        f32x4 gg[2][2];
#pragma unroll
        for (int bj = 0; bj < 2; ++bj)
#pragma unroll
            for (int n = 0; n < 2; ++n) gg[bj][n] = norm ? *(const f32x4*)((kind == 0 ? gq : gk) + 32 * bj + 8 * fq + 4 * n) : (f32x4){1.f, 1.f, 1.f, 1.f};
        const float osc = kind == 0 ? QSCALE : (kind == 4 ? 0.125f : 1.f);
        bf16* obase; int ostride; bool use_t;
        switch (kind) {
            case 0: obase = Q + h * 64; ostride = 512; use_t = true; break;
            case 1: obase = K + (size_t)h * NKV * 64; ostride = 64; use_t = false; break;
            case 2: obase = V + (size_t)h * NKV * 64; ostride = 64; use_t = false; break;
            case 3: obase = QR + (size_t)h * SEQ * 64; ostride = 64; use_t = true; break;
            case 4: obase = KR + (size_t)h * NKV * 64; ostride = 64; use_t = false; break;
            case 5: obase = VR + (size_t)(h >> 1) * NKV * 128 + (h & 1) * 64; ostride = 128; use_t = false; break;
            default: obase = GR + h * 64; ostride = 512; use_t = true; break;
        }
        f32x4 csr[2][2], csc[4][2];
        if (rope) { const int tb = u.pm * BM - CL + wr * 64;
#pragma unroll
            for (int ai = 0; ai < 2; ++ai)
#pragma unroll
                for (int n = 0; n < 2; ++n) csr[ai][n] = *(const f32x4*)(ROPE + ((((tb + ai * HALF) >> 6) * 16 + 4 * fq) * 2) + 4 * n);
#pragma unroll
            for (int m = 0; m < 4; ++m)
#pragma unroll
                for (int n = 0; n < 2; ++n) csc[m][n] = *(const f32x4*)(ROPE + (((m * 16 + fr) * 16 + 4 * fq) * 2) + 4 * n); }
#pragma unroll
        for (int ai = 0; ai < 2; ++ai)
#pragma unroll
            for (int m = 0; m < 4; ++m) {
                const int r = u.pm * BM + ai * HALF + wr * 64 + m * 16 + fr, t = r - CL;
                f32x4 v[2][2];
#pragma unroll
                for (int bj = 0; bj < 2; ++bj)
#pragma unroll
                    for (int n = 0; n < 2; ++n) v[bj][n] = acc[ai][bj][m][n];
                if (norm) { float ss = 0.f;
#pragma unroll
                    for (int bj = 0; bj < 2; ++bj)
#pragma unroll
                        for (int n = 0; n < 2; ++n) ss += (v[bj][n][0] * v[bj][n][0] + v[bj][n][1] * v[bj][n][1]) + (v[bj][n][2] * v[bj][n][2] + v[bj][n][3] * v[bj][n][3]);
                    ss = ROWS_SWAP ? rows_sum(ss) : rows_sum_shfl(ss);
                    const float rn = rsqrtf(ss * (1.f / 64.f) + EPS);
#pragma unroll
                    for (int bj = 0; bj < 2; ++bj)
#pragma unroll
                        for (int n = 0; n < 2; ++n) v[bj][n] = v[bj][n] * rn * gg[bj][n]; }
                if (rope) {
#pragma unroll
                    for (int bj = 0; bj < 2; ++bj) {
#pragma unroll
                        for (int n = 0; n < 2; ++n) { const f32x4 cs = bj ? csc[m][n] : csr[ai][n]; const f32x4 x = v[bj][n];
                            v[bj][n] = (f32x4){x[0] * cs[0] - x[1] * cs[1], x[0] * cs[1] + x[1] * cs[0], x[2] * cs[2] - x[3] * cs[3], x[2] * cs[3] + x[3] * cs[2]}; } } }
#pragma unroll
                for (int bj = 0; bj < 2; ++bj) {
                    st16_sel(obase + (size_t)(use_t ? t : r) * ostride + 32 * bj + 8 * fq, pack8(v[bj][0] * osc, v[bj][1] * osc), (WT_MASK & 2) != 0); }
            }
    }
};
template <bool WT> struct EpiOutProj {
    static constexpr bool PERM = true, AFTER_DRAIN = false;
    const float* x; const float* gt1; bf16* XN;
    __device__ __forceinline__ void operator()(const f32x4 (&acc)[2][2][4][2], const Unit& u, int wr, int wc, int fr, int fq) const {
        const int c0 = u.pn * BM + wc * 32 + 8 * fq;
        f32x4 g[2][2];
#pragma unroll
        for (int bj = 0; bj < 2; ++bj)
#pragma unroll
            for (int n = 0; n < 2; ++n) g[bj][n] = *(const f32x4*)(gt1 + c0 + bj * HALF + 4 * n);
#pragma unroll
        for (int ai = 0; ai < 2; ++ai) { f32x4 xv[4][2][2];
#pragma unroll
            for (int m = 0; m < 4; ++m) { const size_t off = (size_t)(u.pm * BM + ai * HALF + wr * 64 + m * 16 + fr) * DM + c0;
#pragma unroll
                for (int bj = 0; bj < 2; ++bj)
#pragma unroll
                    for (int n = 0; n < 2; ++n) xv[m][bj][n] = NT_LD((const f32x4*)(x + off + bj * HALF + 4 * n)); }
#pragma unroll
            for (int m = 0; m < 4; ++m) { const size_t off = (size_t)(u.pm * BM + ai * HALF + wr * 64 + m * 16 + fr) * DM + c0;
#pragma unroll
                for (int bj = 0; bj < 2; ++bj) { const u32x4 w = pack8(xv[m][bj][0] + g[bj][0] * acc[ai][bj][m][0], xv[m][bj][1] + g[bj][1] * acc[ai][bj][m][1]);
                    if (WT) store16_wt(XN + off + bj * HALF, __builtin_bit_cast(f32x4, w)); else *(u32x4*)(XN + off + bj * HALF) = w; } } }
    }
};
#ifndef ACT_ST16
#define ACT_ST16 0
#endif
template <bool WT> struct EpiSwiGLU {
    static constexpr bool PERM = true, AFTER_DRAIN = false;
    bf16* ACT;
    __device__ __forceinline__ void operator()(const f32x4 (&acc)[2][2][4][2], const Unit& u, int wr, int wc, int fr, int fq) const {
        const int c0 = (u.pn & 3) * 128 + wc * 32 + 8 * fq;
#pragma unroll
        for (int ai = 0; ai < 2; ++ai)
#pragma unroll
            for (int m = 0; m < 4; ++m) { f32x4 o[2];
#pragma unroll
                for (int n = 0; n < 2; ++n)
#pragma unroll
                    for (int i = 0; i < 4; i += 2) {
                        const pg8::f32x2 gv = {acc[ai][0][m][n][i], acc[ai][0][m][n][i + 1]}, uv = {acc[ai][1][m][n][i], acc[ai][1][m][n][i + 1]};
                        const pg8::f32x2 tv = gv * -1.4426950408889634f; const pg8::f32x2 dv = (pg8::f32x2){__builtin_amdgcn_exp2f(tv.x), __builtin_amdgcn_exp2f(tv.y)} + 1.f;
                        const pg8::f32x2 ov = (gv * uv) * (pg8::f32x2){__builtin_amdgcn_rcpf(dv.x), __builtin_amdgcn_rcpf(dv.y)}; o[n][i] = ov.x; o[n][i + 1] = ov.y; }
                const u32x4 w = pack8(o[0], o[1]); bf16* dst = ACT + (size_t)(u.pm * BM + ai * HALF + wr * 64 + m * 16 + fr) * DEXP + c0;
                if (WT && !ACT_ST16) { __hip_atomic_store((unsigned long long*)dst, (unsigned long long)w.x | ((unsigned long long)w.y << 32), __ATOMIC_RELAXED, __HIP_MEMORY_SCOPE_AGENT);
                          __hip_atomic_store((unsigned long long*)dst + 1, (unsigned long long)w.z | ((unsigned long long)w.w << 32), __ATOMIC_RELAXED, __HIP_MEMORY_SCOPE_AGENT); }
                else st16_sel(dst, w, WT); }
    }
};
struct EpiScatter {
    static constexpr bool PERM = true, AFTER_DRAIN = false;
    MoeTable mt; bf16* Y; int* FLAG;
    __device__ __forceinline__ void operator()(const f32x4 (&acc)[2][2][4][2], const Unit& u, int wr, int wc, int fr, int fq) const {
        const int T = u.pm, e = mt.e(T), cnt = mt.cnt(e), s0 = mt.s0(T); const int c0 = (u.pn & 3) * BM + wc * 32 + 8 * fq;
        int al[2][4];
#pragma unroll
        for (int ai = 0; ai < 2; ++ai)
#pragma unroll
            for (int m = 0; m < 4; ++m) { const int s = s0 + ai * HALF + wr * 64 + m * 16 + fr; al[ai][m] = s < cnt ? mt.LIST[e * SEQ + s] : -1; }
#pragma unroll
        for (int ai = 0; ai < 2; ++ai)
#pragma unroll
            for (int m = 0; m < 4; ++m) { const int a = al[ai][m];
                if (a >= 0) { bf16* dst = Y + ((size_t)(a & 1) * SEQ + (a >> 1)) * DM + c0;
#ifdef DIAG_FLAG
                    if ((u.pn & 3) == 0 && wc == 0 && fq == 0) atomicAdd(FLAG + a, 1);
#endif
#pragma unroll
                    for (int bj = 0; bj < 2; ++bj) st16_sel(dst + bj * HALF, pack8(acc[ai][bj][m][0], acc[ai][bj][m][1]), (WT_MASK & 32) != 0); } }
    }
};
}
__device__ __forceinline__ void moe_build_table(Frame& F, const int* CNT) {
    LAS int* tt = (LAS int*)(F.lds + TT_OFF);
    if (F.wave == 0) { const int lane = fresh_lane(); const int c = lane < NEXP ? CNT[lane] : 0; const int nt = (c + 255) >> 8; int incl = nt;
#pragma unroll
        for (int o = 1; o < 32; o <<= 1) { const int v = __shfl_up(incl, o); if (lane >= o) incl += v; }
        const int first = incl - nt;
        if (lane < NEXP) { tt[2 * MAXT + lane] = c; for (int k = 0; k < nt; ++k) if (first + k < MAXT) { tt[first + k] = lane; tt[MAXT + first + k] = 256 * k; } }
        const int total = __shfl(incl, NEXP - 1); if (lane == 0) tt[2 * MAXT + 32] = total < MAXT ? total : MAXT; }
    __syncthreads();
}

namespace ret {
typedef short bf16x8 __attribute__((ext_vector_type(8)));
typedef short s16x4 __attribute__((ext_vector_type(4)));
constexpr int KS = 144, VS = 272, PS = 272;
constexpr int NCH = 130;
#define RET_MFMA(a, b, c) __builtin_amdgcn_mfma_f32_16x16x32_bf16(a, b, c, 0, 0, 0)
__device__ __forceinline__ bf16x8 tr_frag(LAS unsigned char* base, int S, int tok0, int feat0, int lane) {
    const int g = lane >> 4, i = lane & 15;
#ifndef RET_NO_TR
    const int q = i >> 2, p = i & 3;
    LAS unsigned char* a0 = base + (tok0 + 8 * g + q) * S + (feat0 + 4 * p) * 2;
    const s16x4 lo = __builtin_bit_cast(s16x4, __builtin_amdgcn_ds_read_tr16_b64_v4i16((LAS s16x4*)a0));
    const s16x4 hi = __builtin_bit_cast(s16x4, __builtin_amdgcn_ds_read_tr16_b64_v4i16((LAS s16x4*)(a0 + 4 * S)));
    return (bf16x8){lo[0], lo[1], lo[2], lo[3], hi[0], hi[1], hi[2], hi[3]};
#else
    bf16x8 r;
#pragma unroll
    for (int j = 0; j < 8; ++j) r[j] = *(LAS short*)(base + (tok0 + 8 * g + j) * S + (feat0 + i) * 2);
    return r;
#endif
}
__device__ __forceinline__ u32x4 scale8(u32x4 w, float s) {
    u32x4 o;
#pragma unroll
    for (int i = 0; i < 4; ++i) { const float lo = __uint_as_float(w[i] << 16) * s, hi = __uint_as_float(w[i] & 0xffff0000u) * s; o[i] = pk2(lo, hi); }
    return o;
}
#ifndef RET_WT
#define RET_WT 0
#endif
__device__ __forceinline__ void r1_unit(Frame& F, int h, int j, const bf16* KR, const bf16* VR, float lgf, float lgb, float* U) {
    LAS unsigned char* Kf = F.lds, *Kb = F.lds + 128 * KS, *Vs = F.lds + 2 * 128 * KS;
    const int lane = fresh_lane(), tid = F.wave * 64 + lane;
    const bf16* kc = KR + ((size_t)h * NKV + 128 * j) * 64; const bf16* vc = VR + ((size_t)h * NKV + 128 * j) * 128;
#pragma unroll
    for (int i = 0; i < 2; ++i) { const int id = tid + 512 * i, row = id >> 3, ch = id & 7; const u32x4 w = *(const u32x4*)(kc + row * 64 + ch * 8);
        *(LAS u32x4*)(Kf + row * KS + ch * 16) = scale8(w, __expf(lgf * (float)(127 - row))); *(LAS u32x4*)(Kb + row * KS + ch * 16) = scale8(w, __expf(lgb * (float)row)); }
#pragma unroll
    for (int i = 0; i < 4; ++i) { const int id = tid + 512 * i, row = id >> 4, ch = id & 15; *(LAS u32x4*)(Vs + row * VS + ch * 16) = *(const u32x4*)(vc + row * 128 + ch * 8); }
    __syncthreads();
    const int w = F.wave, g = lane >> 4, li = lane & 15;
    bf16x8 a[4];
#pragma unroll
    for (int ks = 0; ks < 4; ++ks) a[ks] = tr_frag(Vs, VS, 32 * ks, 16 * w, lane);
#pragma unroll
    for (int dir = 0; dir < 2; ++dir)
#pragma unroll
        for (int c = 0; c < 4; ++c) { f32x4 acc = {0.f, 0.f, 0.f, 0.f}; bf16x8 bfr[4];
#pragma unroll
            for (int ks = 0; ks < 4; ++ks) bfr[ks] = tr_frag(dir ? Kb : Kf, KS, 32 * ks, 16 * c, lane);
#pragma unroll
            for (int ks = 0; ks < 4; ++ks) acc = RET_MFMA(a[ks], bfr[ks], acc);
            float* up = U + ((size_t)((h * NCH + j) * 2 + dir)) * 8192 + (16 * w + 4 * g) * 64 + 16 * c + li;
#pragma unroll
            for (int r = 0; r < 4; ++r) { if (RET_WT) __hip_atomic_store(up + r * 64, acc[r], __ATOMIC_RELAXED, __HIP_MEMORY_SCOPE_AGENT); else up[r * 64] = acc[r]; } }
    __syncthreads();
}
__device__ __forceinline__ void r2_scan(int gid, const float* U, float lgf, float lgb, int h, int dir, bf16* SP) {
    const int e = gid & 8191; const float gC = __expf((dir ? lgb : lgf) * 128.f); float S = 0.f;
    const float* up = U + (size_t)(h * NCH * 2 + dir) * 8192 + e; bf16* sp = SP + (size_t)(h * 128 * 2 + dir) * 8192 + e;
    if (dir == 0) {
#pragma unroll 44
        for (int j = 0; j < NCH; ++j) { if (j >= 2) sp[(size_t)(j - 2) * 16384] = f2bf(S); S = gC * S + up[(size_t)j * 16384]; }
    } else {
        S = up[(size_t)1 * 16384]; S = gC * S + up[0];
#pragma unroll 43
        for (int j = NCH - 1; j >= 2; --j) { sp[(size_t)(j - 2) * 16384] = f2bf(S); S = gC * S + up[(size_t)j * 16384]; }
    }
}
__device__ __forceinline__ void r2_scan_block(Frame& F, int blk, const float* U, const float* dec_f, const float* dec_b, bf16* SP) {
    const int cid0 = blk * 256, combo = cid0 >> 13, h = combo >> 1, dir = combo & 1, s = F.wave, lane = fresh_lane(), vz = lane >> 6;
    const float lg = lsig(dir ? dec_b[h] : dec_f[h]), gC = __expf(lg * 128.f), D16 = __expf(lg * 128.f * 16.f);
    LAS f32x4* Tl = (LAS f32x4*)(F.lds + RING_OFF);
    const int e = (cid0 + 4 * lane) & 8191; const float* up = U + (size_t)(h * NCH * 2 + dir) * 8192 + e;
    const f32x4 ua = *(const f32x4*)(up + (size_t)(dir + vz) * 16384), ub = *(const f32x4*)(up + (size_t)(1 - dir + vz) * 16384);
    f32x4 u[16], pre[16];
#pragma unroll
    for (int k = 0; k < 16; ++k) { const int n = (dir == 0 ? 16 * s + k : 127 - 16 * s - k) + vz; u[k] = *(const f32x4*)(up + (size_t)(2 + n) * 16384); }
    const f32x4 c0 = ua * gC + ub;
    f32x4 P = {0.f, 0.f, 0.f, 0.f};
#pragma unroll
    for (int k = 0; k < 16; ++k) { pre[k] = P; P = P * gC + u[k]; }
    Tl[s * 64 + lane] = P;
    __syncthreads();
    f32x4 C = c0;
    for (int s2 = 0; s2 < s; ++s2) C = C * D16 + Tl[s2 * 64 + lane];
    bf16* sp = SP + (size_t)(h * 128 * 2 + dir) * 8192 + e; f32x4 cur = C;
#pragma unroll
    for (int k = 0; k < 16; ++k) { const int n = (dir == 0 ? 16 * s + k : 127 - 16 * s - k) + vz; const f32x4 val = cur + pre[k];
        u32x2 o; o.x = pk2(val.x, val.y); o.y = pk2(val.z, val.w); st8_sel(sp + (size_t)n * 16384, o, RET_WT != 0); cur = cur * gC; }
    __syncthreads();
}
struct R3Regs { u32x4 kreg[2], vreg[4], sreg[4]; bf16x8 qa[2]; };
__device__ __forceinline__ void r3_load(R3Regs& R, int wv, int lane, int h, int n, const bf16* QR, const bf16* KR, const bf16* VR, const bf16* SP) {
    const int t0 = 128 * n, tid = wv * 64 + lane, g = lane >> 4, li = lane & 15; const bf16* kc = KR + ((size_t)h * NKV + CL + t0) * 64; const bf16* vc = VR + ((size_t)h * NKV + CL + t0) * 128;
    const bf16* spc = SP + (size_t)((h * 128 + n) * 2) * 8192;
#pragma unroll
    for (int q = 0; q < 2; ++q) { const int id = tid + 512 * q; R.kreg[q] = *(const u32x4*)(kc + (id >> 3) * 64 + (id & 7) * 8); }
#pragma unroll
    for (int q = 0; q < 4; ++q) { const int id = tid + 512 * q; R.vreg[q] = *(const u32x4*)(vc + (id >> 4) * 128 + (id & 15) * 8); R.sreg[q] = *(const u32x4*)(spc + (size_t)id * 8); }
#pragma unroll
    for (int ks = 0; ks < 2; ++ks) R.qa[ks] = *(const bf16x8*)(QR + ((size_t)h * SEQ + t0 + 16 * wv + li) * 64 + 32 * ks + 8 * g);
}
__device__ __forceinline__ void r3_unit(Frame& F, R3Regs& R, int h, int n, int hn, int nn, const bf16* QR, const bf16* KR, const bf16* VR, const bf16* GR, const bf16* SP,
                                        float lgf, float lgb, const float* gn_g, const float* gn_b, bf16* MIX) {
    LAS unsigned char* Ks = F.lds, *Vs = F.lds + 128 * KS, *Ps = F.lds + 128 * KS + 128 * VS, *Ss = F.lds + 128 * KS + 2 * 128 * VS;
    const int t0 = 128 * n;
    const int w = F.wave, lane = fresh_lane(), g = lane >> 4, li = lane & 15, tid = w * 64 + lane;
    const int i = 16 * w + li, t = t0 + i;
    bf16x8 qa[2]; qa[0] = R.qa[0]; qa[1] = R.qa[1];
#pragma unroll
    for (int q = 0; q < 2; ++q) { const int id = tid + 512 * q; *(LAS u32x4*)(Ks + (id >> 3) * KS + (id & 7) * 16) = R.kreg[q]; }
#pragma unroll
    for (int q = 0; q < 4; ++q) { const int id = tid + 512 * q; *(LAS u32x4*)(Vs + (id >> 4) * VS + (id & 15) * 16) = R.vreg[q]; *(LAS u32x4*)(Ss + (id >> 3) * KS + (id & 7) * 16) = R.sreg[q]; }
    if (hn >= 0) r3_load(R, w, lane, hn, nn, QR, KR, VR, SP);
    __syncthreads();
    u32x2 greg[8];
#pragma unroll
    for (int d = 0; d < 8; ++d) greg[d] = *(const u32x2*)(GR + (size_t)t * 512 + h * 128 + 16 * d + 4 * g);
    float cf[4], cb[4];
#pragma unroll
    for (int r = 0; r < 4; ++r) { cf[r] = __expf(-lgf * (float)r); cb[r] = __expf(lgb * (float)r); }
    bf16x8 kfr[8][2];
#pragma unroll
    for (int jt = 0; jt < 8; ++jt)
#pragma unroll
        for (int ks = 0; ks < 2; ++ks) kfr[jt][ks] = *(LAS bf16x8*)(Ks + (16 * jt + li) * KS + (32 * ks + 8 * g) * 2);
#pragma unroll
    for (int jt = 0; jt < 8; ++jt) { f32x4 s = {0.f, 0.f, 0.f, 0.f};
#pragma unroll
        for (int ks = 0; ks < 2; ++ks) s = RET_MFMA(kfr[jt][ks], qa[ks], s);
        const int df0 = i - (16 * jt + 4 * g); const float ef0 = __expf(lgf * (float)df0), eb0 = __expf(-lgb * (float)df0);
        float p[4];
#pragma unroll
        for (int r = 0; r < 4; ++r) p[r] = s[r] * ((df0 - r >= 0) ? ef0 * cf[r] : eb0 * cb[r]);
        u32x2 pw; pw.x = pk2(p[0], p[1]); pw.y = pk2(p[2], p[3]);
        *(LAS u32x2*)(Ps + i * PS + (16 * jt + 4 * g) * 2) = pw; }
    LDS_WAIT();
    f32x4 acc[8], af[8], ab[8];
#pragma unroll
    for (int d = 0; d < 8; ++d) { acc[d] = (f32x4){0.f, 0.f, 0.f, 0.f}; af[d] = acc[d]; ab[d] = acc[d]; }
#pragma unroll
    for (int ks = 0; ks < 4; ++ks) { const bf16x8 pf = *(LAS bf16x8*)(Ps + i * PS + (32 * ks + 8 * g) * 2); bf16x8 vf[8];
#pragma unroll
        for (int d = 0; d < 8; ++d) vf[d] = tr_frag(Vs, VS, 32 * ks, 16 * d, lane);
#pragma unroll
        for (int d = 0; d < 8; ++d) acc[d] = RET_MFMA(vf[d], pf, acc[d]); }
#pragma unroll
    for (int ks = 0; ks < 2; ++ks) { bf16x8 sf[8], sb[8];
#pragma unroll
        for (int d = 0; d < 8; ++d) { const int off = (16 * d + li) * KS + (32 * ks + 8 * g) * 2; sf[d] = *(LAS bf16x8*)(Ss + off); sb[d] = *(LAS bf16x8*)(Ss + 128 * KS + off); }
#pragma unroll
        for (int d = 0; d < 8; ++d) { af[d] = RET_MFMA(sf[d], qa[ks], af[d]); ab[d] = RET_MFMA(sb[d], qa[ks], ab[d]); } }
    const float xf = __expf(lgf * (float)(i + 1)), xb = __expf(lgb * (float)(128 - i));
    f32x4 ggv[8], bbv[8];
#pragma unroll
    for (int d = 0; d < 8; ++d) { const int c0 = h * 128 + 16 * d + 4 * g; ggv[d] = *(const f32x4*)(gn_g + c0); bbv[d] = *(const f32x4*)(gn_b + c0); }
    float s1 = 0.f;
#pragma unroll
    for (int d = 0; d < 8; ++d) { acc[d] = acc[d] + xf * af[d] + xb * ab[d]; s1 += (acc[d][0] + acc[d][1]) + (acc[d][2] + acc[d][3]); }
    s1 = ROWS_SWAP ? rows_sum(s1) : rows_sum_shfl(s1);
    const float mu = s1 * (1.f / 128.f); float s2 = 0.f;
#pragma unroll
    for (int d = 0; d < 8; ++d) { acc[d] = acc[d] - mu; s2 += (acc[d][0] * acc[d][0] + acc[d][1] * acc[d][1]) + (acc[d][2] * acc[d][2] + acc[d][3] * acc[d][3]); }
    s2 = ROWS_SWAP ? rows_sum(s2) : rows_sum_shfl(s2);
    const float rs = rsqrtf(s2 * (1.f / 128.f) + EPS);
#pragma unroll
    for (int d = 0; d < 8; ++d) { const int c0 = h * 128 + 16 * d + 4 * g; const f32x4 gg = ggv[d], bb = bbv[d]; const u32x2 gr = greg[d];
        const float r0 = __uint_as_float(gr.x << 16), r1 = __uint_as_float(gr.x & 0xffff0000u), r2 = __uint_as_float(gr.y << 16), r3 = __uint_as_float(gr.y & 0xffff0000u);
        u32x2 o; o.x = pk2((acc[d][0] * rs * gg[0] + bb[0]) * silu_f(r0), (acc[d][1] * rs * gg[1] + bb[1]) * silu_f(r1));
        o.y = pk2((acc[d][2] * rs * gg[2] + bb[2]) * silu_f(r2), (acc[d][3] * rs * gg[3] + bb[3]) * silu_f(r3));
        st8_sel(MIX + (size_t)t * 1024 + 512 + c0, o, (WT_MASK & 8) != 0); }
    __syncthreads();
}
#undef RET_MFMA
}
#ifndef FUSE67_WT
#define FUSE67_WT false
#endif
constexpr int N_PHASES = 11;
struct Args { const float* in[24]; float* out; unsigned char* ws; int ph_lo, ph_hi, flags, pad; };
__global__ void __launch_bounds__(NTHREADS, 2) mega_fwd(Args args) {
    extern __shared__ __attribute__((aligned(16))) unsigned char lds[];
    Frame F;
    F.lds = (LAS unsigned char*)lds; F.MISC = (volatile LAS unsigned*)(F.lds + MISC_OFF);
    F.tid = threadIdx.x; F.lane = F.tid & 63; F.wave = __builtin_amdgcn_readfirstlane(F.tid >> 6);
    F.G = gridDim.x; { const int bx = blockIdx.x; F.vcu = (F.G % 8 == 0) ? (bx % 8) * (F.G / 8) + bx / 8 : bx; }
    unsigned char* ws = args.ws; const float* const* in = args.in;
    F.ctl = (unsigned*)(ws + WS_CTL);
    float* MOD = (float*)(ws + WS_MOD); float* ROPE = (float*)(ws + WS_ROPE);
    int* EID = (int*)(ws + WS_EID); float* RW = (float*)(ws + WS_RW); int* LIST = (int*)(ws + WS_LIST); int* CNT = (int*)(ws + WS_CTL) + CW_CNT;
    bf16 *Wi = (bf16*)(ws + WS_WI), *Wo = (bf16*)(ws + WS_WO), *Wgu = (bf16*)(ws + WS_WGU), *Wd = (bf16*)(ws + WS_WD);
    bf16 *HX = (bf16*)(ws + WS_HX), *MIX = (bf16*)(ws + WS_MIX), *H2 = (bf16*)(ws + WS_H2), *Q = (bf16*)(ws + WS_Q), *K = (bf16*)(ws + WS_K), *V = (bf16*)(ws + WS_V);
    bf16 *QR = (bf16*)(ws + WS_QR), *KR = (bf16*)(ws + WS_KR), *VR = (bf16*)(ws + WS_VR), *GR = (bf16*)(ws + WS_GR), *SP = (bf16*)(ws + WS_SP), *ACT = (bf16*)(ws + WS_ACT), *Y = (bf16*)(ws + WS_Y);
    float* U = (float*)(ws + WS_U); bf16* XN = (bf16*)(ws + WS_XNB);
    for (int u = F.tid; u < (LDS_BYTES - LDSCTL_OFF) / 4; u += NTHREADS) ((LAS unsigned*)(F.lds + LDSCTL_OFF))[u] = 0u;
    __syncthreads();
#ifdef DIAG_STOP
    const int lo = args.ph_lo, hi = (args.ph_hi < DIAG_STOP ? args.ph_hi : DIAG_STOP);
#else
    const int lo = args.ph_lo, hi = args.ph_hi;
#endif
    XcdBarrier bar; bar.bar = (unsigned*)F.ctl + CW_BAR; bar.x = 0; bar.st = nullptr;
    if (hi - lo > 1) bar = xcd_barrier_post((unsigned*)F.ctl + CW_BAR, F.MISC + 8);
#define IN(k) (lo <= (k) && (k) < hi)
#ifndef PROBE_PHASE
#define PROBE_PHASE -1
#endif
#define PH(k, ...) do { if (IN(k)) { { __VA_ARGS__ } if (PROBE_PHASE == (k) || PROBE_PHASE == -2) { __syncthreads(); { __VA_ARGS__ } } } } while (0)
#define REFRESH() do { F.lane = fresh_lane(); F.tid = F.wave * 64 + F.lane; } while (0)
#define SEAM(k) do { if (IN(k) && IN((k) + 1)) { xcd_barrier(bar, F.wave == 0 && fresh_lane() == 0); } REFRESH(); } while (0)
    const int gw = F.vcu * NWAVES + F.wave, NGW = F.G * NWAVES;
    REFRESH();

#ifdef DIAG_FLAG
    if (IN(0)) { int* FLAG = (int*)(ws + WS_EID + 512 * 1024); for (int i = F.vcu * NTHREADS + F.tid; i < 2 * SEQ; i += F.G * NTHREADS) FLAG[i] = 0; }
#endif
#ifdef DIAG_CK
#define CKBUF(ptr, n16) do { const u32x4* cp_ = (const u32x4*)(ptr); unsigned cx_ = 0; \
        for (size_t q_ = (size_t)F.vcu * NTHREADS + F.tid; q_ < (size_t)(n16); q_ += (size_t)F.G * NTHREADS) { const u32x4 w_ = cp_[q_]; const unsigned k_ = (unsigned)(q_ * 2654435761ull) | 1u; \
            cx_ ^= (w_.x * k_) ^ (w_.y * (k_ + 2u)) ^ (w_.z * (k_ + 4u)) ^ (w_.w * (k_ + 6u)); } \
        _Pragma("unroll") for (int o_ = 1; o_ < 64; o_ <<= 1) cx_ ^= (unsigned)__shfl_xor((int)cx_, o_); \
        if (F.lane == 0) atomicXor((unsigned*)(CNT) + 64, cx_); } while (0)
#else
#define CKBUF(ptr, n16) do {} while (0)
#endif
    PH(0,  const P0Args a{(unsigned*)F.ctl + CW_MODCNT, in[1], in[3], in[4], in[5], in[7], in[14], in[20], in[21], in[22], in[16], in[18], MOD, ROPE, (float*)(ws + WS_RTW), Wi, Wo, Wgu, Wd}; p0_prologue(F, a); );
    REFRESH();
#ifdef PROBE_BAR
    if (hi - lo > 1) { for (int q = 0; q < PROBE_BAR; ++q) xcd_barrier(bar, F.wave == 0 && fresh_lane() == 0); }
#endif
    PH(1,  wait_ge((unsigned*)F.ctl + CW_MODCNT, 192u, F.tid == 0, (unsigned*)F.ctl + CW_TMO); { f32x4 lat[2][4];
            _Pragma("unroll") for (int j = 0; j < 4; ++j) { const int n = 8 * F.lane + 4 * (j & 1) + 512 * (j >> 1); const f32x4 g = *(const f32x4*)(in[6] + n), sc = *(const f32x4*)(MOD + 1024 + n); lat[0][j] = g * (sc + 1.f); lat[1][j] = *(const f32x4*)(MOD + n); }
            int r = gw; for (; r + 3 * NGW < NKV; r += 4 * NGW) { const int rows[4] = {r, r + NGW, r + 2 * NGW, r + 3 * NGW}; norm1_rows<4>(rows, F.lane, in[0], in[2], in[6], MOD, HX, lat); }
            for (; r < NKV; r += NGW) { const int rows[1] = {r}; norm1_rows<1>(rows, F.lane, in[0], in[2], in[6], MOD, HX); } } );
    SEAM(1);
#if defined(DIAG_CK) && DIAG_CK == 4
    CKBUF(HX, (size_t)NKV * DM / 8);
#endif
#if defined(DIAG_CK) && DIAG_CK == 7
    CKBUF(Wi, (size_t)NPROJ * DM / 8); CKBUF(MOD, 12288 / 4); CKBUF(ROPE, 8192 / 4);
#endif
    PH(2,
        pg8::Gemm g{HX, Wi, NKV, NPROJ, DM}; pg8::StaticOrder S; S.init(NKV, NPROJ, F.G, (int)blockIdx.x);
        pg8::EpiInProj E{Q, K, V, QR, KR, VR, GR, in[8], in[9], ROPE}; pg8::AMapDirect AM;
        pg8::gemm_phase<pg8::EpiInProj, pg8::StaticOrder, pg8::AMapDirect, true, true>(F.lds + RING_OFF, g, S, E, AM, F.tid);
        {
          const int nun = (NKV / 256) * (NPROJ / 256), maxu = (nun + F.G - 1) / F.G, first_idle = nun - (maxu - 1) * F.G, bx = (int)blockIdx.x;
          const P0Args a{(unsigned*)F.ctl + CW_MODCNT, in[1], in[3], in[4], in[5], in[7], in[14], in[20], in[21], in[22], in[16], in[18], MOD, ROPE, (float*)(ws + WS_RTW), Wi, Wo, Wgu, Wd};
          if (maxu >= 2 && first_idle < F.G) { if (bx >= first_idle) { REFRESH(); convert_items(F, a, P0_ITEMS, CV_ITEMS, (bx - first_idle) * NWAVES + F.wave, (F.G - first_idle) * NWAVES); } }
          else { REFRESH(); convert_items(F, a, P0_ITEMS, CV_ITEMS, F.vcu * NWAVES + F.wave, F.G * NWAVES); } }
    );
    SEAM(2);
#if defined(DIAG_CK) && DIAG_CK == 3
    CKBUF(Q, (size_t)SEQ * 512 / 8); CKBUF(K, (size_t)2 * NKV * 64 / 8); CKBUF(V, (size_t)2 * NKV * 64 / 8);
#endif
#if defined(DIAG_CK) && DIAG_CK == 5
    CKBUF(QR, (size_t)4 * SEQ * 64 / 8); CKBUF(KR, (size_t)4 * NKV * 64 / 8); CKBUF(VR, (size_t)4 * NKV * 128 / 8); CKBUF(GR, (size_t)SEQ * 512 / 8);
#endif
    if (IN(5)) {
        unsigned* r1cnt = (unsigned*)F.ctl + CW_R1CNT; unsigned* sccnt = (unsigned*)F.ctl + CW_SCANCNT; unsigned* tmo = (unsigned*)F.ctl + CW_TMO;
        const bool do_att = (args.flags & 1) != 0, do_ret = (args.flags & 2) != 0;
        const bool hoistl = (F.G % 4) == 0;
        const float lgf5 = lsig(in[10][F.vcu & 3]), lgb5 = lsig(in[11][F.vcu & 3]);
        const int ah = (F.G == 256) ? (((F.vcu >> 5) & 1) * 4 + (F.vcu >> 6)) : 0, ac = F.vcu & 31;
        for (int rep = 0; rep < ((PROBE_PHASE == 5 || PROBE_PHASE == 3 || PROBE_PHASE == -2) ? 2 : 1); ++rep) {
        const bool att = do_att && (rep == 0 || PROBE_PHASE != 3), retp = do_ret && (rep == 0 || PROBE_PHASE != 5);
        if (retp) { for (int q = 0; q < (PROBE_PHASE == 31 ? 2 : 1); ++q) for (int u = F.vcu; u < 4 * ret::NCH; u += F.G) { const int h = u & 3, j = u >> 2; ret::r1_unit(F, h, j, KR, VR, hoistl ? lgf5 : lsig(in[10][h]), hoistl ? lgb5 : lsig(in[11][h]), U); }
            if (rep == 0) { if (RET_WT) publish_add_wt(r1cnt, F.tid == 0); else publish_add(r1cnt, F.tid == 0); } }
        if (att) { if (F.G == 256) { attn_body::attn_unit<8>(ah, ac, Q, K, V, MIX, (char*)lds + RING_OFF, F.tid); }
                   else { for (int u = F.vcu; u < 512; u += 2 * F.G) attn_body::attn_unit<8>(u >> 6, u & 63, Q, K, V, MIX, (char*)lds + RING_OFF, F.tid); } }
        REFRESH();
        if (retp) { wait_ge(r1cnt, (unsigned)F.G, F.tid == 0, tmo, !(RET_WT && (NOACQ_MASK & 1)));
            for (int q = 0; q < (PROBE_PHASE == 32 ? 2 : 1); ++q) for (int b = F.vcu; b < 256; b += F.G) ret::r2_scan_block(F, b, U, in[10], in[11], SP);
            if (rep == 0) { if (RET_WT) publish_add_wt(sccnt, F.tid == 0); else publish_add(sccnt, F.tid == 0); } }
        if (att) { if (F.G == 256) { attn_body::attn_unit<8>(ah, ac + 32, Q, K, V, MIX, (char*)lds + RING_OFF, F.tid); }
                   else { for (int u = F.vcu + F.G; u < 512; u += 2 * F.G) attn_body::attn_unit<8>(u >> 6, u & 63, Q, K, V, MIX, (char*)lds + RING_OFF, F.tid); } }
        REFRESH();
        if (retp) { wait_ge(sccnt, (unsigned)F.G, F.tid == 0, tmo, !(RET_WT && (NOACQ_MASK & 2)));
            for (int q = 0; q < (PROBE_PHASE == 33 ? 2 : 1); ++q) { ret::R3Regs R3; if (F.vcu < 512) ret::r3_load(R3, F.wave, fresh_lane(), F.vcu & 3, F.vcu >> 2, QR, KR, VR, SP);
              for (int u = F.vcu; u < 512; u += F.G) { const int h = u & 3, n = u >> 2, un = u + F.G; ret::r3_unit(F, R3, h, n, un < 512 ? (un & 3) : -1, un >> 2, QR, KR, VR, GR, SP, hoistl ? lgf5 : lsig(in[10][h]), hoistl ? lgb5 : lsig(in[11][h]), in[12], in[13], MIX); } } }
        }
    }
    SEAM(5);
#if defined(DIAG_CK) && DIAG_CK == 2
    CKBUF(MIX, (size_t)SEQ * DM / 8);
#endif
#if defined(DIAG_CK) && (DIAG_CK == 8 || DIAG_CK == 9)
    { const u32x4* cp_ = (const u32x4*)MIX; unsigned cx_ = 0;
      for (size_t q_ = (size_t)F.vcu * NTHREADS + F.tid; q_ < (size_t)SEQ * DM / 8; q_ += (size_t)F.G * NTHREADS) { if ((((q_ & 127) < 64) ? 8 : 9) != DIAG_CK) continue; const u32x4 w_ = cp_[q_]; const unsigned k_ = (unsigned)(q_ * 2654435761ull) | 1u;
          cx_ ^= (w_.x * k_) ^ (w_.y * (k_ + 2u)) ^ (w_.z * (k_ + 4u)) ^ (w_.w * (k_ + 6u)); }
#pragma unroll
      for (int o_ = 1; o_ < 64; o_ <<= 1) cx_ ^= (unsigned)__shfl_xor((int)cx_, o_);
      if (F.lane == 0) atomicXor((unsigned*)(CNT) + 64, cx_); }
#endif
#if defined(DIAG_CK) && DIAG_CK == 6
    CKBUF(SP, (size_t)4 * 128 * 2 * 8192 / 8); CKBUF(U, (size_t)4 * 130 * 2 * 8192 / 4);
#endif
    const bool fuse67 = IN(6) && IN(7) && F.G == 256 && PROBE_PHASE != 6 && PROBE_PHASE != -2;
    if (PROBE_PHASE == 66 && IN(6)) { pg8::Gemm g{MIX, Wo, SEQ, DM, DM}; pg8::StaticOrder S; S.init(SEQ, DM, F.G, (int)blockIdx.x); pg8::EpiOutProj<false> E{in[0], MOD + 2048, XN}; pg8::AMapDirect AM;
        pg8::gemm_phase<pg8::EpiOutProj<false>, pg8::StaticOrder, pg8::AMapDirect, true, true>(F.lds + RING_OFF, g, S, E, AM, F.tid); REFRESH(); }
    if (fuse67) {
        pg8::Gemm g{MIX, Wo, SEQ, DM, DM}; pg8::StaticOrder S; S.init(SEQ, DM, F.G, (int)blockIdx.x);
        pg8::EpiOutProj<FUSE67_WT> E{in[0], MOD + 2048, XN}; pg8::AMapDirect AM;
        pg8::gemm_phase<pg8::EpiOutProj<FUSE67_WT>, pg8::StaticOrder, pg8::AMapDirect, true, true>(F.lds + RING_OFF, g, S, E, AM, F.tid);
    } else {
    PH(6,
        pg8::Gemm g{MIX, Wo, SEQ, DM, DM}; pg8::StaticOrder S; S.init(SEQ, DM, F.G, (int)blockIdx.x);
        pg8::EpiOutProj<false> E{in[0], MOD + 2048, XN}; pg8::AMapDirect AM;
        pg8::gemm_phase<pg8::EpiOutProj<false>, pg8::StaticOrder, pg8::AMapDirect, true, true>(F.lds + RING_OFF, g, S, E, AM, F.tid);
    );
    }
    if (fuse67) {
        pg8::StaticOrder S; S.init(SEQ, DM, F.G, (int)blockIdx.x); pg8::Unit u; (void)S.next(0, u);
        unsigned* pc = (unsigned*)F.ctl + CW_PANEL + 64 * u.pm;
        REFRESH();
        if (FUSE67_WT) publish_add_wt(pc, F.tid == 0); else publish_add(pc, F.tid == 0);
        route_stage_weights(F, (const float*)(ws + WS_RTW));
        wait_ge(pc, 4u, F.tid == 0, (unsigned*)F.ctl + CW_TMO, !(FUSE67_WT && (NOACQ_MASK & 4)));
        { const int tb = u.pm * 256 + u.pn * 64 + F.wave * 8;
          f32x4 gms[2][4];
#pragma unroll
          for (int j = 0; j < 4; ++j) { const int n = 4 * F.lane + 256 * j; const f32x4 g = *(const f32x4*)(in[15] + n), sc = *(const f32x4*)(MOD + 4096 + n); gms[0][j] = g * (sc + 1.f); gms[1][j] = *(const f32x4*)(MOD + 3072 + n); }
          f32x4 xa[4], xb[4]; route_load_row(tb, F.lane, XN, xa);
          float cgl[4] = {0.f, 0.f, 0.f, 0.f}, cel[8] = {0.f, 0.f, 0.f, 0.f, 0.f, 0.f, 0.f, 0.f}; int cg = 0;
#define ROUTE_KEEP(k_, rw_) do { if (F.lane == (k_)) { _Pragma("unroll") for (int c_ = 0; c_ < 4; ++c_) cgl[c_] = rw_.gl[c_]; _Pragma("unroll") for (int c_ = 0; c_ < 8; ++c_) cel[c_] = rw_.el[c_]; cg = rw_.g; } } while (0)
#pragma unroll 1
          for (int k = 0; k < 8; k += 2) { RouteRaw r0, r1; route_load_row(tb + k + 1, F.lane, XN, xb); route_row_pre<2>(F, tb + k, xa, in[15], MOD, in[17], in[19], H2, EID, RW, CNT, LIST, nullptr, nullptr, gms, &r0);
              route_load_row(tb + (k + 2 < 8 ? k + 2 : k + 1), F.lane, XN, xa); route_row_pre<2>(F, tb + k + 1, xb, in[15], MOD, in[17], in[19], H2, EID, RW, CNT, LIST, nullptr, nullptr, gms, &r1);
              ROUTE_KEEP(k, r0); ROUTE_KEEP(k + 1, r1); }
#undef ROUTE_KEEP
          float gmx = cgl[0];
#pragma unroll
          for (int c = 1; c < 4; ++c) gmx = cgl[c] > gmx ? cgl[c] : gmx;
          float gs = 0.f;
#pragma unroll
          for (int c = 0; c < 4; ++c) gs += __expf(cgl[c] - gmx);
          const float pg = __builtin_amdgcn_rcpf(gs);
          int j1 = 0; float m1 = cel[0];
#pragma unroll
          for (int c = 1; c < 8; ++c) if (cel[c] > m1) { m1 = cel[c]; j1 = c; }
          int j2 = -1; float m2 = -INFINITY;
#pragma unroll
          for (int c = 0; c < 8; ++c) if (c != j1 && cel[c] > m2) { m2 = cel[c]; j2 = c; }
          const float e2 = __expf(m2 - m1), r12 = __builtin_amdgcn_rcpf(1.f + e2), w1 = pg * r12, w2 = pg * e2 * r12;
          const int ea = cg * 8 + j1, eb = cg * 8 + j2;
          if (F.lane < 8) { const int t = tb + F.lane; EID[2 * t] = ea; EID[2 * t + 1] = eb; RW[2 * t] = w1; RW[2 * t + 1] = w2;
              const int sa = atomicAdd(CNT + ea, 1), sb = atomicAdd(CNT + eb, 1);
              __hip_atomic_store(LIST + ea * SEQ + sa, 2 * t, __ATOMIC_RELAXED, __HIP_MEMORY_SCOPE_AGENT); __hip_atomic_store(LIST + eb * SEQ + sb, 2 * t + 1, __ATOMIC_RELAXED, __HIP_MEMORY_SCOPE_AGENT); } }
        __syncthreads();
    } else {
    SEAM(6);
    if (IN(7)) { route_stage_weights(F, (const float*)(ws + WS_RTW)); for (int t = gw; t < SEQ; t += NGW) route_row_lds<1>(F, t, XN, in[15], MOD, in[17], in[19], H2, EID, RW, CNT, LIST);
        if (PROBE_PHASE == 7 || PROBE_PHASE == -2) { for (int t = gw; t < SEQ; t += NGW) route_row_lds<0>(F, t, XN, in[15], MOD, in[17], in[19], H2, EID, RW, CNT, LIST); }
        __syncthreads(); }
    }
    SEAM(7);
#ifdef DIAG_THRASH
#define THRASH(src) do { const f32x4* tp = (const f32x4*)(src) + (size_t)F.vcu * 16384; f32x4 ts = {0.f, 0.f, 0.f, 0.f}; \
        for (int q = F.tid; q < 16384; q += NTHREADS) ts += tp[q]; \
        if (ts.x + ts.y + ts.z + ts.w == 12345.678f) ((float*)(ws + WS_CTL))[2000 + (F.tid & 7)] = ts.x; __syncthreads(); } while (0)
#else
#define THRASH(src) do {} while (0)
#endif
    THRASH(in[20]);
    const bool fuse89 = IN(8) && IN(9) && F.G == 256 && PROBE_PHASE != 8 && PROBE_PHASE != 9 && PROBE_PHASE != -2;
    if (fuse89) {
        moe_build_table(F, CNT);
        pg8::MoeTable mt{(const LAS int*)(F.lds + TT_OFF), LIST}; unsigned* tcnt = (unsigned*)F.ctl + CW_TILE;
        { pg8::Gemm g{H2, Wgu, 0, 0, DM}; pg8::MoeOrder1 S{mt, F.G, F.vcu, tcnt}; pg8::EpiSwiGLU<true> E{ACT}; pg8::AMapGather AM{mt};
          pg8::gemm_phase<pg8::EpiSwiGLU<true>, pg8::MoeOrder1, pg8::AMapGather, true, true>(F.lds + RING_OFF, g, S, E, AM, F.tid); }
        REFRESH();
        { pg8::Gemm g{ACT, Wd, 0, 0, DEXP}; pg8::MoeOrder2 S{mt, F.G, F.vcu, F.wave, tcnt, (unsigned*)F.ctl + CW_TMO}; pg8::EpiScatter E{mt, Y, (int*)(ws + WS_EID + 512 * 1024)}; pg8::AMapDirect AM;
          pg8::gemm_phase<pg8::EpiScatter, pg8::MoeOrder2, pg8::AMapDirect, true, true>(F.lds + RING_OFF, g, S, E, AM, F.tid); }
    } else {
    PH(8,
        moe_build_table(F, CNT);
        pg8::MoeTable mt{(const LAS int*)(F.lds + TT_OFF), LIST};
        pg8::Gemm g{H2, Wgu, 0, 0, DM}; pg8::MoeOrder S{mt, F.G, F.vcu}; pg8::EpiSwiGLU<false> E{ACT}; pg8::AMapGather AM{mt};
        pg8::gemm_phase<pg8::EpiSwiGLU<false>, pg8::MoeOrder, pg8::AMapGather, true, true>(F.lds + RING_OFF, g, S, E, AM, F.tid);
    );
    SEAM(8);
    THRASH(in[21]);
    PH(9,
        moe_build_table(F, CNT);
        pg8::MoeTable mt{(const LAS int*)(F.lds + TT_OFF), LIST};
        pg8::Gemm g{ACT, Wd, 0, 0, DEXP}; pg8::MoeOrder S{mt, F.G, F.vcu}; pg8::EpiScatter E{mt, Y, (int*)(ws + WS_EID + 512 * 1024)}; pg8::AMapDirect AM;
        pg8::gemm_phase<pg8::EpiScatter, pg8::MoeOrder, pg8::AMapDirect, true, true>(F.lds + RING_OFF, g, S, E, AM, F.tid);
    );
    }
    SEAM(9);
    THRASH(in[22]);
#ifdef DIAG_CK
    float diag_scale = 1.f;
    if (IN(10)) { const unsigned cur = __hip_atomic_load((unsigned*)(CNT) + 64, __ATOMIC_RELAXED, __HIP_MEMORY_SCOPE_AGENT); unsigned* prev = (unsigned*)(ws + 264 * MiB);
        const unsigned p0 = __hip_atomic_load(prev, __ATOMIC_RELAXED, __HIP_MEMORY_SCOPE_AGENT), p1 = __hip_atomic_load(prev + 1, __ATOMIC_RELAXED, __HIP_MEMORY_SCOPE_AGENT);
        if (p1 == (p0 ^ 0x5a5a1234u) && p0 != cur) diag_scale = 3.f; }
#endif
#ifdef DIAG_FLAG
    if (IN(10)) { const int* FLAG = (const int*)(ws + WS_EID + 512 * 1024); for (int t = gw; t < SEQ; t += NGW) { if (FLAG[2 * t] != 1 || FLAG[2 * t + 1] != 1) { const float qn = __builtin_nanf(""); for (int i = F.lane; i < DM; i += 64) Y[(size_t)t * DM + i] = 0x7fc0; (void)qn; } } }
#endif
    if (IN(10)) { if (PROBE_PHASE == 10 || PROBE_PHASE == -2) { for (int t = gw; t < SEQ; t += NGW) final_row(t, F.lane, XN, Y, RW, MOD, in[23], (float*)(ws + WS_HX)); }
        { f32x4 hv[2][4];
#pragma unroll
          for (int j = 0; j < 4; ++j) { hv[0][j] = *(const f32x4*)(MOD + 5120 + 4 * F.lane + 256 * j); hv[1][j] = *(const f32x4*)(in[23] + 4 * F.lane + 256 * j); }
          int t = gw; for (; t + 3 * NGW < SEQ; t += 4 * NGW) { const int rows[4] = {t, t + NGW, t + 2 * NGW, t + 3 * NGW}; final_rows<4>(rows, F.lane, XN, Y, RW, MOD, in[23], args.out, hv); }
          for (; t < SEQ; t += NGW) final_row(t, F.lane, XN, Y, RW, MOD, in[23], args.out); } }
#ifdef DIAG_CK
    if (IN(10)) { __syncthreads(); if (diag_scale != 1.f) { for (int t = gw; t < SEQ; t += NGW) for (int i = F.lane; i < DM; i += 64) args.out[(size_t)t * DM + i] *= diag_scale; }
        if (blockIdx.x == 0 && F.tid == 0) { const unsigned cur = __hip_atomic_load((unsigned*)(CNT) + 64, __ATOMIC_RELAXED, __HIP_MEMORY_SCOPE_AGENT); unsigned* prev = (unsigned*)(ws + 264 * MiB);
            __hip_atomic_store(prev, cur, __ATOMIC_RELAXED, __HIP_MEMORY_SCOPE_AGENT); __hip_atomic_store(prev + 1, cur ^ 0x5a5a1234u, __ATOMIC_RELAXED, __HIP_MEMORY_SCOPE_AGENT); } }
#endif
    if (PROBE_PHASE == 108 || PROBE_PHASE == 109) { xcd_barrier(bar, F.wave == 0 && fresh_lane() == 0); REFRESH();
        moe_build_table(F, CNT); pg8::MoeTable mt{(const LAS int*)(F.lds + TT_OFF), LIST}; pg8::MoeOrder S{mt, F.G, F.vcu};
        if (PROBE_PHASE == 108) { pg8::Gemm g{H2, Wgu, 0, 0, DM}; pg8::EpiSwiGLU<false> E{ACT}; pg8::AMapGather AM{mt};
            pg8::gemm_phase<pg8::EpiSwiGLU<false>, pg8::MoeOrder, pg8::AMapGather, true, true>(F.lds + RING_OFF, g, S, E, AM, F.tid); }
        else { pg8::Gemm g{ACT, Wd, 0, 0, DEXP}; pg8::EpiScatter E{mt, Y, (int*)(ws + WS_EID + 512 * 1024)}; pg8::AMapDirect AM;
            pg8::gemm_phase<pg8::EpiScatter, pg8::MoeOrder, pg8::AMapDirect, true, true>(F.lds + RING_OFF, g, S, E, AM, F.tid); } }
    if (PROBE_PHASE == 100) { REFRESH(); const P0Args a{(unsigned*)F.ctl + CW_MODCNT, in[1], in[3], in[4], in[5], in[7], in[14], in[20], in[21], in[22], in[16], in[18], MOD, ROPE, (float*)(ws + WS_RTW), Wi, Wo, Wgu, Wd}; p0_prologue(F, a); }
#undef IN
#undef SEAM
}

#ifndef FAST_MASK
#define FAST_MASK 0xff
#endif
#ifndef ONE_LAUNCH
#define ONE_LAUNCH 0
#endif
static int g_grid = 0;
static void launch_fast(Args a, int lo, int hi, int flags, hipStream_t stream) {
    a.ph_lo = lo; a.ph_hi = hi; a.flags = flags; a.pad = 0;
    hipLaunchKernelGGL(mega_fwd, dim3(g_grid), dim3(NTHREADS), LDS_BYTES, stream, a);
}
extern "C" void kernel_launch(void* const* d_in, const int* in_sizes, int n_in, void* d_out, int out_size, void* d_ws, size_t ws_size, hipStream_t stream) {
    if (n_in != 24 || out_size != SEQ * DM || ws_size < WS_END) { fprintf(stderr, "kernel_launch: unexpected shapes / workspace (%d inputs, out %d, ws %zu < %zu)\n", n_in, out_size, ws_size, (size_t)WS_END); return; }
    if (g_grid == 0) {
        int dev = 0, cus = 0;
        if (hipGetDevice(&dev) != hipSuccess || hipDeviceGetAttribute(&cus, hipDeviceAttributeMultiprocessorCount, dev) != hipSuccess) { g_grid = -1; return; }
        if (hipFuncSetAttribute((const void*)mega_fwd, hipFuncAttributeMaxDynamicSharedMemorySize, LDS_BYTES) != hipSuccess) { g_grid = -1; return; }
        int per_cu = 0; (void)hipOccupancyMaxActiveBlocksPerMultiprocessor(&per_cu, (const void*)mega_fwd, NTHREADS, LDS_BYTES); (void)hipGetLastError();
        g_grid = cus;
    }
    if (g_grid < 0) return;
    const float* const* in = (const float* const*)d_in;
    unsigned char* ws = (unsigned char*)d_ws; float* out = (float*)d_out;
    (void)hipMemsetAsync(ws + WS_CTL, 0, CTL_ZERO_BYTES, stream);
    Args a{}; for (int i = 0; i < 24; ++i) a.in[i] = in[i]; a.out = out; a.ws = ws;
#if ONE_LAUNCH
    launch_fast(a, 0, N_PHASES, 3, stream);
#ifdef DIAG_2LAUNCH
    (void)hipMemsetAsync(ws + WS_CTL, 0, CTL_ZERO_BYTES, stream); launch_fast(a, 0, N_PHASES, 3, stream);
#endif
#ifdef DIAG_RERUN_LO
    (void)hipMemsetAsync(ws + WS_CTL + 4 * CW_MODCNT, 0, CTL_ZERO_BYTES - 4 * CW_MODCNT, stream); launch_fast(a, DIAG_RERUN_LO, DIAG_RERUN_HI, DIAG_RERUN_FLAGS, stream);
#endif
#else
    float* MOD = (float*)(ws + WS_MOD); float* ROPE = (float*)(ws + WS_ROPE);
    int* EID = (int*)(ws + WS_EID); float* RW = (float*)(ws + WS_RW); int* LIST = (int*)(ws + WS_LIST); int* CNT = (int*)(ws + WS_CTL) + CW_CNT;
    bf16 *HX = (bf16*)(ws + WS_HX), *MIX = (bf16*)(ws + WS_MIX), *H2 = (bf16*)(ws + WS_H2), *Q = (bf16*)(ws + WS_Q), *K = (bf16*)(ws + WS_K), *V = (bf16*)(ws + WS_V);
    bf16 *QR = (bf16*)(ws + WS_QR), *KR = (bf16*)(ws + WS_KR), *VR = (bf16*)(ws + WS_VR), *GR = (bf16*)(ws + WS_GR), *Y = (bf16*)(ws + WS_Y);
    (void)EID; (void)RW; (void)LIST; (void)CNT; (void)H2; (void)Y;
    const int FM = FAST_MASK;
    if (FM & 1) launch_fast(a, 0, 1, 0, stream);
    if (!(FM & 1)) { nv::k_mod<<<dim3(24, 2), 256, 0, stream>>>(in[1], in[3], in[4], in[5], MOD); nv::k_rope<<<16, 256, 0, stream>>>(ROPE); }
    if (FM & 2) launch_fast(a, 1, 2, 0, stream); else nv::k_norm1<<<NKV, 256, 0, stream>>>(in[0], in[2], in[6], MOD, HX);
#ifdef DUP_P2
    launch_fast(a, 2, 3, 0, stream);
#endif
    if (FM & 4) launch_fast(a, 2, 3, 0, stream); else nv::k_inproj<<<dim3(36, NKV / 64), 256, 0, stream>>>(HX, in[7], in[8], in[9], ROPE, Q, K, V, QR, KR, VR, GR);
    if (FM & 8) { launch_fast(a, 3, 4, 0, stream); launch_fast(a, 4, 5, 0, stream); launch_fast(a, 5, 6, 2, stream);
#ifdef DUP_R3
    launch_fast(a, 5, 6, 2, stream);
#endif
    }
    else nv::k_ret<<<dim3(SEQ / 128, 4), 256, 0, stream>>>(QR, KR, VR, GR, in[10], in[11], in[12], in[13], MIX);
    if (FM & 16) launch_fast(a, 5, 6, 1, stream); else nv::k_attn<<<dim3(SEQ / 256, 8), 256, 0, stream>>>(Q, K, V, MIX);
    if (FM & 32) launch_fast(a, 6, 7, 0, stream); else nv::k_outproj<<<dim3(16, SEQ / 64), 256, 0, stream>>>(MIX, in[14], in[0], MOD, out);
    launch_fast(a, 7, 8, 0, stream);
    if (FM & 64) { launch_fast(a, 8, 9, 0, stream); launch_fast(a, 9, 10, 0, stream); }
    else nv::k_moe<<<dim3(SEQ / 8, NEXP), 256, 0, stream>>>(H2, CNT, LIST, in[20], in[21], in[22], Y);
    launch_fast(a, 10, 11, 0, stream);
#endif
}
```
